# Optimizing an MI355X kernel written in HIP

```python
import jax, jax.numpy as jnp
from jax import lax
import numpy as np

D_MODEL = 1024
BATCH = 8
SEQ = 4096
DEPTH = 2

D_MIX = 512
N_BRANCH = 3
GLA_HEADS = 4
GLA_DK = 64
GLA_DV = 128
GLA_RANK = 16
GLA_TAU = 16.0
GLA_CHUNK = 64
POOL_WINDOWS = (2, 4, 8, 16)
POOL_GROUPS = 4
POOL_GC = D_MIX // POOL_GROUPS
MOBA_HEADS = 8
MOBA_DH = D_MIX // MOBA_HEADS
MOBA_BLOCK = 256
MOBA_TOPK = 3
MOBA_QBLOCK = 128
D_FF = -(-8 * D_MODEL // (3 * 256)) * 256
EPS = 1e-6
NEG = -1e30

IN_SIZES = (GLA_HEADS * GLA_DK, GLA_HEADS * GLA_DK, GLA_HEADS * GLA_DV, GLA_RANK,
            GLA_HEADS * GLA_DV, D_MIX, D_MIX, D_MIX, D_MIX, N_BRANCH * D_MODEL)
D_IN = sum(IN_SIZES)

kernel_name = "hybrid_gla_pool_moba_block"


def rmsnorm(x, w):
    xf = x.astype(jnp.float32)
    y = xf * lax.rsqrt(jnp.mean(xf * xf, axis=-1, keepdims=True) + EPS)
    return (y * w.astype(jnp.float32)).astype(x.dtype)


def gla_mixer(q, k, v, g1, r, w_g2, b_g, norm_w):
    B, T, _ = q.shape
    H, DK, DV, C = GLA_HEADS, GLA_DK, GLA_DV, GLA_CHUNK
    NC = T // C
    f32 = jnp.float32
    qf = q.astype(f32).reshape(B, T, H, DK) * (DK ** -0.5)
    kf = k.astype(f32).reshape(B, T, H, DK)
    vf = v.astype(f32).reshape(B, T, H, DV)
    logit = (g1 @ w_g2 + b_g).astype(f32)
    log_a = (jax.nn.log_sigmoid(logit) / GLA_TAU).reshape(B, T, H, DK)

    def to_chunks(a):
        return a.reshape(B, NC, C, H, a.shape[-1]).transpose(1, 0, 3, 2, 4)

    causal = jnp.tril(jnp.ones((C, C), dtype=bool))

    def step(S, inp):
        qc, kc, vc, gc = inp
        bc = jnp.cumsum(gc, axis=2)
        diff = bc[:, :, :, None, :] - bc[:, :, None, :, :]
        decay = jnp.exp(jnp.where(causal[None, None, :, :, None], diff, NEG))
        attn = jnp.einsum('bhtd,bhsd,bhtsd->bhts', qc, kc, decay)
        o = (jnp.einsum('bhts,bhsv->bhtv', attn, vc)
             + jnp.einsum('bhtd,bhdv->bhtv', qc * jnp.exp(bc), S))
        b_last = bc[:, :, -1:, :]
        S = (jnp.exp(b_last[:, :, 0, :])[..., None] * S
             + jnp.einsum('bhsd,bhsv->bhdv', kc * jnp.exp(b_last - bc), vc))
        return S, o

    S0 = jnp.zeros((B, H, DK, DV), f32)
    _, o = lax.scan(step, S0, (to_chunks(qf), to_chunks(kf), to_chunks(vf), to_chunks(log_a)))
    o = o.transpose(1, 0, 3, 2, 4).reshape(B, T, H, DV)
    o = o * lax.rsqrt(jnp.mean(o * o, axis=-1, keepdims=True) + EPS) * norm_w.astype(f32)
    o = o.reshape(B, T, H * DV) * jax.nn.silu(r.astype(f32))
    return o.astype(q.dtype)


def pool_mixer(u, w_pool, scale):
    B, T, _ = u.shape
    f32 = jnp.float32
    uf = u.astype(f32).reshape(B, T, POOL_GROUPS, POOL_GC)
    cs = jnp.cumsum(uf, axis=1)
    t = jnp.arange(T)
    outs = []
    for gi, w in enumerate(POOL_WINDOWS):
        c = cs[:, :, gi]
        lag = jnp.pad(c, ((0, 0), (w, 0), (0, 0)))[:, :T]
        cnt = jnp.minimum(t + 1, w).astype(f32)[None, :, None]
        outs.append((c - lag) / cnt - uf[:, :, gi])
    p = jnp.stack(outs, axis=2)
    y = jnp.einsum('btgc,gcd->btgd', p, w_pool.astype(f32)).reshape(B, T, D_MIX)
    return (y * scale.astype(f32)).astype(u.dtype)


def moba_mixer(q, k, v):
    B, T, _ = q.shape
    H, DH, BLK, QB = MOBA_HEADS, MOBA_DH, MOBA_BLOCK, MOBA_QBLOCK
    NB = -(-T // BLK)
    NQ = T // QB
    KSEL = min(MOBA_TOPK, NB)
    f32 = jnp.float32
    qh = q.reshape(B, T, H, DH).transpose(0, 2, 1, 3)
    kh = k.reshape(B, T, H, DH).transpose(0, 2, 1, 3)
    vh = v.reshape(B, T, H, DH).transpose(0, 2, 1, 3)
    pad = NB * BLK - T
    kp = jnp.pad(kh, ((0, 0), (0, 0), (0, pad), (0, 0)))
    vp = jnp.pad(vh, ((0, 0), (0, 0), (0, pad), (0, 0)))
    kblk = kp.reshape(B, H, NB, BLK, DH)
    vblk = vp.reshape(B, H, NB, BLK, DH)
    kmean = jnp.mean(kblk.astype(f32), axis=3)
    gate = jnp.einsum('bhtd,bhnd->bhtn', qh.astype(f32), kmean)
    tblk = jnp.arange(T) // BLK
    past = jnp.arange(NB)[None, :] < tblk[:, None]
    gate = jnp.where(past[None, None], gate, NEG)
    _, idx = lax.top_k(gate, KSEL)
    valid = jnp.arange(KSEL)[None, :] < tblk[:, None]
    slopes = (2.0 ** (-8.0 * (jnp.arange(H) + 1) / H)).astype(f32)
    scale = DH ** -0.5
    hi = jnp.arange(H)[:, None, None]

    def one_block(i):
        b = i // NQ
        t0 = (i % NQ) * QB
        qb = lax.dynamic_slice(qh, (b, 0, t0, 0), (1, H, QB, DH))[0]
        ib = lax.dynamic_slice(idx, (b, 0, t0, 0), (1, H, QB, KSEL))[0]
        vm = lax.dynamic_slice(valid, (t0, 0), (QB, KSEL))
        kg = kblk[b][hi, ib]
        vg = vblk[b][hi, ib]
        own0 = (t0 // BLK) * BLK
        ko = lax.dynamic_slice(kp, (b, 0, own0, 0), (1, H, BLK, DH))[0]
        vo = lax.dynamic_slice(vp, (b, 0, own0, 0), (1, H, BLK, DH))[0]
        tq = t0 + jnp.arange(QB)
        s_sel = ib[..., None] * BLK + jnp.arange(BLK)
        s_own = own0 + jnp.arange(BLK)
        sc_sel = (jnp.einsum('hqd,hqkjd->hqkj', qb, kg).astype(f32) * scale
                  - slopes[:, None, None, None] * (tq[None, :, None, None] - s_sel).astype(f32))
        sc_sel = jnp.where(vm[None, :, :, None], sc_sel, NEG)
        sc_own = (jnp.einsum('hqd,hjd->hqj', qb, ko).astype(f32) * scale
                  - slopes[:, None, None] * (tq[:, None] - s_own[None, :]).astype(f32)[None])
        sc_own = jnp.where((s_own[None, :] <= tq[:, None])[None], sc_own, NEG)
        sc = jnp.concatenate([sc_sel.reshape(H, QB, KSEL * BLK), sc_own], axis=-1)
        p = jax.nn.softmax(sc, axis=-1).astype(v.dtype)
        p_sel = p[..., :KSEL * BLK].reshape(H, QB, KSEL, BLK)
        p_own = p[..., KSEL * BLK:]
        return (jnp.einsum('hqkj,hqkjd->hqd', p_sel, vg)
                + jnp.einsum('hqj,hjd->hqd', p_own, vo))

    out = lax.map(one_block, jnp.arange(B * NQ))
    return out.reshape(B, NQ, H, QB, DH).transpose(0, 1, 3, 2, 4).reshape(B, T, H * DH)


def setup_inputs(seed: int = 0) -> dict:
    key = jax.random.key(seed)
    ks = jax.random.split(key, 20)
    f32 = jnp.float32

    def nrm(k, shape, fan_in):
        return jax.random.normal(k, shape, f32) * (fan_in ** -0.5)

    def gain(k, shape):
        return 1.0 + 0.05 * jax.random.normal(k, shape, f32)

    L = DEPTH
    return {
        "x": jax.random.normal(ks[0], (BATCH, SEQ, D_MODEL), f32),
        "norm_mix_pre": gain(ks[1], (L, D_MODEL)),
        "w_in": nrm(ks[2], (L, D_MODEL, D_IN), D_MODEL),
        "gla_w_g2": nrm(ks[3], (L, GLA_RANK, GLA_HEADS * GLA_DK), GLA_RANK),
        "gla_b_g": 0.1 * jax.random.normal(ks[4], (L, GLA_HEADS * GLA_DK), f32),
        "gla_norm": gain(ks[5], (L, GLA_DV)),
        "pool_w": nrm(ks[6], (L, POOL_GROUPS, POOL_GC, POOL_GC), POOL_GC),
        "pool_scale": gain(ks[7], (L, D_MIX)),
        "w_branch_a": nrm(ks[8], (L, D_MIX, D_MODEL), D_MIX),
        "w_branch_b": nrm(ks[9], (L, D_MIX, D_MODEL), D_MIX),
        "w_branch_c": nrm(ks[10], (L, D_MIX, D_MODEL), D_MIX),
        "w_out": nrm(ks[11], (L, D_MODEL, D_MODEL), D_MODEL),
        "norm_mix_post": gain(ks[12], (L, D_MODEL)),
        "norm_ffn_pre": gain(ks[13], (L, D_MODEL)),
        "ffn_w_gate": nrm(ks[14], (L, D_MODEL, D_FF), D_MODEL),
        "ffn_w_up": nrm(ks[15], (L, D_MODEL, D_FF), D_MODEL),
        "ffn_w_down": nrm(ks[16], (L, D_FF, D_MODEL), D_FF),
        "norm_ffn_post": gain(ks[17], (L, D_MODEL)),
    }


def reference(x, norm_mix_pre, w_in, gla_w_g2, gla_b_g, gla_norm, pool_w, pool_scale,
              w_branch_a, w_branch_b, w_branch_c, w_out, norm_mix_post, norm_ffn_pre,
              ffn_w_gate, ffn_w_up, ffn_w_down, norm_ffn_post):
    B, T, D = x.shape
    splits = [int(s) for s in np.cumsum(IN_SIZES)[:-1]]
    for l in range(DEPTH):
        h = rmsnorm(x, norm_mix_pre[l])
        proj = h @ w_in[l]
        gq, gk, gv, gg1, gr, pu, mq, mk, mv, gates = jnp.split(proj, splits, axis=-1)
        ya = gla_mixer(gq, gk, gv, gg1, gr, gla_w_g2[l], gla_b_g[l], gla_norm[l]) @ w_branch_a[l]
        yb = pool_mixer(pu, pool_w[l], pool_scale[l]) @ w_branch_b[l]
        yc = moba_mixer(mq, mk, mv) @ w_branch_c[l]
        gs = jax.nn.sigmoid(gates).reshape(B, T, N_BRANCH, D)
        mixed = gs[:, :, 0] * ya + gs[:, :, 1] * yb + gs[:, :, 2] * yc
        x = x + rmsnorm(mixed @ w_out[l], norm_mix_post[l])
        h = rmsnorm(x, norm_ffn_pre[l])
        f = (jax.nn.silu(h @ ffn_w_gate[l]) * (h @ ffn_w_up[l])) @ ffn_w_down[l]
        x = x + rmsnorm(f, norm_ffn_post[l])
    return x
```

```cpp
#include <hip/hip_runtime.h>
#include <stdint.h>
#include <stdio.h>

typedef unsigned short bf16_t;

constexpr int BATCH = 8, SEQ = 4096, DM = 1024, M = BATCH * SEQ, DEPTH = 2;
constexpr int DIN = 6672, NMIX = 3584, NGATE = 3072, DFF = 2816, NGU = 2 * DFF, KBR = 1536;
constexpr int C_MQ = 0, C_MK = 512, C_MV = 1024, C_GQ = 1536, C_GK = 1792, C_GV = 2048, C_GR = 2560, C_PU = 3072;
constexpr int O_GQ = 0, O_GK = 256, O_GV = 512, O_G1 = 1024, O_GR = 1040, O_PU = 1552, O_MQ = 2064, O_MK = 2576, O_MV = 3088, O_GATE = 3600;
constexpr float EPS = 1e-6f;

constexpr size_t MiB = 1u << 20;
constexpr size_t WS_CTL = 0;
constexpr size_t WS_R = 1 * MiB;
constexpr size_t WS_G1 = 2 * MiB;
constexpr size_t WS_KM = 4 * MiB;
constexpr size_t WS_WG1 = 5 * MiB;
constexpr size_t WS_W = 6 * MiB, W_LAYER = 35 * MiB;
constexpr size_t W_IN = 0, W_GATE = 7 * MiB, W_BR = 13 * MiB, W_OUT = 16 * MiB, W_GU = 18 * MiB, W_DN = 29 * MiB;
constexpr size_t WS_XB = 76 * MiB;
constexpr size_t WS_PM = 140 * MiB;
constexpr size_t WS_MO = 364 * MiB;
constexpr size_t WS_SP = 460 * MiB;
constexpr size_t WS_MIXED = WS_PM;
constexpr size_t WS_F1 = WS_PM + 64 * MiB;
constexpr size_t WS_HDN = WS_PM;
constexpr size_t WS_F2 = WS_MO;
constexpr size_t WS_END = 512 * MiB;

__device__ __forceinline__ float bf2f(unsigned v) { return __uint_as_float(v << 16); }
__device__ __forceinline__ bf16_t f2bf(float f) { unsigned u = __float_as_uint(f); return (bf16_t)((u + 0x7fffu + ((u >> 16) & 1u)) >> 16); }
__device__ __forceinline__ float sigmoidf_(float x) { return 1.f / (1.f + __expf(-x)); }
__device__ __forceinline__ float siluf_(float x) { return x / (1.f + __expf(-x)); }

__device__ __forceinline__ float wave_sum(float v) {
#pragma unroll
    for (int o = 1; o < 64; o <<= 1) v += __shfl_xor(v, o);
    return v;
}
__device__ __forceinline__ float block_sum256(float v, float* red) {
    v = wave_sum(v);
    __syncthreads();
    if ((threadIdx.x & 63) == 0) red[threadIdx.x >> 6] = v;
    __syncthreads();
    return red[0] + red[1] + red[2] + red[3];
}

__global__ void k_prep_transpose(const float* __restrict__ W, int ldin, int col0, const float* __restrict__ gain, bf16_t* out, int ldout, int seg, int seg_stride) {
    __shared__ float tile[32][33];
    const int n0 = blockIdx.x * 32, k0 = blockIdx.y * 32, tx = threadIdx.x & 31, ty = threadIdx.x >> 5;
    for (int i = ty; i < 32; i += 8) { const int k = k0 + i; const float g = gain ? gain[k] : 1.f; tile[i][tx] = W[(size_t)k * ldin + col0 + n0 + tx] * g; }
    __syncthreads();
    for (int i = ty; i < 32; i += 8) { const int n = n0 + i; const int drow = (n / seg) * seg_stride + (n % seg); out[(size_t)drow * ldout + k0 + tx] = f2bf(tile[tx][i]); }
}
__global__ void k_prep_g1(const float* __restrict__ w_in, const float* __restrict__ gain, float* out) {
    const int idx = blockIdx.x * 256 + threadIdx.x;
    const int j = idx >> 10, k = idx & 1023;
    out[idx] = gain[k] * w_in[(size_t)k * DIN + O_G1 + j];
}
__global__ void k_prep_poolfold(const float* __restrict__ w_pool, const float* __restrict__ scale, const float* __restrict__ Wb, bf16_t* WBR_t) {
    const int n = blockIdx.x * 256 + threadIdx.x;
    const int kk = blockIdx.y;
    const int g = kk >> 7, c = kk & 127;
    float s = 0.f;
    for (int d = 0; d < 128; ++d) s += w_pool[((size_t)g * 128 + c) * 128 + d] * scale[g * 128 + d] * Wb[(size_t)(g * 128 + d) * 1024 + n];
    WBR_t[(size_t)n * KBR + 512 + kk] = f2bf(s);
}

__global__ void k_rows(const float* __restrict__ xsrc, const bf16_t* __restrict__ F, const float* __restrict__ wpost, float* xdst, bf16_t* XB, float* R, float* G1, const float* __restrict__ WG1f) {
    __shared__ float red[4];
    const int m = blockIdx.x, tid = threadIdx.x;
    float4 v = ((const float4*)(xsrc + (size_t)m * DM))[tid];
    if (F) {
        const uint2 fw = ((const uint2*)(F + (size_t)m * DM))[tid];
        const float f0 = bf2f(fw.x & 0xffffu), f1 = bf2f(fw.x >> 16), f2 = bf2f(fw.y & 0xffffu), f3 = bf2f(fw.y >> 16);
        const float ss = block_sum256(f0 * f0 + f1 * f1 + f2 * f2 + f3 * f3, red);
        const float rf = rsqrtf(ss * (1.f / DM) + EPS);
        const float4 w = ((const float4*)wpost)[tid];
        v.x += f0 * rf * w.x; v.y += f1 * rf * w.y; v.z += f2 * rf * w.z; v.w += f3 * rf * w.w;
    }
    if (xdst) ((float4*)(xdst + (size_t)m * DM))[tid] = v;
    if (XB) {
        const float ss = block_sum256(v.x * v.x + v.y * v.y + v.z * v.z + v.w * v.w, red);
        const float r = rsqrtf(ss * (1.f / DM) + EPS);
        uint2 o; o.x = (unsigned)f2bf(v.x) | ((unsigned)f2bf(v.y) << 16); o.y = (unsigned)f2bf(v.z) | ((unsigned)f2bf(v.w) << 16);
        ((uint2*)(XB + (size_t)m * DM))[tid] = o;
        if (tid == 0) R[m] = r;
        if (WG1f) {
            for (int j = 0; j < 16; ++j) {
                const float4 w = ((const float4*)(WG1f + j * DM))[tid];
                const float s = block_sum256(v.x * w.x + v.y * w.y + v.z * w.z + v.w * w.w, red);
                if (tid == 0) G1[m * 16 + j] = s * r;
            }
        }
    }
}

__device__ __forceinline__ void tile_gemm(float (&acc)[4][4], const bf16_t* __restrict__ A, int lda, const bf16_t* __restrict__ Bt, int ldb, int K, int m0, int n0, float* As, float* Bs) {
    const int tid = threadIdx.x, tx = tid & 15, ty = tid >> 4;
    const int r = tid >> 2, kc = (tid & 3) * 8;
    for (int k0 = 0; k0 < K; k0 += 32) {
        const uint4 va = *(const uint4*)(A + (size_t)(m0 + r) * lda + k0 + kc);
        const uint4 vb = *(const uint4*)(Bt + (size_t)(n0 + r) * ldb + k0 + kc);
        __syncthreads();
        As[(kc + 0) * 65 + r] = bf2f(va.x & 0xffffu); As[(kc + 1) * 65 + r] = bf2f(va.x >> 16);
        As[(kc + 2) * 65 + r] = bf2f(va.y & 0xffffu); As[(kc + 3) * 65 + r] = bf2f(va.y >> 16);
        As[(kc + 4) * 65 + r] = bf2f(va.z & 0xffffu); As[(kc + 5) * 65 + r] = bf2f(va.z >> 16);
        As[(kc + 6) * 65 + r] = bf2f(va.w & 0xffffu); As[(kc + 7) * 65 + r] = bf2f(va.w >> 16);
        Bs[(kc + 0) * 65 + r] = bf2f(vb.x & 0xffffu); Bs[(kc + 1) * 65 + r] = bf2f(vb.x >> 16);
        Bs[(kc + 2) * 65 + r] = bf2f(vb.y & 0xffffu); Bs[(kc + 3) * 65 + r] = bf2f(vb.y >> 16);
        Bs[(kc + 4) * 65 + r] = bf2f(vb.z & 0xffffu); Bs[(kc + 5) * 65 + r] = bf2f(vb.z >> 16);
        Bs[(kc + 6) * 65 + r] = bf2f(vb.w & 0xffffu); Bs[(kc + 7) * 65 + r] = bf2f(vb.w >> 16);
        __syncthreads();
#pragma unroll 8
        for (int k = 0; k < 32; ++k) {
            float a[4], b[4];
#pragma unroll
            for (int i = 0; i < 4; ++i) a[i] = As[k * 65 + ty * 4 + i];
#pragma unroll
            for (int j = 0; j < 4; ++j) b[j] = Bs[k * 65 + tx * 4 + j];
#pragma unroll
            for (int i = 0; i < 4; ++i)
#pragma unroll
                for (int j = 0; j < 4; ++j) acc[i][j] += a[i] * b[j];
        }
    }
}
#define ZERO_ACC(a) do { _Pragma("unroll") for (int i_ = 0; i_ < 4; ++i_) _Pragma("unroll") for (int j_ = 0; j_ < 4; ++j_) a[i_][j_] = 0.f; } while (0)

__global__ void __launch_bounds__(256) k_inproj(const bf16_t* __restrict__ XB, const bf16_t* __restrict__ WIN_t, const float* __restrict__ R, bf16_t* PM) {
    __shared__ float As[32 * 65], Bs[32 * 65];
    const int n0 = blockIdx.x * 64, m0 = blockIdx.y * 64, tx = threadIdx.x & 15, ty = threadIdx.x >> 4;
    float acc[4][4]; ZERO_ACC(acc);
    tile_gemm(acc, XB, DM, WIN_t, DM, DM, m0, n0, As, Bs);
    const bool is_scale = (n0 < C_MK) || (n0 >= C_GQ && n0 < C_GK);
    const bool is_silu = (n0 >= C_GR && n0 < C_PU);
#pragma unroll
    for (int i = 0; i < 4; ++i) {
        const int m = m0 + ty * 4 + i; const float r = R[m];
#pragma unroll
        for (int j = 0; j < 4; ++j) {
            float v = acc[i][j] * r;
            if (is_scale) v *= 0.125f;
            if (is_silu) v = siluf_(v);
            PM[(size_t)m * NMIX + n0 + tx * 4 + j] = f2bf(v);
        }
    }
}
__global__ void __launch_bounds__(256) k_gemm_bf16(const bf16_t* __restrict__ A, int lda, const bf16_t* __restrict__ Bt, int ldb, int K, bf16_t* C, int ldc) {
    __shared__ float As[32 * 65], Bs[32 * 65];
    const int n0 = blockIdx.x * 64, m0 = blockIdx.y * 64, tx = threadIdx.x & 15, ty = threadIdx.x >> 4;
    float acc[4][4]; ZERO_ACC(acc);
    tile_gemm(acc, A, lda, Bt, ldb, K, m0, n0, As, Bs);
#pragma unroll
    for (int i = 0; i < 4; ++i)
#pragma unroll
        for (int j = 0; j < 4; ++j) C[(size_t)(m0 + ty * 4 + i) * ldc + n0 + tx * 4 + j] = f2bf(acc[i][j]);
}
__global__ void __launch_bounds__(256) k_mix(const bf16_t* __restrict__ XB, const bf16_t* __restrict__ WGATE_t, const float* __restrict__ R, const bf16_t* __restrict__ MO, const bf16_t* __restrict__ WBR_t, bf16_t* MIXED) {
    __shared__ float As[32 * 65], Bs[32 * 65];
    const int n0 = blockIdx.x * 64, m0 = blockIdx.y * 64, tx = threadIdx.x & 15, ty = threadIdx.x >> 4;
    float tot[4][4]; ZERO_ACC(tot);
    for (int br = 0; br < 3; ++br) {
        float g[4][4]; ZERO_ACC(g);
        tile_gemm(g, XB, DM, WGATE_t + (size_t)br * 1024 * DM, DM, DM, m0, n0, As, Bs);
        float y[4][4]; ZERO_ACC(y);
        tile_gemm(y, MO + br * 512, KBR, WBR_t + br * 512, KBR, 512, m0, n0, As, Bs);
#pragma unroll
        for (int i = 0; i < 4; ++i) {
            const float r = R[m0 + ty * 4 + i];
#pragma unroll
            for (int j = 0; j < 4; ++j) tot[i][j] += sigmoidf_(g[i][j] * r) * y[i][j];
        }
    }
#pragma unroll
    for (int i = 0; i < 4; ++i)
#pragma unroll
        for (int j = 0; j < 4; ++j) MIXED[(size_t)(m0 + ty * 4 + i) * DM + n0 + tx * 4 + j] = f2bf(tot[i][j]);
}
__global__ void __launch_bounds__(256) k_ffn_up(const bf16_t* __restrict__ XB, const bf16_t* __restrict__ WGU_t, const float* __restrict__ R, bf16_t* HDN) {
    __shared__ float As[32 * 65], Bs[32 * 65];
    const int j0 = blockIdx.x * 64, m0 = blockIdx.y * 64, tx = threadIdx.x & 15, ty = threadIdx.x >> 4;
    const int ng = (j0 / 128) * 256 + (j0 % 128), nu = ng + 128;
    float g[4][4]; ZERO_ACC(g);
    tile_gemm(g, XB, DM, WGU_t, DM, DM, m0, ng, As, Bs);
    float u[4][4]; ZERO_ACC(u);
    tile_gemm(u, XB, DM, WGU_t, DM, DM, m0, nu, As, Bs);
#pragma unroll
    for (int i = 0; i < 4; ++i) {
        const int m = m0 + ty * 4 + i; const float r = R[m];
#pragma unroll
        for (int j = 0; j < 4; ++j) HDN[(size_t)m * DFF + j0 + tx * 4 + j] = f2bf(siluf_(g[i][j] * r) * (u[i][j] * r));
    }
}

__global__ void k_gla_gate(const float* __restrict__ G1, const float* __restrict__ w2, const float* __restrict__ bg, float* LA) {
    const int m = blockIdx.x, c = threadIdx.x;
    float s = bg[c];
#pragma unroll
    for (int j = 0; j < 16; ++j) s += G1[m * 16 + j] * w2[j * 256 + c];
    const float ls = fminf(s, 0.f) - log1pf(__expf(-fabsf(s)));
    LA[(size_t)m * 256 + c] = ls * (1.f / 16.f);
}
__global__ void __launch_bounds__(64) k_gla_scan(const bf16_t* __restrict__ PM, const float* __restrict__ LA, bf16_t* MO) {
    __shared__ float qs[64 * 64], ks[64 * 64], as[64 * 64];
    const int bh = blockIdx.x, b = bh >> 2, h = bh & 3, tid = threadIdx.x, col = blockIdx.y * 64 + tid;
    float S[64];
#pragma unroll
    for (int d = 0; d < 64; ++d) S[d] = 0.f;
    for (int c = 0; c < 64; ++c) {
        const size_t row0 = (size_t)b * SEQ + c * 64;
        __syncthreads();
        for (int t = 0; t < 64; ++t) {
            qs[t * 64 + tid] = bf2f(PM[(row0 + t) * NMIX + C_GQ + h * 64 + tid]);
            ks[t * 64 + tid] = bf2f(PM[(row0 + t) * NMIX + C_GK + h * 64 + tid]);
            as[t * 64 + tid] = __expf(LA[(row0 + t) * 256 + h * 64 + tid]);
        }
        __syncthreads();
        for (int t = 0; t < 64; ++t) {
            const float v = bf2f(PM[(row0 + t) * NMIX + C_GV + h * 128 + col]);
            float o = 0.f;
#pragma unroll
            for (int d = 0; d < 64; ++d) { S[d] = as[t * 64 + d] * S[d] + ks[t * 64 + d] * v; o += qs[t * 64 + d] * S[d]; }
            MO[(row0 + t) * KBR + h * 128 + col] = f2bf(o);
        }
    }
}
__global__ void k_gla_post(const bf16_t* __restrict__ PM, const float* __restrict__ norm_w, bf16_t* MO) {
    const int m = blockIdx.x, h = threadIdx.x >> 6, lane = threadIdx.x & 63;
    const unsigned ow = *(const unsigned*)(MO + (size_t)m * KBR + h * 128 + lane * 2);
    const float o0 = bf2f(ow & 0xffffu), o1 = bf2f(ow >> 16);
    const float ss = wave_sum(o0 * o0 + o1 * o1);
    const float rn = rsqrtf(ss * (1.f / 128.f) + EPS);
    const unsigned rw = *(const unsigned*)(PM + (size_t)m * NMIX + C_GR + h * 128 + lane * 2);
    const float y0 = o0 * rn * norm_w[lane * 2] * bf2f(rw & 0xffffu), y1 = o1 * rn * norm_w[lane * 2 + 1] * bf2f(rw >> 16);
    *(unsigned*)(MO + (size_t)m * KBR + h * 128 + lane * 2) = (unsigned)f2bf(y0) | ((unsigned)f2bf(y1) << 16);
}
__global__ void k_pool(const bf16_t* __restrict__ PM, bf16_t* MO) {
    const int m = blockIdx.x, t = m & (SEQ - 1);
    for (int c = threadIdx.x; c < 512; c += 256) {
        const int w = 2 << (c >> 7);
        const int cnt = (t + 1 < w) ? (t + 1) : w;
        float s = 0.f;
        for (int i = 0; i < cnt; ++i) s += bf2f(PM[(size_t)(m - i) * NMIX + C_PU + c]);
        const float u = bf2f(PM[(size_t)m * NMIX + C_PU + c]);
        MO[(size_t)m * KBR + 512 + c] = f2bf(s / (float)cnt - u);
    }
}
__global__ void k_kmean(const bf16_t* __restrict__ PM, float* KM) {
    const int bn = blockIdx.x, b = bn >> 4, n = bn & 15, h = blockIdx.y, d = threadIdx.x;
    float s = 0.f;
    for (int i = 0; i < 256; ++i) s += bf2f(PM[((size_t)b * SEQ + n * 256 + i) * NMIX + C_MK + h * 64 + d]);
    KM[(((size_t)b * 8 + h) * 16 + n) * 64 + d] = s * (1.f / 256.f);
}
__global__ void __launch_bounds__(64) k_moba(const bf16_t* __restrict__ PM, const float* __restrict__ KM, bf16_t* MO) {
    __shared__ float Ks[64 * 64], Vs[64 * 64];
    const int tid = threadIdx.x, m = blockIdx.x * 64 + tid, b = m >> 12, t = m & (SEQ - 1), j = t >> 8, h = blockIdx.y;
    const float slope = exp2f(-(float)(h + 1));
    float q[64];
#pragma unroll
    for (int d = 0; d < 64; d += 2) { const unsigned w = *(const unsigned*)(PM + (size_t)m * NMIX + C_MQ + h * 64 + d); q[d] = bf2f(w & 0xffffu); q[d + 1] = bf2f(w >> 16); }
    float b0 = -3e38f, b1 = -3e38f, b2 = -3e38f; int i0 = -1, i1 = -1, i2 = -1;
    for (int n = 0; n < j; ++n) {
        const float* km = KM + (((size_t)b * 8 + h) * 16 + n) * 64;
        float g = 0.f;
#pragma unroll
        for (int d = 0; d < 64; ++d) g += q[d] * km[d];
        if (g > b0) { b2 = b1; i2 = i1; b1 = b0; i1 = i0; b0 = g; i0 = n; }
        else if (g > b1) { b2 = b1; i2 = i1; b1 = g; i1 = n; }
        else if (g > b2) { b2 = g; i2 = n; }
    }
    unsigned sel = 0u;
    if (i0 >= 0) sel |= 1u << i0;
    if (i1 >= 0) sel |= 1u << i1;
    if (i2 >= 0) sel |= 1u << i2;
    sel |= 1u << j;
    float mrun = -1e30f, l = 0.f, o[64];
#pragma unroll
    for (int d = 0; d < 64; ++d) o[d] = 0.f;
    for (int n = 0; n <= j; ++n) {
        const bool mine = (sel >> n) & 1u;
        for (int kt = 0; kt < 4; ++kt) {
            const size_t row0 = (size_t)b * SEQ + n * 256 + kt * 64;
            __syncthreads();
            for (int s = 0; s < 64; ++s) {
                Ks[s * 64 + tid] = bf2f(PM[(row0 + s) * NMIX + C_MK + h * 64 + tid]);
                Vs[s * 64 + tid] = bf2f(PM[(row0 + s) * NMIX + C_MV + h * 64 + tid]);
            }
            __syncthreads();
            if (mine) {
                for (int s = 0; s < 64; ++s) {
                    const int pos = n * 256 + kt * 64 + s;
                    if (pos > t) break;
                    float sc = 0.f;
#pragma unroll
                    for (int d = 0; d < 64; ++d) sc += q[d] * Ks[s * 64 + d];
                    sc -= slope * (float)(t - pos);
                    if (sc > mrun) {
                        const float corr = __expf(mrun - sc);
                        l *= corr;
#pragma unroll
                        for (int d = 0; d < 64; ++d) o[d] *= corr;
                        mrun = sc;
                    }
                    const float p = __expf(sc - mrun);
                    l += p;
#pragma unroll
                    for (int d = 0; d < 64; ++d) o[d] += p * Vs[s * 64 + d];
                }
            }
        }
    }
    const float il = 1.f / l;
#pragma unroll
    for (int d = 0; d < 64; d += 2) *(unsigned*)(MO + (size_t)m * KBR + 1024 + h * 64 + d) = (unsigned)f2bf(o[d] * il) | ((unsigned)f2bf(o[d + 1] * il) << 16);
}

extern "C" void kernel_launch(void* const* d_in, const int* in_sizes, int n_in, void* d_out, int out_size, void* d_ws, size_t ws_size, hipStream_t stream) {
    if (n_in != 18 || ws_size < WS_END || out_size != M * DM) { fprintf(stderr, "kernel_launch: unexpected shapes n_in %d ws %zu out %d\n", n_in, ws_size, out_size); return; }
    const float* x = (const float*)d_in[0];
    const float* norm_mix_pre = (const float*)d_in[1];
    const float* w_in = (const float*)d_in[2];
    const float* gla_w_g2 = (const float*)d_in[3];
    const float* gla_b_g = (const float*)d_in[4];
    const float* gla_norm = (const float*)d_in[5];
    const float* pool_w = (const float*)d_in[6];
    const float* pool_scale = (const float*)d_in[7];
    const float* w_br_a = (const float*)d_in[8];
    const float* w_br_b = (const float*)d_in[9];
    const float* w_br_c = (const float*)d_in[10];
    const float* w_out = (const float*)d_in[11];
    const float* norm_mix_post = (const float*)d_in[12];
    const float* norm_ffn_pre = (const float*)d_in[13];
    const float* ffn_w_gate = (const float*)d_in[14];
    const float* ffn_w_up = (const float*)d_in[15];
    const float* ffn_w_down = (const float*)d_in[16];
    const float* norm_ffn_post = (const float*)d_in[17];
    unsigned char* ws = (unsigned char*)d_ws;
    float* out = (float*)d_out;
    float* R = (float*)(ws + WS_R); float* G1 = (float*)(ws + WS_G1); float* KM = (float*)(ws + WS_KM); float* WG1f = (float*)(ws + WS_WG1);
    bf16_t* XB = (bf16_t*)(ws + WS_XB); bf16_t* PM = (bf16_t*)(ws + WS_PM); bf16_t* MO = (bf16_t*)(ws + WS_MO);
    float* LA = (float*)(ws + WS_SP);
    bf16_t* MIXED = (bf16_t*)(ws + WS_MIXED); bf16_t* F1 = (bf16_t*)(ws + WS_F1); bf16_t* HDN = (bf16_t*)(ws + WS_HDN); bf16_t* F2 = (bf16_t*)(ws + WS_F2);

    for (int l = 0; l < DEPTH; ++l) {
        unsigned char* wl = ws + WS_W + l * W_LAYER;
        bf16_t* WIN_t = (bf16_t*)(wl + W_IN); bf16_t* WGATE_t = (bf16_t*)(wl + W_GATE); bf16_t* WBR_t = (bf16_t*)(wl + W_BR);
        bf16_t* WOUT_t = (bf16_t*)(wl + W_OUT); bf16_t* WGU_t = (bf16_t*)(wl + W_GU); bf16_t* WDN_t = (bf16_t*)(wl + W_DN);
        const float* win = w_in + (size_t)l * DM * DIN; const float* gpre = norm_mix_pre + l * DM; const float* gffn = norm_ffn_pre + l * DM;
        struct Seg { int dst, src, n; };
        const Seg segs[8] = {{C_MQ, O_MQ, 512}, {C_MK, O_MK, 512}, {C_MV, O_MV, 512}, {C_GQ, O_GQ, 256}, {C_GK, O_GK, 256}, {C_GV, O_GV, 512}, {C_GR, O_GR, 512}, {C_PU, O_PU, 512}};
        for (int s = 0; s < 8; ++s)
            k_prep_transpose<<<dim3(segs[s].n / 32, DM / 32), 256, 0, stream>>>(win, DIN, segs[s].src, gpre, WIN_t + (size_t)segs[s].dst * DM, DM, 1 << 30, 0);
        k_prep_transpose<<<dim3(NGATE / 32, DM / 32), 256, 0, stream>>>(win, DIN, O_GATE, gpre, WGATE_t, DM, 1 << 30, 0);
        k_prep_g1<<<64, 256, 0, stream>>>(win, gpre, WG1f + l * 16 * DM);
        k_prep_transpose<<<dim3(1024 / 32, 512 / 32), 256, 0, stream>>>(w_br_a + (size_t)l * 512 * 1024, 1024, 0, nullptr, WBR_t, KBR, 1 << 30, 0);
        k_prep_poolfold<<<dim3(4, 512), 256, 0, stream>>>(pool_w + (size_t)l * 4 * 128 * 128, pool_scale + l * 512, w_br_b + (size_t)l * 512 * 1024, WBR_t);
        k_prep_transpose<<<dim3(1024 / 32, 512 / 32), 256, 0, stream>>>(w_br_c + (size_t)l * 512 * 1024, 1024, 0, nullptr, WBR_t + 1024, KBR, 1 << 30, 0);
        k_prep_transpose<<<dim3(1024 / 32, 1024 / 32), 256, 0, stream>>>(w_out + (size_t)l * 1024 * 1024, 1024, 0, nullptr, WOUT_t, DM, 1 << 30, 0);
        k_prep_transpose<<<dim3(DFF / 32, DM / 32), 256, 0, stream>>>(ffn_w_gate + (size_t)l * DM * DFF, DFF, 0, gffn, WGU_t, DM, 128, 256);
        k_prep_transpose<<<dim3(DFF / 32, DM / 32), 256, 0, stream>>>(ffn_w_up + (size_t)l * DM * DFF, DFF, 0, gffn, WGU_t + (size_t)128 * DM, DM, 128, 256);
        k_prep_transpose<<<dim3(1024 / 32, DFF / 32), 256, 0, stream>>>(ffn_w_down + (size_t)l * DFF * DM, DM, 0, nullptr, WDN_t, DFF, 1 << 30, 0);
    }
    k_rows<<<M, 256, 0, stream>>>(x, nullptr, nullptr, nullptr, XB, R, G1, WG1f);
    for (int l = 0; l < DEPTH; ++l) {
        unsigned char* wl = ws + WS_W + l * W_LAYER;
        const bf16_t* WIN_t = (const bf16_t*)(wl + W_IN); const bf16_t* WGATE_t = (const bf16_t*)(wl + W_GATE); const bf16_t* WBR_t = (const bf16_t*)(wl + W_BR);
        const bf16_t* WOUT_t = (const bf16_t*)(wl + W_OUT); const bf16_t* WGU_t = (const bf16_t*)(wl + W_GU); const bf16_t* WDN_t = (const bf16_t*)(wl + W_DN);
        const float* xsrc = (l == 0) ? x : out;
        k_inproj<<<dim3(NMIX / 64, M / 64), 256, 0, stream>>>(XB, WIN_t, R, PM);
        k_gla_gate<<<M, 256, 0, stream>>>(G1, gla_w_g2 + l * 16 * 256, gla_b_g + l * 256, LA);
        k_gla_scan<<<dim3(BATCH * 4, 2), 64, 0, stream>>>(PM, LA, MO);
        k_gla_post<<<M, 256, 0, stream>>>(PM, gla_norm + l * 128, MO);
        k_pool<<<M, 256, 0, stream>>>(PM, MO);
        k_kmean<<<dim3(BATCH * 16, 8), 64, 0, stream>>>(PM, KM);
        k_moba<<<dim3(M / 64, 8), 64, 0, stream>>>(PM, KM, MO);
        k_mix<<<dim3(1024 / 64, M / 64), 256, 0, stream>>>(XB, WGATE_t, R, MO, WBR_t, MIXED);
        k_gemm_bf16<<<dim3(1024 / 64, M / 64), 256, 0, stream>>>(MIXED, DM, WOUT_t, DM, DM, F1, DM);
        k_rows<<<M, 256, 0, stream>>>(xsrc, F1, norm_mix_post + l * DM, out, XB, R, nullptr, nullptr);
        k_ffn_up<<<dim3(DFF / 64, M / 64), 256, 0, stream>>>(XB, WGU_t, R, HDN);
        k_gemm_bf16<<<dim3(1024 / 64, M / 64), 256, 0, stream>>>(HDN, DFF, WDN_t, DFF, DFF, F2, DM);
        const bool last = (l == DEPTH - 1);
        k_rows<<<M, 256, 0, stream>>>(out, F2, norm_ffn_post + l * DM, out, last ? nullptr : XB, last ? nullptr : R, last ? nullptr : G1, last ? nullptr : WG1f + (l + 1) * 16 * DM);
    }
}
```

```cpp
#include <hip/hip_runtime.h>
#include <stdint.h>
#include <cstdio>

constexpr int BATCH = 8, SEQ = 4096, DM = 1024, M = BATCH * SEQ, DEPTH = 2;
constexpr int DIN = 6672, NMIX = 3584, NGATE = 3072, DFF = 2816, KBR = 1536;
constexpr int C_MQ = 0, C_MK = 512, C_MV = 1024, C_GQ = 1536, C_GK = 1792, C_GV = 2048, C_GR = 2560, C_PU = 3072;
constexpr int O_GQ = 0, O_GK = 256, O_GV = 512, O_G1 = 1024, O_GR = 1040, O_PU = 1552, O_MQ = 2064, O_MK = 2576, O_MV = 3088, O_GATE = 3600;
constexpr float EPS = 1e-6f;

constexpr size_t MiB = 1u << 20;
constexpr size_t WS_CTL = 0, CTL_ZERO_BYTES = 1 * MiB;
constexpr size_t WS_R = 1 * MiB;
constexpr size_t WS_G1 = 2 * MiB;
constexpr size_t WS_KM = 4 * MiB;
constexpr size_t WS_W = 6 * MiB, W_LAYER = 35 * MiB;
constexpr size_t W_IN = 0, W_GATE = 7 * MiB, W_BR = 13 * MiB, W_OUT = 16 * MiB, W_GU = 18 * MiB, W_DN = 29 * MiB;
constexpr size_t WS_XB = 76 * MiB;
constexpr size_t WS_PM = 140 * MiB;
constexpr size_t WS_MO = 364 * MiB;
constexpr size_t WS_SP = 460 * MiB;
constexpr size_t WS_GATES = WS_PM;
constexpr size_t WS_MIXED = WS_XB;
constexpr size_t WS_F1 = WS_MO;
constexpr size_t WS_HDN = WS_PM;
constexpr size_t WS_F2 = WS_MO;
constexpr size_t WS_END = 512 * MiB;

typedef unsigned short bf16_t;
namespace pg8 {
#define PG8_LAS __attribute__((address_space(3)))
typedef unsigned short bf16_t;
typedef short bf16x8 __attribute__((ext_vector_type(8)));
typedef float f32x4 __attribute__((ext_vector_type(4)));
typedef unsigned u32x4 __attribute__((ext_vector_type(4)));
constexpr int BM = 256, BK = 64, HALF = 128, HTB = HALF * BK * 2  , STAGE_BYTES = 8 * HTB, NXCD = 8, WGM = 8;

__host__ __device__ __forceinline__ int lds_byte(int r, int c) { const int st = (r >> 4) * 2 + (c >> 5), rr = r & 15, cc = c & 31, ob = rr * 64 + cc * 2; return st * 1024 + (ob ^ (((ob >> 9) & 1) << 5)); }
__host__ __device__ __forceinline__ void stage_rc(int b, int& R, int& C) { const int st = b / 1024, sb = b % 1024, swz = sb ^ (((sb >> 9) & 1) << 5); R = (st >> 1) * 16 + swz / 64; C = (st & 1) * 32 + (swz % 64) / 2; }
__host__ __device__ __forceinline__ int perm32(int rho) { const int n = rho >> 4, i = rho & 15; return 8 * (i >> 2) + 4 * n + (i & 3); }

struct Unit { int pm, pn, ks; };
struct Gemm { const bf16_t* A; const bf16_t* Bt; int M, N, K, Kt, ksb; };

struct StaticOrder {
    int nM, nN, nwg, G, c;
    __host__ __device__ void init(int M, int N, int G_, int c_) { nM = M / BM; nN = N / BM; nwg = nM * nN; G = G_; c = c_; }
    __host__ __device__ bool next(int i, Unit& u) const {
        const long L = (long)i * G + c; if (L >= nwg) return false;
        int wgid = (int)L; { const int q = nwg / NXCD, r = nwg % NXCD, xcd = wgid % NXCD, off = wgid / NXCD; wgid = (xcd < r ? xcd * (q + 1) : r * (q + 1) + (xcd - r) * q) + off; }
        const int nig = WGM * nN, gid = wgid / nig, fm = gid * WGM, gsz = (nM - fm) < WGM ? (nM - fm) : WGM;
        u.pm = fm + ((wgid % nig) % gsz); u.pn = (wgid % nig) / gsz; u.ks = 0; return true;
    }
    __device__ __forceinline__ void a_ready(const Unit&) const {}
    __device__ __forceinline__ void done(const Unit&) const {}
};

__device__ __forceinline__ unsigned cvt_pk_bf16(float lo, float hi) { unsigned r; asm volatile("v_cvt_pk_bf16_f32 %0, %1, %2" : "=v"(r) : "v"(lo), "v"(hi)); return r; }
struct SegOrder3 {
    StaticOrder S;
    __device__ __forceinline__ bool next(int i, Unit& u) const { const int q = i / 3; if (!S.next(q, u)) return false; u.ks = i - 3 * q; return true; }
    __device__ __forceinline__ void a_ready(const Unit&) const {}
    __device__ __forceinline__ void done(const Unit&) const {}
};
__device__ __forceinline__ float fast_sigmoid(float x) { return __builtin_amdgcn_rcpf(1.f + __expf(-x)); }
__device__ __forceinline__ float bflo(unsigned w) { return __uint_as_float(w << 16); }
__device__ __forceinline__ float bfhi(unsigned w) { return __uint_as_float(w & 0xffff0000u); }
struct EpiProj {
    static constexpr bool PERM = true, AFTER_DRAIN = false, SEGS = false;
    bf16_t* O; const float* R;
    __device__ __forceinline__ void operator()(const f32x4 (&acc)[2][2][4][2], const Unit& u, int wr, int wc, int fr, int fq) const {
        const int pn = u.pn; const float cs = (pn < 2 || pn == 6) ? 0.125f : 1.f; const bool silu = (pn == 10 || pn == 11);
        const int row0 = u.pm * BM + wr * 64 + fr, col0 = pn * BM + wc * 32 + 8 * fq;
#pragma unroll
        for (int ai = 0; ai < 2; ++ai)
#pragma unroll
            for (int m = 0; m < 4; ++m) { const int row = row0 + ai * HALF + m * 16; const float r = R[row] * cs; bf16_t* rowp = O + (size_t)row * 3584 + col0;
#pragma unroll
                for (int bj = 0; bj < 2; ++bj) { f32x4 v0 = acc[ai][bj][m][0] * r, v1 = acc[ai][bj][m][1] * r;
                    if (silu) {
#pragma unroll
                        for (int i = 0; i < 4; ++i) { v0[i] = v0[i] * fast_sigmoid(v0[i]); v1[i] = v1[i] * fast_sigmoid(v1[i]); } }
                    u32x4 w; w.x = cvt_pk_bf16(v0[0], v0[1]); w.y = cvt_pk_bf16(v0[2], v0[3]); w.z = cvt_pk_bf16(v1[0], v1[1]); w.w = cvt_pk_bf16(v1[2], v1[3]);
                    *(u32x4*)(rowp + bj * HALF) = w; } }
    }
};
struct EpiSig {
    static constexpr bool PERM = true, AFTER_DRAIN = false, SEGS = false;
    bf16_t* O; const float* R;
    __device__ __forceinline__ void operator()(const f32x4 (&acc)[2][2][4][2], const Unit& u, int wr, int wc, int fr, int fq) const {
        const int row0 = u.pm * BM + wr * 64 + fr, col0 = u.pn * BM + wc * 32 + 8 * fq;
#pragma unroll
        for (int ai = 0; ai < 2; ++ai)
#pragma unroll
            for (int m = 0; m < 4; ++m) { const int row = row0 + ai * HALF + m * 16; const float r = R[row]; bf16_t* rowp = O + (size_t)row * 3072 + col0;
#pragma unroll
                for (int bj = 0; bj < 2; ++bj) { f32x4 v0 = acc[ai][bj][m][0] * r, v1 = acc[ai][bj][m][1] * r;
#pragma unroll
                    for (int i = 0; i < 4; ++i) { v0[i] = fmaxf(fast_sigmoid(v0[i]), 1e-18f); v1[i] = fmaxf(fast_sigmoid(v1[i]), 1e-18f); }
                    u32x4 w; w.x = cvt_pk_bf16(v0[0], v0[1]); w.y = cvt_pk_bf16(v0[2], v0[3]); w.z = cvt_pk_bf16(v1[0], v1[1]); w.w = cvt_pk_bf16(v1[2], v1[3]);
                    *(u32x4*)(rowp + bj * HALF) = w; } }
    }
};
struct EpiPlain {
    static constexpr bool PERM = true, AFTER_DRAIN = false, SEGS = false;
    bf16_t* O;
    __device__ __forceinline__ void operator()(const f32x4 (&acc)[2][2][4][2], const Unit& u, int wr, int wc, int fr, int fq) const {
        const int row0 = u.pm * BM + wr * 64 + fr, col0 = u.pn * BM + wc * 32 + 8 * fq;
#pragma unroll
        for (int ai = 0; ai < 2; ++ai)
#pragma unroll
            for (int m = 0; m < 4; ++m) { bf16_t* rowp = O + (size_t)(row0 + ai * HALF + m * 16) * 1024 + col0;
#pragma unroll
                for (int bj = 0; bj < 2; ++bj) { const f32x4 v0 = acc[ai][bj][m][0], v1 = acc[ai][bj][m][1];
                    u32x4 w; w.x = cvt_pk_bf16(v0[0], v0[1]); w.y = cvt_pk_bf16(v0[2], v0[3]); w.z = cvt_pk_bf16(v1[0], v1[1]); w.w = cvt_pk_bf16(v1[2], v1[3]);
                    *(u32x4*)(rowp + bj * HALF) = w; } }
    }
};
struct EpiSwiglu {
    static constexpr bool PERM = true, AFTER_DRAIN = false, SEGS = false;
    bf16_t* O; const float* R;
    __device__ __forceinline__ void operator()(const f32x4 (&acc)[2][2][4][2], const Unit& u, int wr, int wc, int fr, int fq) const {
        const int row0 = u.pm * BM + wr * 64 + fr, col0 = u.pn * HALF + wc * 32 + 8 * fq;
#pragma unroll
        for (int ai = 0; ai < 2; ++ai)
#pragma unroll
            for (int m = 0; m < 4; ++m) { const int row = row0 + ai * HALF + m * 16; const float r = R[row];
                f32x4 h0, h1;
#pragma unroll
                for (int i = 0; i < 4; ++i) { const float g0 = acc[ai][0][m][0][i] * r, g1 = acc[ai][0][m][1][i] * r;
                    h0[i] = g0 * fast_sigmoid(g0) * (acc[ai][1][m][0][i] * r); h1[i] = g1 * fast_sigmoid(g1) * (acc[ai][1][m][1][i] * r); }
                u32x4 w; w.x = cvt_pk_bf16(h0[0], h0[1]); w.y = cvt_pk_bf16(h0[2], h0[3]); w.z = cvt_pk_bf16(h1[0], h1[1]); w.w = cvt_pk_bf16(h1[2], h1[3]);
                *(u32x4*)(O + (size_t)row * 2816 + col0) = w; }
    }
};
struct EpiMixed {
    static constexpr bool PERM = true, AFTER_DRAIN = false, SEGS = true;
    bf16_t* O; const bf16_t* G;
    __device__ __forceinline__ void operator()(f32x4 (&acc)[2][2][4][2], const Unit& u, int wr, int wc, int fr, int fq) const {
        const int row0 = u.pm * BM + wr * 64 + fr, col0 = u.pn * BM + wc * 32 + 8 * fq;
        if (u.ks < 2) {
            const char* gb = (const char*)G + (size_t)u.ks * 2048;
#pragma unroll
            for (int ai = 0; ai < 2; ++ai)
#pragma unroll
                for (int m = 0; m < 4; ++m) { const unsigned off = ((unsigned)(row0 + ai * HALF + m * 16) * 3072u + (unsigned)col0) * 2u;
#pragma unroll
                    for (int bj = 0; bj < 2; ++bj) { const u32x4 a = *(const u32x4*)(gb + off + bj * 256), b = *(const u32x4*)(gb + off + 2048 + bj * 256);
                        f32x4 r0, r1;
                        r0[0] = bflo(a.x) * __builtin_amdgcn_rcpf(bflo(b.x)); r0[1] = bfhi(a.x) * __builtin_amdgcn_rcpf(bfhi(b.x));
                        r0[2] = bflo(a.y) * __builtin_amdgcn_rcpf(bflo(b.y)); r0[3] = bfhi(a.y) * __builtin_amdgcn_rcpf(bfhi(b.y));
                        r1[0] = bflo(a.z) * __builtin_amdgcn_rcpf(bflo(b.z)); r1[1] = bfhi(a.z) * __builtin_amdgcn_rcpf(bfhi(b.z));
                        r1[2] = bflo(a.w) * __builtin_amdgcn_rcpf(bflo(b.w)); r1[3] = bfhi(a.w) * __builtin_amdgcn_rcpf(bfhi(b.w));
                        acc[ai][bj][m][0] *= r0; acc[ai][bj][m][1] *= r1; }
                    asm volatile("" ::: "memory"); }
        } else {
#pragma unroll
            for (int ai = 0; ai < 2; ++ai)
#pragma unroll
                for (int m = 0; m < 4; ++m) { const int row = row0 + ai * HALF + m * 16; const bf16_t* gp = G + (size_t)row * 3072 + 2048 + col0; bf16_t* rowp = O + (size_t)row * 1024 + col0;
#pragma unroll
                    for (int bj = 0; bj < 2; ++bj) { const u32x4 a = *(const u32x4*)(gp + bj * HALF); const f32x4 v0 = acc[ai][bj][m][0], v1 = acc[ai][bj][m][1];
                        u32x4 w; w.x = cvt_pk_bf16(v0[0] * bflo(a.x), v0[1] * bfhi(a.x)); w.y = cvt_pk_bf16(v0[2] * bflo(a.y), v0[3] * bfhi(a.y));
                        w.z = cvt_pk_bf16(v1[0] * bflo(a.z), v1[1] * bfhi(a.z)); w.w = cvt_pk_bf16(v1[2] * bflo(a.w), v1[3] * bfhi(a.w));
                        *(u32x4*)(rowp + bj * HALF) = w; }
                    asm volatile("" ::: "memory"); }
        }
    }
};

template <class Epi, class Sched, bool ALIGN_EPI = false, bool SP2 = false>
__device__ __forceinline__ void gemm_phase(PG8_LAS unsigned char* lds, const Gemm g, const Sched& S, const Epi& E) {
    int tid_ = threadIdx.x; asm volatile("" : "+v"(tid_));
    const int tid = tid_, wid = __builtin_amdgcn_readfirstlane(tid >> 6), lane = tid & 63, wr = wid >> 2, wc = wid & 3, fr = lane & 15, fq = lane >> 4;
    const int K = g.K, nt = g.Kt / BK;
    unsigned voffA[2], voffB[2];
#pragma unroll
    for (int i = 0; i < 2; ++i) { int R, C; stage_rc(tid * 16 + i * 8192, R, C); const int Rb = Epi::PERM ? ((R & ~31) + perm32(R & 31)) : R;
        voffA[i] = (unsigned)(R * K + C) * 2u; voffB[i] = (unsigned)(Rb * K + C) * 2u; }
    const size_t kstep = (size_t)(BK * 2);
    const size_t hstep = (size_t)HALF * K * 2;
    const size_t tstep = 2 * hstep;
    const unsigned ldsw = (unsigned)wid * 1024u;
    const int aoff = lds_byte(wr * 64 + fr, fq * 8), boff = lds_byte(wc * 32 + fr, fq * 8);
#define PG8_SA(b, h) (((b) * 2 + (h)) * HTB)
#define PG8_SB(b, h) ((4 + (b) * 2 + (h)) * HTB)
#define PG8_STAGE(bufoff, gbase, voff) do { _Pragma("unroll") for (int _i = 0; _i < 2; ++_i) \
        __builtin_amdgcn_global_load_lds((const unsigned*)((const char*)(gbase) + (voff)[_i]), (PG8_LAS unsigned*)(lds + (bufoff) + ldsw + _i * 8192), 16, 0, 0); } while (0)
#define PG8_LDA(dst, b, h) do { _Pragma("unroll") for (int m = 0; m < 4; ++m) _Pragma("unroll") for (int k = 0; k < 2; ++k) dst[m][k] = *(const PG8_LAS bf16x8*)(lds + PG8_SA(b, h) + aoff + m * 2048 + k * 1024); } while (0)
#define PG8_LDB(dst, b, h) do { _Pragma("unroll") for (int n = 0; n < 2; ++n) _Pragma("unroll") for (int k = 0; k < 2; ++k) dst[n][k] = *(const PG8_LAS bf16x8*)(lds + PG8_SB(b, h) + boff + n * 2048 + k * 1024); } while (0)
#define PG8_MMA(ai, bj, At, Bt) do { __builtin_amdgcn_s_setprio(1); _Pragma("unroll") for (int m = 0; m < 4; ++m) _Pragma("unroll") for (int n = 0; n < 2; ++n) _Pragma("unroll") for (int k = 0; k < 2; ++k) \
        acc[ai][bj][m][n] = __builtin_amdgcn_mfma_f32_16x16x32_bf16(Bt[n][k], At[m][k], acc[ai][bj][m][n], 0, 0, 0); __builtin_amdgcn_s_setprio(0); } while (0)
#define PG8_WAIT_V(n) asm volatile("s_waitcnt vmcnt(" #n ")" ::: "memory")
#define PG8_WAIT_L(n) asm volatile("s_waitcnt lgkmcnt(" #n ")" ::: "memory")
#define PG8_BAR __builtin_amdgcn_s_barrier()
#define PG8_SCHED __builtin_amdgcn_sched_barrier(0)
    Unit cur, nxt; int ui = 0;
    if (!S.next(0, cur)) return;
    f32x4 acc[2][2][4][2];
#pragma unroll
    for (int a = 0; a < 2; ++a)
#pragma unroll
        for (int b = 0; b < 2; ++b)
#pragma unroll
            for (int m = 0; m < 4; ++m)
#pragma unroll
                for (int n = 0; n < 2; ++n) acc[a][b][m][n] = (f32x4){0.f, 0.f, 0.f, 0.f};
    bf16x8 At[4][2], B0[2][2], B1[2][2];
    const char* cA = (const char*)g.A + (size_t)cur.pm * tstep + (size_t)cur.ks * g.ksb; const char* cB = (const char*)g.Bt + (size_t)cur.pn * tstep + (size_t)cur.ks * g.ksb;
    S.a_ready(cur);
    if constexpr (SP2) {
        PG8_STAGE(PG8_SB(0, 0), cB, voffB); PG8_STAGE(PG8_SB(0, 1), cB + hstep, voffB); PG8_STAGE(PG8_SA(0, 0), cA, voffA); PG8_STAGE(PG8_SA(0, 1), cA + hstep, voffA);
        if (wr == 1) PG8_BAR;
        PG8_WAIT_V(2); PG8_BAR;
        PG8_STAGE(PG8_SB(1, 0), cB + kstep, voffB); PG8_STAGE(PG8_SA(1, 0), cA + kstep, voffA); PG8_STAGE(PG8_SB(1, 1), cB + hstep + kstep, voffB);
        PG8_WAIT_V(6); PG8_BAR;
    } else {
        PG8_STAGE(PG8_SB(0, 0), cB, voffB); PG8_STAGE(PG8_SA(0, 0), cA, voffA); PG8_STAGE(PG8_SB(0, 1), cB + hstep, voffB); PG8_STAGE(PG8_SA(0, 1), cA + hstep, voffA);
        if (wr == 1) PG8_BAR;
        PG8_WAIT_V(4); PG8_BAR;
        PG8_STAGE(PG8_SB(1, 0), cB + kstep, voffB); PG8_STAGE(PG8_SA(1, 0), cA + kstep, voffA); PG8_STAGE(PG8_SB(1, 1), cB + hstep + kstep, voffB);
        PG8_WAIT_V(6); PG8_BAR;
    }
    for (;;) {
        const bool has_next = S.next(ui + 1, nxt);
        const char* nA = has_next ? (const char*)g.A + (size_t)nxt.pm * tstep + (size_t)nxt.ks * g.ksb : cA; const char* nB = has_next ? (const char*)g.Bt + (size_t)nxt.pn * tstep + (size_t)nxt.ks * g.ksb : cB;
        for (int t = 0; t < nt; t += 2) {
            const bool last = (t == nt - 2);
            const char* a1 = cA + (size_t)(t + 1) * kstep;
            const char* a2 = last ? nA : cA + (size_t)(t + 2) * kstep; const char* b2 = last ? nB : cB + (size_t)(t + 2) * kstep;
            const char* a3 = a2 + kstep; const char* b3 = b2 + kstep;
            if (last && has_next) S.a_ready(nxt);
            if constexpr (SP2) {
            PG8_LDB(B0, 0, 0); PG8_LDB(B1, 0, 1); PG8_SCHED; PG8_LDA(At, 0, 0); PG8_STAGE(PG8_SA(1, 1), a1 + hstep, voffA);
            PG8_WAIT_V(8); PG8_WAIT_L(0); PG8_BAR; PG8_MMA(0, 0, At, B0); PG8_MMA(0, 1, At, B1); PG8_BAR; PG8_SCHED;
            PG8_LDA(At, 0, 1); PG8_STAGE(PG8_SB(0, 0), b2, voffB); PG8_STAGE(PG8_SB(0, 1), b2 + hstep, voffB); PG8_STAGE(PG8_SA(0, 0), a2, voffA);
            PG8_WAIT_V(8); PG8_WAIT_L(0); PG8_BAR; PG8_MMA(1, 0, At, B0); PG8_MMA(1, 1, At, B1); PG8_BAR; PG8_SCHED;
            PG8_LDB(B0, 1, 0); PG8_LDB(B1, 1, 1); PG8_SCHED; PG8_LDA(At, 1, 0); PG8_STAGE(PG8_SA(0, 1), a2 + hstep, voffA);
            PG8_WAIT_V(8); PG8_WAIT_L(0); PG8_BAR; PG8_MMA(0, 0, At, B0); PG8_MMA(0, 1, At, B1); PG8_BAR; PG8_SCHED;
            PG8_LDA(At, 1, 1); PG8_STAGE(PG8_SB(1, 0), b3, voffB); PG8_STAGE(PG8_SB(1, 1), b3 + hstep, voffB); PG8_STAGE(PG8_SA(1, 0), a3, voffA);
            PG8_WAIT_V(8); PG8_WAIT_L(0); PG8_BAR; PG8_MMA(1, 0, At, B0); PG8_MMA(1, 1, At, B1); PG8_BAR; PG8_SCHED;
            } else {
            PG8_LDB(B0, 0, 0); PG8_SCHED; PG8_LDA(At, 0, 0); PG8_STAGE(PG8_SA(1, 1), a1 + hstep, voffA);
            PG8_WAIT_L(8); PG8_BAR; PG8_WAIT_L(0); PG8_MMA(0, 0, At, B0); PG8_BAR; PG8_SCHED;
            PG8_LDB(B1, 0, 1); PG8_STAGE(PG8_SB(0, 0), b2, voffB);
            PG8_BAR; PG8_WAIT_L(0); PG8_MMA(0, 1, At, B1); PG8_BAR;
            PG8_LDA(At, 0, 1); PG8_STAGE(PG8_SA(0, 0), a2, voffA);
            PG8_BAR; PG8_WAIT_L(0); PG8_MMA(1, 0, At, B0); PG8_BAR; PG8_SCHED;
            PG8_STAGE(PG8_SB(0, 1), b2 + hstep, voffB);
            PG8_WAIT_V(6); PG8_BAR; PG8_MMA(1, 1, At, B1); PG8_BAR;
            PG8_LDB(B0, 1, 0); PG8_SCHED; PG8_LDA(At, 1, 0); PG8_STAGE(PG8_SA(0, 1), a2 + hstep, voffA);
            PG8_WAIT_L(8); PG8_BAR; PG8_WAIT_L(0); PG8_MMA(0, 0, At, B0); PG8_BAR; PG8_SCHED;
            PG8_LDB(B1, 1, 1); PG8_STAGE(PG8_SB(1, 0), b3, voffB);
            PG8_BAR; PG8_WAIT_L(0); PG8_MMA(0, 1, At, B1); PG8_BAR;
            PG8_LDA(At, 1, 1); PG8_STAGE(PG8_SA(1, 0), a3, voffA);
            PG8_BAR; PG8_WAIT_L(0); PG8_MMA(1, 0, At, B0); PG8_BAR; PG8_SCHED;
            PG8_STAGE(PG8_SB(1, 1), b3 + hstep, voffB);
            PG8_WAIT_V(6); PG8_BAR; PG8_MMA(1, 1, At, B1); PG8_BAR;
            }
        }
        if constexpr (ALIGN_EPI) { if (wr == 0) PG8_BAR; }
        if constexpr (!Epi::AFTER_DRAIN) { E(acc, cur, wr, wc, fr, fq); S.done(cur); }
        if (!has_next) break;
        if (!(Epi::SEGS && cur.ks < 2)) {
#pragma unroll
        for (int a = 0; a < 2; ++a)
#pragma unroll
            for (int b = 0; b < 2; ++b)
#pragma unroll
                for (int m = 0; m < 4; ++m)
#pragma unroll
                    for (int n = 0; n < 2; ++n) acc[a][b][m][n] = (f32x4){0.f, 0.f, 0.f, 0.f};
        }
        cur = nxt; cA = nA; cB = nB; ++ui;
        if constexpr (ALIGN_EPI) { if (wr == 1) PG8_BAR; }
    }
    PG8_WAIT_V(0);
    if constexpr (!ALIGN_EPI) { if (wr == 0) PG8_BAR; }
    PG8_BAR;
    if constexpr (Epi::AFTER_DRAIN) { E.fused(acc, cur, wr, wc, fr, fq, lds, wid, lane); S.done(cur); }
#undef PG8_SA
#undef PG8_SB
#undef PG8_STAGE
#undef PG8_LDA
#undef PG8_LDB
#undef PG8_MMA
#undef PG8_WAIT_V
#undef PG8_WAIT_L
#undef PG8_BAR
#undef PG8_SCHED
}
}

#define GAS __attribute__((address_space(1)))
#define LAS __attribute__((address_space(3)))
typedef unsigned short bf16;
typedef unsigned v4u __attribute__((ext_vector_type(4)));
typedef float f32x4 __attribute__((ext_vector_type(4)));
typedef short bf16x8 __attribute__((ext_vector_type(8)));
typedef GAS unsigned gu32;
typedef GAS unsigned long long gu64;
#define RLX_AGENT __ATOMIC_RELAXED, __HIP_MEMORY_SCOPE_AGENT
#define LDS_WAIT() asm volatile("s_waitcnt lgkmcnt(0)" ::: "memory")
#define VM_WAIT() asm volatile("s_waitcnt vmcnt(0)" ::: "memory")
__device__ __forceinline__ unsigned long long rt() { return __builtin_amdgcn_s_memrealtime(); }
__device__ __forceinline__ unsigned f2bf(float f) { unsigned u = __builtin_bit_cast(unsigned, f); return (u + 0x7fffu + ((u >> 16) & 1u)) >> 16; }
__device__ __forceinline__ unsigned pk2(float lo, float hi) { return f2bf(lo) | (f2bf(hi) << 16); }

#define XB_TMO      128
#define XB_XCNT(j)  (256  + 64 * (j))
#define XB_XSUB(j)  (1280 + 64 * (j))
#define XB_XGEN(j)  (2304 + 64 * (j))
#define XB_TOP      3328
#define XB_TOPGEN   3392
#define XCD_BAR_WORDS 3456
#define XB_SPIN_CAP (1u << 18)

__device__ __forceinline__ unsigned xb_ld(unsigned* p)              { return __hip_atomic_load(p, __ATOMIC_RELAXED, __HIP_MEMORY_SCOPE_AGENT); }
__device__ __forceinline__ unsigned xb_add(unsigned* p, unsigned v) { return __hip_atomic_fetch_add(p, v, __ATOMIC_RELAXED, __HIP_MEMORY_SCOPE_AGENT); }
__device__ __forceinline__ unsigned xb_xcc_id() { return (unsigned)__builtin_amdgcn_s_getreg((3 << 11) | 20) & 0xFu; }
#define XB_SPIN(cond, bar) do { unsigned _sp = 0; while (cond) { __builtin_amdgcn_s_sleep(1); \
    if ((++_sp & 255u) == 0u) { if (xb_ld(&(bar)[XB_TMO])) break; if (_sp > XB_SPIN_CAP) { atomicAdd(&(bar)[XB_TMO], 1u); break; } } } } while (0)

struct XcdBarrier {
    unsigned* bar; unsigned x;
    volatile LAS unsigned* st;
};

__device__ __forceinline__ XcdBarrier xcd_barrier_post(unsigned* bar, volatile LAS unsigned* st) {
    XcdBarrier b; b.bar = bar; b.x = xb_xcc_id(); b.st = st;
    if (threadIdx.x == 0) (void)xb_add(&bar[XB_XCNT(b.x)], 1u);
    return b;
}
__device__ __forceinline__ void xcd_barrier_complete(unsigned* bar, unsigned x, unsigned& nloc, unsigned& nx) {
    const unsigned G = gridDim.x * gridDim.y * gridDim.z;
    unsigned sum, cnt, mine, sp = 0u;
    for (;;) {
        sum = 0u; cnt = 0u; mine = 0u;
#pragma unroll
        for (unsigned j = 0; j < 16; ++j) { const unsigned c = xb_ld(&bar[XB_XCNT(j)]); sum += c; cnt += (c > 0u) ? 1u : 0u; mine = (j == x) ? c : mine; }
        if (sum == G) break;
        __builtin_amdgcn_s_sleep(1);
        if ((++sp & 255u) == 0u) { if (xb_ld(&bar[XB_TMO])) break; if (sp > XB_SPIN_CAP) { atomicAdd(&bar[XB_TMO], 1u); break; } }
    }
    nloc = mine > 0u ? mine : 1u; nx = cnt > 0u ? cnt : 1u;
}

__device__ __forceinline__ void xcd_barrier(const XcdBarrier& b) {
    asm volatile("s_waitcnt vmcnt(0)" ::: "memory");
    __syncthreads();
    if (threadIdx.x == 0) {
        unsigned* bar = b.bar;
        __builtin_amdgcn_s_waitcnt(0);
        unsigned nloc = b.st[0], nx = b.st[1];
        if (nloc == 0u) { xcd_barrier_complete(bar, b.x, nloc, nx); b.st[0] = nloc; b.st[1] = nx; }
        const unsigned old = xb_add(&bar[XB_XSUB(b.x)], 1u);
        const unsigned gen = old / nloc;
        if (old + 1u == (gen + 1u) * nloc) {
            __builtin_amdgcn_fence(__ATOMIC_RELEASE, "agent");
            asm volatile("s_waitcnt vmcnt(0)" ::: "memory");
            const unsigned og = xb_add(&bar[XB_TOP], 1u);
            const unsigned tg = og / nx;
            if (og + 1u == (tg + 1u) * nx) xb_add(&bar[XB_TOPGEN], 1u);
            else XB_SPIN(xb_ld(&bar[XB_TOPGEN]) == tg, bar);
            __builtin_amdgcn_fence(__ATOMIC_ACQUIRE, "agent");
            xb_add(&bar[XB_XGEN(b.x)], 1u);
            asm volatile("s_waitcnt vmcnt(0)" ::: "memory");
        } else {
            XB_SPIN(xb_ld(&bar[XB_XGEN(b.x)]) == gen, bar);
            __builtin_amdgcn_fence(__ATOMIC_ACQUIRE, "agent");
            asm volatile("s_waitcnt vmcnt(0)" ::: "memory");
        }
    }
    __syncthreads();
}


constexpr int NWAVES = 8;
constexpr int RING_OFF = 0, RING_BYTES = 131072;
constexpr int LDSCTL_OFF = RING_BYTES, MISC_OFF = LDSCTL_OFF + 320;
constexpr int LDS_BYTES = 147456;
constexpr int CW_TMO = 0, CW_CODE = 1, CW_BAR = 4096;
constexpr int N_PHASES = 19;

struct Frame {
    LAS unsigned char* lds;
    volatile LAS unsigned* MISC;
    gu32* ctl;
    int tid, lane, wave, vcu, G;
};
struct Args { const float* in[18]; float* out; unsigned char* ws; int ph_lo, ph_hi, li, pad; };

__device__ __forceinline__ float wave_sum(float v) {
#pragma unroll
    for (int o = 1; o < 64; o <<= 1) v += __shfl_xor(v, o);
    return v;
}

struct PrepSeg { const float* W; const float* gain; bf16* dst; int ldin, col0, N, K, ldout, seg, seg_stride; };
__device__ __forceinline__ void prep_item(const PrepSeg& s, LAS float* scr, int item, int lane) {
    const int nblk = s.N / 32, kb = item / nblk, nb = item % nblk, k0 = 64 * kb, n0 = 32 * nb;
#pragma unroll 8
    for (int i = 0; i < 32; ++i) { const int kk = 2 * i + (lane >> 5); const float g = s.gain ? s.gain[k0 + kk] : 1.f; scr[kk * 33 + (lane & 31)] = s.W[(size_t)(k0 + kk) * s.ldin + s.col0 + n0 + (lane & 31)] * g; }
    LDS_WAIT(); asm volatile("" ::: "memory");
    const int c = lane & 7;
#pragma unroll
    for (int j = 0; j < 4; ++j) { const int n = n0 + (lane >> 3) + 8 * j; const LAS float* p = scr + (8 * c) * 33 + (lane >> 3) + 8 * j;
        v4u o; o.x = pk2(p[0 * 33], p[1 * 33]); o.y = pk2(p[2 * 33], p[3 * 33]); o.z = pk2(p[4 * 33], p[5 * 33]); o.w = pk2(p[6 * 33], p[7 * 33]);
        const int drow = (n / s.seg) * s.seg_stride + (n % s.seg);
        *(GAS v4u*)(s.dst + (size_t)drow * s.ldout + k0 + 8 * c) = o; }
    LDS_WAIT(); asm volatile("" ::: "memory");
}
constexpr int NSEG = 14;
__device__ const int SEG_DSTC[9] = {C_MQ, C_MK, C_MV, C_GQ, C_GK, C_GV, C_GR, C_PU, 0};
__device__ const int SEG_SRCC[9] = {O_MQ, O_MK, O_MV, O_GQ, O_GK, O_GV, O_GR, O_PU, O_GATE};
__device__ const int SEG_NN[9] = {512, 512, 512, 256, 256, 512, 512, 512, NGATE};
__device__ __forceinline__ void get_seg(const Args& a, int l, int s, PrepSeg& d) {
    unsigned char* wl = a.ws + WS_W + (size_t)l * W_LAYER;
    const float* win = a.in[2] + (size_t)l * DM * DIN; const float* gpre = a.in[1] + l * DM; const float* gffn = a.in[13] + l * DM;
    d.seg = 1 << 30; d.seg_stride = 0; d.gain = nullptr; d.col0 = 0;
    if (s < 9) {
        d.W = win; d.gain = gpre; d.ldin = DIN; d.col0 = SEG_SRCC[s]; d.N = SEG_NN[s]; d.K = DM; d.ldout = DM;
        d.dst = (s < 8) ? (bf16*)(wl + W_IN) + (size_t)SEG_DSTC[s] * DM : (bf16*)(wl + W_GATE);
    } else if (s == 9)  { d.W = a.in[8] + (size_t)l * 512 * 1024; d.ldin = 1024; d.N = 1024; d.K = 512; d.ldout = KBR; d.dst = (bf16*)(wl + W_BR); }
    else if (s == 10) { d.W = a.in[10] + (size_t)l * 512 * 1024; d.ldin = 1024; d.N = 1024; d.K = 512; d.ldout = KBR; d.dst = (bf16*)(wl + W_BR) + 1024; }
    else if (s == 11) { d.W = a.in[11] + (size_t)l * 1024 * 1024; d.ldin = 1024; d.N = 1024; d.K = 1024; d.ldout = DM; d.dst = (bf16*)(wl + W_OUT); }
    else if (s == 12) { d.W = a.in[14] + (size_t)l * DM * DFF; d.gain = gffn; d.ldin = DFF; d.N = DFF; d.K = DM; d.ldout = DM; d.dst = (bf16*)(wl + W_GU); d.seg = 128; d.seg_stride = 256; }
    else              { d.W = a.in[15] + (size_t)l * DM * DFF; d.gain = gffn; d.ldin = DFF; d.N = DFF; d.K = DM; d.ldout = DM; d.dst = (bf16*)(wl + W_GU) + (size_t)128 * DM; d.seg = 128; d.seg_stride = 256; }
}
__device__ __forceinline__ void p0_prologue(Frame& F, const Args& a) {
    int tid_ = threadIdx.x; asm volatile("" : "+v"(tid_)); const int tid = tid_, lane = tid & 63;
    LAS float* scr = (LAS float*)(F.lds + RING_OFF + F.wave * 16384);
    const int gw = F.vcu * NWAVES + F.wave, NGW = F.G * NWAVES;
    int base = 0;
    for (int l = 0; l < DEPTH; ++l) {
        for (int s = 0; s < NSEG + 1; ++s) {
            PrepSeg d;
            if (s < NSEG) get_seg(a, l, s, d);
            else { d.W = a.in[16] + (size_t)l * DFF * DM; d.gain = nullptr; d.ldin = DM; d.col0 = 0; d.N = DM; d.K = DFF; d.ldout = DFF; d.dst = (bf16*)(a.ws + WS_W + (size_t)l * W_LAYER + W_DN); d.seg = 1 << 30; d.seg_stride = 0; }
            const int nitems = (d.K / 64) * (d.N / 32);
            int first = gw - (base % NGW); if (first < 0) first += NGW;
            for (int it = first; it < nitems; it += NGW) prep_item(d, scr, it, lane);
            base += nitems;
        }
        const float* wp = a.in[6] + (size_t)l * 4 * 128 * 128; const float* sc = a.in[7] + l * 512; const float* Wb = a.in[9] + (size_t)l * 512 * 1024;
        bf16* WBR_t = (bf16*)(a.ws + WS_W + (size_t)l * W_LAYER + W_BR);
        for (int idx = (F.vcu * NWAVES * 64) + tid; idx < 64 * 1024; idx += F.G * NWAVES * 64) {
            const int n = idx & 1023, c8 = idx >> 10, g = c8 >> 4, c0 = (c8 & 15) * 8;
            float s8[8];
#pragma unroll
            for (int i = 0; i < 8; ++i) s8[i] = 0.f;
            for (int d = 0; d < 128; ++d) { const float wb = sc[g * 128 + d] * Wb[(size_t)(g * 128 + d) * 1024 + n];
#pragma unroll
                for (int i = 0; i < 8; ++i) s8[i] += wp[((size_t)g * 128 + c0 + i) * 128 + d] * wb; }
            v4u o; o.x = pk2(s8[0], s8[1]); o.y = pk2(s8[2], s8[3]); o.z = pk2(s8[4], s8[5]); o.w = pk2(s8[6], s8[7]);
            *(GAS v4u*)(WBR_t + (size_t)n * KBR + 512 + g * 128 + c0) = o;
        }
    }
}
__device__ __forceinline__ void rows_phase(Frame& F, const float* xsrc, const bf16* Fin, const float* wpost, float* xdst, bf16* XB, float* R, float* G1, const float* g1_win, const float* g1_gain) {
    int tid_ = threadIdx.x; asm volatile("" : "+v"(tid_)); const int tid = tid_;
    LAS float* wt = (LAS float*)(F.lds + RING_OFF);
    if (g1_win) {
        for (int idx = tid; idx < 16 * 1024; idx += NWAVES * 64) { const int k = idx >> 4, j = idx & 15; wt[j * 1024 + k] = g1_gain[k] * g1_win[(size_t)k * DIN + O_G1 + j]; }
        __syncthreads();
    }
    const int gw = F.vcu * NWAVES + F.wave, NGW = F.G * NWAVES, lane = tid & 63;
    for (int m = gw; m < M; m += NGW) {
        const GAS f32x4* xr = (const GAS f32x4*)(xsrc + (size_t)m * DM) + lane;
        f32x4 v[4];
#pragma unroll
        for (int j = 0; j < 4; ++j) v[j] = xr[64 * j];
        if (Fin) {
            const GAS unsigned long long* fr8 = (const GAS unsigned long long*)(Fin + (size_t)m * DM) + lane;
            f32x4 f[4]; float s = 0.f;
#pragma unroll
            for (int j = 0; j < 4; ++j) { const unsigned long long w = fr8[64 * j]; const unsigned lo = (unsigned)w, hi = (unsigned)(w >> 32);
                f[j] = (f32x4){__uint_as_float(lo << 16), __uint_as_float(lo & 0xffff0000u), __uint_as_float(hi << 16), __uint_as_float(hi & 0xffff0000u)};
                s += (f[j].x * f[j].x + f[j].y * f[j].y) + (f[j].z * f[j].z + f[j].w * f[j].w); }
            const float rf = 1.f / sqrtf(wave_sum(s) * (1.f / DM) + EPS);
#pragma unroll
            for (int j = 0; j < 4; ++j) { const f32x4 w = ((const GAS f32x4*)wpost)[64 * j + lane]; v[j] = v[j] + f[j] * rf * w; }
        }
        if (xdst) { GAS f32x4* xo = (GAS f32x4*)(xdst + (size_t)m * DM) + lane;
#pragma unroll
            for (int j = 0; j < 4; ++j) xo[64 * j] = v[j]; }
        if (XB) {
            float s = 0.f;
#pragma unroll
            for (int j = 0; j < 4; ++j) s += (v[j].x * v[j].x + v[j].y * v[j].y) + (v[j].z * v[j].z + v[j].w * v[j].w);
            const float r = 1.f / sqrtf(wave_sum(s) * (1.f / DM) + EPS);
            GAS unsigned long long* o8 = (GAS unsigned long long*)(XB + (size_t)m * DM) + lane;
#pragma unroll
            for (int j = 0; j < 4; ++j) o8[64 * j] = (unsigned long long)pk2(v[j].x, v[j].y) | ((unsigned long long)pk2(v[j].z, v[j].w) << 32);
            if (lane == 0) R[m] = r;
            if (g1_win) {
                float mine = 0.f;
#pragma unroll
                for (int jj = 0; jj < 16; ++jj) { float d = 0.f;
#pragma unroll
                    for (int j = 0; j < 4; ++j) { const f32x4 w = *(const LAS f32x4*)(wt + jj * 1024 + 4 * (64 * j + lane)); d += (v[j].x * w.x + v[j].y * w.y) + (v[j].z * w.z + v[j].w * w.w); }
                    d = wave_sum(d); if (lane == jj) mine = d; }
                if (lane < 16) G1[(size_t)m * 16 + lane] = mine * r;
            }
        }
    }
    if (g1_win) __syncthreads();
}

__global__ void __launch_bounds__(NWAVES * 64, 2) mega_fwd(Args args) {
    extern __shared__ __attribute__((aligned(16))) unsigned char lds[];
    Frame F;
    F.lds = (LAS unsigned char*)lds;
    F.MISC = (volatile LAS unsigned*)(F.lds + MISC_OFF);
    F.tid = threadIdx.x; F.lane = F.tid & 63; F.wave = __builtin_amdgcn_readfirstlane(F.tid >> 6);
    F.G = gridDim.x; { const int bx = blockIdx.x; F.vcu = (F.G % 8 == 0) ? (bx % 8) * (F.G / 8) + bx / 8 : bx; }
    unsigned char* ws = args.ws;
    F.ctl = (gu32*)(ws + WS_CTL);
    for (int u = F.tid; u < (LDS_BYTES - LDSCTL_OFF) / 4; u += NWAVES * 64) ((LAS unsigned*)(F.lds + LDSCTL_OFF))[u] = 0u;
    __syncthreads();
    XcdBarrier bar = xcd_barrier_post((unsigned*)(F.ctl + CW_BAR) + args.li * XCD_BAR_WORDS, F.MISC + 8);
    const int lo = args.ph_lo, hi = args.ph_hi;
#define IN(k) (lo <= (k) && (k) < hi)
#define SEAM(k) do { if (IN(k) && IN((k) + 1)) xcd_barrier(bar); } while (0)
    const float* x = args.in[0]; float* out = args.out;
    float* R = (float*)(ws + WS_R); float* G1 = (float*)(ws + WS_G1);
    bf16* XB = (bf16*)(ws + WS_XB); bf16* PM = (bf16*)(ws + WS_PM); bf16* MO = (bf16*)(ws + WS_MO);
    bf16* GATES = (bf16*)(ws + WS_GATES); bf16* MIXED = (bf16*)(ws + WS_MIXED); bf16* F1 = (bf16*)(ws + WS_F1); bf16* HDN = (bf16*)(ws + WS_HDN); bf16* F2 = (bf16*)(ws + WS_F2);

    if (IN(0)) { p0_prologue(F, args); __syncthreads();     rows_phase(F, x, nullptr, nullptr, nullptr, XB, R, G1, args.in[2], args.in[1]); }
    SEAM(0);
    for (int l = 0; l < DEPTH; ++l) {
        const int pb = 1 + 9 * l;
        unsigned char* wl = ws + WS_W + (size_t)l * W_LAYER;
        const bf16* WIN_t = (const bf16*)(wl + W_IN); const bf16* WGATE_t = (const bf16*)(wl + W_GATE); const bf16* WBR_t = (const bf16*)(wl + W_BR);
        const bf16* WOUT_t = (const bf16*)(wl + W_OUT); const bf16* WGU_t = (const bf16*)(wl + W_GU); const bf16* WDN_t = (const bf16*)(wl + W_DN);
        if (IN(pb + 0)) {
            pg8::Gemm g{XB, WIN_t, M, NMIX, DM, DM, 0}; pg8::StaticOrder S; S.init(M, NMIX, F.G, (int)blockIdx.x);
            pg8::EpiProj E{PM, R};
            pg8::gemm_phase<pg8::EpiProj, pg8::StaticOrder, true, true>(F.lds + RING_OFF, g, S, E);
        }
        SEAM(pb + 0);
        SEAM(pb + 1);
        if (IN(pb + 2)) {
            pg8::Gemm g{XB, WGATE_t, M, NGATE, DM, DM, 0}; pg8::StaticOrder S; S.init(M, NGATE, F.G, (int)blockIdx.x);
            pg8::EpiSig E{GATES, R};
            pg8::gemm_phase<pg8::EpiSig, pg8::StaticOrder, true, true>(F.lds + RING_OFF, g, S, E);
        }
        SEAM(pb + 2);
        if (IN(pb + 3)) {
            pg8::Gemm g{MO, WBR_t, M, DM, KBR, 512, 1024}; pg8::SegOrder3 S; S.S.init(M, DM, F.G, (int)blockIdx.x);
            pg8::EpiMixed E{MIXED, GATES};
            pg8::gemm_phase<pg8::EpiMixed, pg8::SegOrder3, true, true>(F.lds + RING_OFF, g, S, E);
        }
        SEAM(pb + 3);
        if (IN(pb + 4)) {
            pg8::Gemm g{MIXED, WOUT_t, M, DM, DM, DM, 0}; pg8::StaticOrder S; S.init(M, DM, F.G, (int)blockIdx.x);
            pg8::EpiPlain E{F1};
            pg8::gemm_phase<pg8::EpiPlain, pg8::StaticOrder, true, true>(F.lds + RING_OFF, g, S, E);
        }
        SEAM(pb + 4);
        if (IN(pb + 5)) rows_phase(F, l == 0 ? x : out, F1, args.in[12] + l * DM, out, XB, R, nullptr, nullptr, nullptr);
        SEAM(pb + 5);
        if (IN(pb + 6)) {
            pg8::Gemm g{XB, WGU_t, M, 2 * DFF, DM, DM, 0}; pg8::StaticOrder S; S.init(M, 2 * DFF, F.G, (int)blockIdx.x);
            pg8::EpiSwiglu E{HDN, R};
            pg8::gemm_phase<pg8::EpiSwiglu, pg8::StaticOrder, true, true>(F.lds + RING_OFF, g, S, E);
        }
        SEAM(pb + 6);
        if (IN(pb + 7)) {
            pg8::Gemm g{HDN, WDN_t, M, DM, DFF, DFF, 0}; pg8::StaticOrder S; S.init(M, DM, F.G, (int)blockIdx.x);
            pg8::EpiPlain E{F2};
            pg8::gemm_phase<pg8::EpiPlain, pg8::StaticOrder, true, true>(F.lds + RING_OFF, g, S, E);
        }
        SEAM(pb + 7);
        if (IN(pb + 8)) {
            const bool last = (l == DEPTH - 1);
            rows_phase(F, out, F2, args.in[17] + l * DM, out, last ? nullptr : XB, last ? nullptr : R, last ? nullptr : G1,
                       last ? nullptr : args.in[2] + (size_t)(l + 1) * DM * DIN, last ? nullptr : args.in[1] + (l + 1) * DM);
        }
        SEAM(pb + 8);
    }
#undef IN
#undef SEAM
}

__device__ __forceinline__ float bf2f(unsigned v) { return __uint_as_float(v << 16); }
__global__ void k_gla_gate(const float* __restrict__ G1, const float* __restrict__ w2, const float* __restrict__ bg, float* LA) {
    const int m = blockIdx.x, c = threadIdx.x;
    float s = bg[c];
#pragma unroll
    for (int j = 0; j < 16; ++j) s += G1[m * 16 + j] * w2[j * 256 + c];
    const float ls = fminf(s, 0.f) - log1pf(__expf(-fabsf(s)));
    LA[(size_t)m * 256 + c] = ls * (1.f / 16.f);
}
__global__ void __launch_bounds__(64) k_gla_scan(const bf16_t* __restrict__ PM, const float* __restrict__ LA, bf16_t* MO) {
    __shared__ float qs[64 * 64], ks[64 * 64], as[64 * 64];
    const int bh = blockIdx.x, b = bh >> 2, h = bh & 3, tid = threadIdx.x, col = blockIdx.y * 64 + tid;
    float S[64];
#pragma unroll
    for (int d = 0; d < 64; ++d) S[d] = 0.f;
    for (int c = 0; c < 64; ++c) {
        const size_t row0 = (size_t)b * SEQ + c * 64;
        __syncthreads();
        for (int t = 0; t < 64; ++t) {
            qs[t * 64 + tid] = bf2f(PM[(row0 + t) * NMIX + C_GQ + h * 64 + tid]);
            ks[t * 64 + tid] = bf2f(PM[(row0 + t) * NMIX + C_GK + h * 64 + tid]);
            as[t * 64 + tid] = __expf(LA[(row0 + t) * 256 + h * 64 + tid]);
        }
        __syncthreads();
        for (int t = 0; t < 64; ++t) {
            const float v = bf2f(PM[(row0 + t) * NMIX + C_GV + h * 128 + col]);
            float o = 0.f;
#pragma unroll
            for (int d = 0; d < 64; ++d) { S[d] = as[t * 64 + d] * S[d] + ks[t * 64 + d] * v; o += qs[t * 64 + d] * S[d]; }
            MO[(row0 + t) * KBR + h * 128 + col] = f2bf(o);
        }
    }
}
__global__ void k_gla_post(const bf16_t* __restrict__ PM, const float* __restrict__ norm_w, bf16_t* MO) {
    const int m = blockIdx.x, h = threadIdx.x >> 6, lane = threadIdx.x & 63;
    const unsigned ow = *(const unsigned*)(MO + (size_t)m * KBR + h * 128 + lane * 2);
    const float o0 = bf2f(ow & 0xffffu), o1 = bf2f(ow >> 16);
    const float ss = wave_sum(o0 * o0 + o1 * o1);
    const float rn = rsqrtf(ss * (1.f / 128.f) + EPS);
    const unsigned rw = *(const unsigned*)(PM + (size_t)m * NMIX + C_GR + h * 128 + lane * 2);
    const float y0 = o0 * rn * norm_w[lane * 2] * bf2f(rw & 0xffffu), y1 = o1 * rn * norm_w[lane * 2 + 1] * bf2f(rw >> 16);
    *(unsigned*)(MO + (size_t)m * KBR + h * 128 + lane * 2) = (unsigned)f2bf(y0) | ((unsigned)f2bf(y1) << 16);
}
__global__ void k_pool(const bf16_t* __restrict__ PM, bf16_t* MO) {
    const int m = blockIdx.x, t = m & (SEQ - 1);
    for (int c = threadIdx.x; c < 512; c += 256) {
        const int w = 2 << (c >> 7);
        const int cnt = (t + 1 < w) ? (t + 1) : w;
        float s = 0.f;
        for (int i = 0; i < cnt; ++i) s += bf2f(PM[(size_t)(m - i) * NMIX + C_PU + c]);
        const float u = bf2f(PM[(size_t)m * NMIX + C_PU + c]);
        MO[(size_t)m * KBR + 512 + c] = f2bf(s / (float)cnt - u);
    }
}
__global__ void k_kmean(const bf16_t* __restrict__ PM, float* KM) {
    const int bn = blockIdx.x, b = bn >> 4, n = bn & 15, h = blockIdx.y, d = threadIdx.x;
    float s = 0.f;
    for (int i = 0; i < 256; ++i) s += bf2f(PM[((size_t)b * SEQ + n * 256 + i) * NMIX + C_MK + h * 64 + d]);
    KM[(((size_t)b * 8 + h) * 16 + n) * 64 + d] = s * (1.f / 256.f);
}
__global__ void __launch_bounds__(64) k_moba(const bf16_t* __restrict__ PM, const float* __restrict__ KM, bf16_t* MO) {
    __shared__ float Ks[64 * 64], Vs[64 * 64];
    const int tid = threadIdx.x, m = blockIdx.x * 64 + tid, b = m >> 12, t = m & (SEQ - 1), j = t >> 8, h = blockIdx.y;
    const float slope = exp2f(-(float)(h + 1));
    float q[64];
#pragma unroll
    for (int d = 0; d < 64; d += 2) { const unsigned w = *(const unsigned*)(PM + (size_t)m * NMIX + C_MQ + h * 64 + d); q[d] = bf2f(w & 0xffffu); q[d + 1] = bf2f(w >> 16); }
    float b0 = -3e38f, b1 = -3e38f, b2 = -3e38f; int i0 = -1, i1 = -1, i2 = -1;
    for (int n = 0; n < j; ++n) {
        const float* km = KM + (((size_t)b * 8 + h) * 16 + n) * 64;
        float g = 0.f;
#pragma unroll
        for (int d = 0; d < 64; ++d) g += q[d] * km[d];
        if (g > b0) { b2 = b1; i2 = i1; b1 = b0; i1 = i0; b0 = g; i0 = n; }
        else if (g > b1) { b2 = b1; i2 = i1; b1 = g; i1 = n; }
        else if (g > b2) { b2 = g; i2 = n; }
    }
    unsigned sel = 0u;
    if (i0 >= 0) sel |= 1u << i0;
    if (i1 >= 0) sel |= 1u << i1;
    if (i2 >= 0) sel |= 1u << i2;
    sel |= 1u << j;
    float mrun = -1e30f, l = 0.f, o[64];
#pragma unroll
    for (int d = 0; d < 64; ++d) o[d] = 0.f;
    for (int n = 0; n <= j; ++n) {
        const bool mine = (sel >> n) & 1u;
        for (int kt = 0; kt < 4; ++kt) {
            const size_t row0 = (size_t)b * SEQ + n * 256 + kt * 64;
            __syncthreads();
            for (int s = 0; s < 64; ++s) {
                Ks[s * 64 + tid] = bf2f(PM[(row0 + s) * NMIX + C_MK + h * 64 + tid]);
                Vs[s * 64 + tid] = bf2f(PM[(row0 + s) * NMIX + C_MV + h * 64 + tid]);
            }
            __syncthreads();
            if (mine) {
                for (int s = 0; s < 64; ++s) {
                    const int pos = n * 256 + kt * 64 + s;
                    if (pos > t) break;
                    float sc = 0.f;
#pragma unroll
                    for (int d = 0; d < 64; ++d) sc += q[d] * Ks[s * 64 + d];
                    sc -= slope * (float)(t - pos);
                    if (sc > mrun) {
                        const float corr = __expf(mrun - sc);
                        l *= corr;
#pragma unroll
                        for (int d = 0; d < 64; ++d) o[d] *= corr;
                        mrun = sc;
                    }
                    const float p = __expf(sc - mrun);
                    l += p;
#pragma unroll
                    for (int d = 0; d < 64; ++d) o[d] += p * Vs[s * 64 + d];
                }
            }
        }
    }
    const float il = 1.f / l;
#pragma unroll
    for (int d = 0; d < 64; d += 2) *(unsigned*)(MO + (size_t)m * KBR + 1024 + h * 64 + d) = (unsigned)f2bf(o[d] * il) | ((unsigned)f2bf(o[d + 1] * il) << 16);
}


extern "C" void kernel_launch(void* const* d_in, const int* in_sizes, int n_in, void* d_out, int out_size, void* d_ws, size_t ws_size, hipStream_t stream) {
    static int grid = 0;
    if (grid == 0) {
        if (n_in != 18 || in_sizes[0] != M * DM || out_size != M * DM || ws_size < WS_END) { fprintf(stderr, "kernel_launch: unexpected shapes (n_in %d, out %d, ws %zu); nothing launched\n", n_in, out_size, ws_size); grid = -1; return; }
        int dev = 0, cus = 0, per_cu = 0;
        if (hipGetDevice(&dev) != hipSuccess || hipDeviceGetAttribute(&cus, hipDeviceAttributeMultiprocessorCount, dev) != hipSuccess) { grid = -1; return; }
        if (hipFuncSetAttribute((const void*)mega_fwd, hipFuncAttributeMaxDynamicSharedMemorySize, LDS_BYTES) != hipSuccess) { fprintf(stderr, "kernel_launch: hipFuncSetAttribute failed\n"); grid = -1; return; }
        if (hipOccupancyMaxActiveBlocksPerMultiprocessor(&per_cu, (const void*)mega_fwd, NWAVES * 64, LDS_BYTES) != hipSuccess || per_cu < 1) { fprintf(stderr, "kernel_launch: occupancy query reports %d blocks per CU; nothing launched\n", per_cu); (void)hipGetLastError(); grid = -1; return; }
        grid = cus;
    }
    if (grid < 0) return;
    if (hipMemsetAsync((char*)d_ws + WS_CTL, 0, CTL_ZERO_BYTES, stream) != hipSuccess) return;
    Args a{};
    for (int i = 0; i < 18; ++i) a.in[i] = (const float*)d_in[i];
    a.out = (float*)d_out; a.ws = (unsigned char*)d_ws;
    unsigned char* ws = (unsigned char*)d_ws;
    float* G1 = (float*)(ws + WS_G1); float* KM = (float*)(ws + WS_KM); float* LA = (float*)(ws + WS_SP);
    bf16_t* PM = (bf16_t*)(ws + WS_PM); bf16_t* MO = (bf16_t*)(ws + WS_MO);
    const float* gla_w_g2 = (const float*)d_in[3]; const float* gla_b_g = (const float*)d_in[4]; const float* gla_norm = (const float*)d_in[5];
    const int cuts[4] = {0, 2, 11, N_PHASES};
    for (int li = 0; li < 3; ++li) {
        a.ph_lo = cuts[li] + (li > 0 ? 1 : 0); a.ph_hi = cuts[li + 1]; a.li = li;
        hipLaunchKernelGGL(mega_fwd, dim3(grid), dim3(NWAVES * 64), LDS_BYTES, stream, a);
        if (li < 2) {
            const int l = li;
            k_gla_gate<<<M, 256, 0, stream>>>(G1, gla_w_g2 + l * 16 * 256, gla_b_g + l * 256, LA);
            k_gla_scan<<<dim3(BATCH * 4, 2), 64, 0, stream>>>(PM, LA, MO);
            k_gla_post<<<M, 256, 0, stream>>>(PM, gla_norm + l * 128, MO);
            k_pool<<<M, 256, 0, stream>>>(PM, MO);
            k_kmean<<<dim3(BATCH * 16, 8), 64, 0, stream>>>(PM, KM);
            k_moba<<<dim3(M / 64, 8), 64, 0, stream>>>(PM, KM, MO);
        }
    }
}
```

```cpp
#include <hip/hip_runtime.h>
#include <hip/hip_bf16.h>
#include <cmath>
#include <stdint.h>
#include <cstdio>

constexpr int BATCH = 8, SEQ = 4096, DM = 1024, M = BATCH * SEQ, DEPTH = 2;
constexpr int DIN = 6672, NMIX = 3584, NGATE = 3072, DFF = 2816, KBR = 1536;
constexpr int C_MQ = 0, C_MK = 512, C_MV = 1024, C_GQ = 1536, C_GK = 1792, C_GV = 2048, C_GR = 2560, C_PU = 3072;
constexpr int O_GQ = 0, O_GK = 256, O_GV = 512, O_G1 = 1024, O_GR = 1040, O_PU = 1552, O_MQ = 2064, O_MK = 2576, O_MV = 3088, O_GATE = 3600;
constexpr float EPS = 1e-6f;

constexpr size_t MiB = 1u << 20;
constexpr size_t WS_CTL = 0, CTL_ZERO_BYTES = 1 * MiB;
constexpr size_t WS_R = 1 * MiB;
constexpr size_t WS_G1 = 2 * MiB;
constexpr size_t WS_KM = 4 * MiB;
constexpr size_t WS_W = 6 * MiB, W_LAYER = 35 * MiB;
constexpr size_t W_IN = 0, W_GATE = 7 * MiB, W_BR = 13 * MiB, W_OUT = 16 * MiB, W_GU = 18 * MiB, W_DN = 29 * MiB;
constexpr size_t WS_XB = 76 * MiB;
constexpr size_t WS_PM = 140 * MiB;
constexpr size_t WS_MO = 364 * MiB;
constexpr size_t WS_SP = 460 * MiB;
constexpr size_t WS_GATES = WS_PM;
constexpr size_t WS_MIXED = WS_XB;
constexpr size_t WS_F1 = WS_MO;
constexpr size_t WS_HDN = WS_PM;
constexpr size_t WS_F2 = WS_MO;
constexpr size_t WS_END = 512 * MiB;

typedef unsigned short bf16_t;
namespace pg8 {
#define PG8_LAS __attribute__((address_space(3)))
typedef unsigned short bf16_t;
typedef short bf16x8 __attribute__((ext_vector_type(8)));
typedef float f32x4 __attribute__((ext_vector_type(4)));
typedef unsigned u32x4 __attribute__((ext_vector_type(4)));
constexpr int BM = 256, BK = 64, HALF = 128, HTB = HALF * BK * 2  , STAGE_BYTES = 8 * HTB, NXCD = 8, WGM = 8;

__host__ __device__ __forceinline__ int lds_byte(int r, int c) { const int st = (r >> 4) * 2 + (c >> 5), rr = r & 15, cc = c & 31, ob = rr * 64 + cc * 2; return st * 1024 + (ob ^ (((ob >> 9) & 1) << 5)); }
__host__ __device__ __forceinline__ void stage_rc(int b, int& R, int& C) { const int st = b / 1024, sb = b % 1024, swz = sb ^ (((sb >> 9) & 1) << 5); R = (st >> 1) * 16 + swz / 64; C = (st & 1) * 32 + (swz % 64) / 2; }
__host__ __device__ __forceinline__ int perm32(int rho) { const int n = rho >> 4, i = rho & 15; return 8 * (i >> 2) + 4 * n + (i & 3); }

struct Unit { int pm, pn, ks; };
struct Gemm { const bf16_t* A; const bf16_t* Bt; int M, N, K, Kt, ksb; };

struct StaticOrder {
    int nM, nN, nwg, G, c;
    __host__ __device__ void init(int M, int N, int G_, int c_) { nM = M / BM; nN = N / BM; nwg = nM * nN; G = G_; c = c_; }
    __host__ __device__ bool next(int i, Unit& u) const {
        const long L = (long)i * G + c; if (L >= nwg) return false;
        int wgid = (int)L; { const int q = nwg / NXCD, r = nwg % NXCD, xcd = wgid % NXCD, off = wgid / NXCD; wgid = (xcd < r ? xcd * (q + 1) : r * (q + 1) + (xcd - r) * q) + off; }
        const int nig = WGM * nN, gid = wgid / nig, fm = gid * WGM, gsz = (nM - fm) < WGM ? (nM - fm) : WGM;
        u.pm = fm + ((wgid % nig) % gsz); u.pn = (wgid % nig) / gsz; u.ks = 0; return true;
    }
    __device__ __forceinline__ void a_ready(const Unit&) const {}
    __device__ __forceinline__ void done(const Unit&) const {}
};

__device__ __forceinline__ unsigned cvt_pk_bf16(float lo, float hi) { unsigned r; asm volatile("v_cvt_pk_bf16_f32 %0, %1, %2" : "=v"(r) : "v"(lo), "v"(hi)); return r; }
struct SegOrder3 {
    StaticOrder S;
    __device__ __forceinline__ bool next(int i, Unit& u) const { const int q = i / 3; if (!S.next(q, u)) return false; u.ks = i - 3 * q; return true; }
    __device__ __forceinline__ void a_ready(const Unit&) const {}
    __device__ __forceinline__ void done(const Unit&) const {}
};
__device__ __forceinline__ float fast_sigmoid(float x) { return __builtin_amdgcn_rcpf(1.f + __expf(-x)); }
__device__ __forceinline__ float bflo(unsigned w) { return __uint_as_float(w << 16); }
__device__ __forceinline__ float bfhi(unsigned w) { return __uint_as_float(w & 0xffff0000u); }
struct EpiProj {
    static constexpr bool PERM = true, AFTER_DRAIN = false, SEGS = false;
    bf16_t* O; const float* R;
    __device__ __forceinline__ void operator()(const f32x4 (&acc)[2][2][4][2], const Unit& u, int wr, int wc, int fr, int fq) const {
        const int pn = u.pn; const float cs = (pn < 2) ? 0.125f * 1.4426950408889634f : (pn == 6) ? 0.125f : 1.f; const bool silu = (pn == 10 || pn == 11);
        const int row0 = u.pm * BM + wr * 64 + fr, col0 = pn * BM + wc * 32 + 8 * fq;
#pragma unroll
        for (int ai = 0; ai < 2; ++ai)
#pragma unroll
            for (int m = 0; m < 4; ++m) { const int row = row0 + ai * HALF + m * 16; const float r = R[row] * cs; bf16_t* rowp = O + (size_t)row * 3584 + col0;
#pragma unroll
                for (int bj = 0; bj < 2; ++bj) { f32x4 v0 = acc[ai][bj][m][0] * r, v1 = acc[ai][bj][m][1] * r;
                    if (silu) {
#pragma unroll
                        for (int i = 0; i < 4; ++i) { v0[i] = v0[i] * fast_sigmoid(v0[i]); v1[i] = v1[i] * fast_sigmoid(v1[i]); } }
                    u32x4 w; w.x = cvt_pk_bf16(v0[0], v0[1]); w.y = cvt_pk_bf16(v0[2], v0[3]); w.z = cvt_pk_bf16(v1[0], v1[1]); w.w = cvt_pk_bf16(v1[2], v1[3]);
                    *(u32x4*)(rowp + bj * HALF) = w; } }
    }
};
struct EpiSig {
    static constexpr bool PERM = true, AFTER_DRAIN = false, SEGS = false;
    bf16_t* O; const float* R;
    __device__ __forceinline__ void operator()(const f32x4 (&acc)[2][2][4][2], const Unit& u, int wr, int wc, int fr, int fq) const {
        const int row0 = u.pm * BM + wr * 64 + fr, col0 = u.pn * BM + wc * 32 + 8 * fq;
#pragma unroll
        for (int ai = 0; ai < 2; ++ai)
#pragma unroll
            for (int m = 0; m < 4; ++m) { const int row = row0 + ai * HALF + m * 16; const float r = R[row]; bf16_t* rowp = O + (size_t)row * 3072 + col0;
#pragma unroll
                for (int bj = 0; bj < 2; ++bj) { f32x4 v0 = acc[ai][bj][m][0] * r, v1 = acc[ai][bj][m][1] * r;
#pragma unroll
                    for (int i = 0; i < 4; ++i) { v0[i] = fmaxf(fast_sigmoid(v0[i]), 1e-18f); v1[i] = fmaxf(fast_sigmoid(v1[i]), 1e-18f); }
                    u32x4 w; w.x = cvt_pk_bf16(v0[0], v0[1]); w.y = cvt_pk_bf16(v0[2], v0[3]); w.z = cvt_pk_bf16(v1[0], v1[1]); w.w = cvt_pk_bf16(v1[2], v1[3]);
                    *(u32x4*)(rowp + bj * HALF) = w; } }
    }
};
struct EpiPlain {
    static constexpr bool PERM = true, AFTER_DRAIN = false, SEGS = false;
    bf16_t* O;
    __device__ __forceinline__ void operator()(const f32x4 (&acc)[2][2][4][2], const Unit& u, int wr, int wc, int fr, int fq) const {
        const int row0 = u.pm * BM + wr * 64 + fr, col0 = u.pn * BM + wc * 32 + 8 * fq;
#pragma unroll
        for (int ai = 0; ai < 2; ++ai)
#pragma unroll
            for (int m = 0; m < 4; ++m) { bf16_t* rowp = O + (size_t)(row0 + ai * HALF + m * 16) * 1024 + col0;
#pragma unroll
                for (int bj = 0; bj < 2; ++bj) { const f32x4 v0 = acc[ai][bj][m][0], v1 = acc[ai][bj][m][1];
                    u32x4 w; w.x = cvt_pk_bf16(v0[0], v0[1]); w.y = cvt_pk_bf16(v0[2], v0[3]); w.z = cvt_pk_bf16(v1[0], v1[1]); w.w = cvt_pk_bf16(v1[2], v1[3]);
                    *(u32x4*)(rowp + bj * HALF) = w; } }
    }
};
struct EpiSwiglu {
    static constexpr bool PERM = true, AFTER_DRAIN = false, SEGS = false;
    bf16_t* O; const float* R;
    __device__ __forceinline__ void operator()(const f32x4 (&acc)[2][2][4][2], const Unit& u, int wr, int wc, int fr, int fq) const {
        const int row0 = u.pm * BM + wr * 64 + fr, col0 = u.pn * HALF + wc * 32 + 8 * fq;
#pragma unroll
        for (int ai = 0; ai < 2; ++ai)
#pragma unroll
            for (int m = 0; m < 4; ++m) { const int row = row0 + ai * HALF + m * 16; const float r = R[row];
                f32x4 h0, h1;
#pragma unroll
                for (int i = 0; i < 4; ++i) { const float g0 = acc[ai][0][m][0][i] * r, g1 = acc[ai][0][m][1][i] * r;
                    h0[i] = g0 * fast_sigmoid(g0) * (acc[ai][1][m][0][i] * r); h1[i] = g1 * fast_sigmoid(g1) * (acc[ai][1][m][1][i] * r); }
                u32x4 w; w.x = cvt_pk_bf16(h0[0], h0[1]); w.y = cvt_pk_bf16(h0[2], h0[3]); w.z = cvt_pk_bf16(h1[0], h1[1]); w.w = cvt_pk_bf16(h1[2], h1[3]);
                *(u32x4*)(O + (size_t)row * 2816 + col0) = w; }
    }
};
struct EpiMixed {
    static constexpr bool PERM = true, AFTER_DRAIN = false, SEGS = true;
    bf16_t* O; const bf16_t* G;
    __device__ __forceinline__ void operator()(f32x4 (&acc)[2][2][4][2], const Unit& u, int wr, int wc, int fr, int fq) const {
        const int row0 = u.pm * BM + wr * 64 + fr, col0 = u.pn * BM + wc * 32 + 8 * fq;
        if (u.ks < 2) {
            const char* gb = (const char*)G + (size_t)u.ks * 2048;
#pragma unroll
            for (int ai = 0; ai < 2; ++ai)
#pragma unroll
                for (int m = 0; m < 4; ++m) { const unsigned off = ((unsigned)(row0 + ai * HALF + m * 16) * 3072u + (unsigned)col0) * 2u;
#pragma unroll
                    for (int bj = 0; bj < 2; ++bj) { const u32x4 a = *(const u32x4*)(gb + off + bj * 256), b = *(const u32x4*)(gb + off + 2048 + bj * 256);
                        f32x4 r0, r1;
                        r0[0] = bflo(a.x) * __builtin_amdgcn_rcpf(bflo(b.x)); r0[1] = bfhi(a.x) * __builtin_amdgcn_rcpf(bfhi(b.x));
                        r0[2] = bflo(a.y) * __builtin_amdgcn_rcpf(bflo(b.y)); r0[3] = bfhi(a.y) * __builtin_amdgcn_rcpf(bfhi(b.y));
                        r1[0] = bflo(a.z) * __builtin_amdgcn_rcpf(bflo(b.z)); r1[1] = bfhi(a.z) * __builtin_amdgcn_rcpf(bfhi(b.z));
                        r1[2] = bflo(a.w) * __builtin_amdgcn_rcpf(bflo(b.w)); r1[3] = bfhi(a.w) * __builtin_amdgcn_rcpf(bfhi(b.w));
                        acc[ai][bj][m][0] *= r0; acc[ai][bj][m][1] *= r1; }
                    asm volatile("" ::: "memory"); }
        } else {
#pragma unroll
            for (int ai = 0; ai < 2; ++ai)
#pragma unroll
                for (int m = 0; m < 4; ++m) { const int row = row0 + ai * HALF + m * 16; const bf16_t* gp = G + (size_t)row * 3072 + 2048 + col0; bf16_t* rowp = O + (size_t)row * 1024 + col0;
#pragma unroll
                    for (int bj = 0; bj < 2; ++bj) { const u32x4 a = *(const u32x4*)(gp + bj * HALF); const f32x4 v0 = acc[ai][bj][m][0], v1 = acc[ai][bj][m][1];
                        u32x4 w; w.x = cvt_pk_bf16(v0[0] * bflo(a.x), v0[1] * bfhi(a.x)); w.y = cvt_pk_bf16(v0[2] * bflo(a.y), v0[3] * bfhi(a.y));
                        w.z = cvt_pk_bf16(v1[0] * bflo(a.z), v1[1] * bfhi(a.z)); w.w = cvt_pk_bf16(v1[2] * bflo(a.w), v1[3] * bfhi(a.w));
                        *(u32x4*)(rowp + bj * HALF) = w; }
                    asm volatile("" ::: "memory"); }
        }
    }
};

template <class Epi, class Sched, bool ALIGN_EPI = false, bool SP2 = false>
__device__ __forceinline__ void gemm_phase(PG8_LAS unsigned char* lds, const Gemm g, const Sched& S, const Epi& E) {
    int tid_ = threadIdx.x; asm volatile("" : "+v"(tid_));
    const int tid = tid_, wid = __builtin_amdgcn_readfirstlane(tid >> 6), lane = tid & 63, wr = wid >> 2, wc = wid & 3, fr = lane & 15, fq = lane >> 4;
    const int K = g.K, nt = g.Kt / BK;
    unsigned voffA[2], voffB[2];
#pragma unroll
    for (int i = 0; i < 2; ++i) { int R, C; stage_rc(tid * 16 + i * 8192, R, C); const int Rb = Epi::PERM ? ((R & ~31) + perm32(R & 31)) : R;
        voffA[i] = (unsigned)(R * K + C) * 2u; voffB[i] = (unsigned)(Rb * K + C) * 2u; }
    const size_t kstep = (size_t)(BK * 2);
    const size_t hstep = (size_t)HALF * K * 2;
    const size_t tstep = 2 * hstep;
    const unsigned ldsw = (unsigned)wid * 1024u;
    const int aoff = lds_byte(wr * 64 + fr, fq * 8), boff = lds_byte(wc * 32 + fr, fq * 8);
#define PG8_SA(b, h) (((b) * 2 + (h)) * HTB)
#define PG8_SB(b, h) ((4 + (b) * 2 + (h)) * HTB)
#define PG8_STAGE(bufoff, gbase, voff) do { _Pragma("unroll") for (int _i = 0; _i < 2; ++_i) \
        __builtin_amdgcn_global_load_lds((const unsigned*)((const char*)(gbase) + (voff)[_i]), (PG8_LAS unsigned*)(lds + (bufoff) + ldsw + _i * 8192), 16, 0, 0); } while (0)
#define PG8_LDA(dst, b, h) do { _Pragma("unroll") for (int m = 0; m < 4; ++m) _Pragma("unroll") for (int k = 0; k < 2; ++k) dst[m][k] = *(const PG8_LAS bf16x8*)(lds + PG8_SA(b, h) + aoff + m * 2048 + k * 1024); } while (0)
#define PG8_LDB(dst, b, h) do { _Pragma("unroll") for (int n = 0; n < 2; ++n) _Pragma("unroll") for (int k = 0; k < 2; ++k) dst[n][k] = *(const PG8_LAS bf16x8*)(lds + PG8_SB(b, h) + boff + n * 2048 + k * 1024); } while (0)
#define PG8_MMA(ai, bj, At, Bt) do { __builtin_amdgcn_s_setprio(1); _Pragma("unroll") for (int m = 0; m < 4; ++m) _Pragma("unroll") for (int n = 0; n < 2; ++n) _Pragma("unroll") for (int k = 0; k < 2; ++k) \
        acc[ai][bj][m][n] = __builtin_amdgcn_mfma_f32_16x16x32_bf16(Bt[n][k], At[m][k], acc[ai][bj][m][n], 0, 0, 0); __builtin_amdgcn_s_setprio(0); } while (0)
#define PG8_WAIT_V(n) asm volatile("s_waitcnt vmcnt(" #n ")" ::: "memory")
#define PG8_WAIT_L(n) asm volatile("s_waitcnt lgkmcnt(" #n ")" ::: "memory")
#define PG8_BAR __builtin_amdgcn_s_barrier()
#define PG8_SCHED __builtin_amdgcn_sched_barrier(0)
    Unit cur, nxt; int ui = 0;
    if (!S.next(0, cur)) return;
    f32x4 acc[2][2][4][2];
#pragma unroll
    for (int a = 0; a < 2; ++a)
#pragma unroll
        for (int b = 0; b < 2; ++b)
#pragma unroll
            for (int m = 0; m < 4; ++m)
#pragma unroll
                for (int n = 0; n < 2; ++n) acc[a][b][m][n] = (f32x4){0.f, 0.f, 0.f, 0.f};
    bf16x8 At[4][2], B0[2][2], B1[2][2];
    const char* cA = (const char*)g.A + (size_t)cur.pm * tstep + (size_t)cur.ks * g.ksb; const char* cB = (const char*)g.Bt + (size_t)cur.pn * tstep + (size_t)cur.ks * g.ksb;
    S.a_ready(cur);
    if constexpr (SP2) {
        PG8_STAGE(PG8_SB(0, 0), cB, voffB); PG8_STAGE(PG8_SB(0, 1), cB + hstep, voffB); PG8_STAGE(PG8_SA(0, 0), cA, voffA); PG8_STAGE(PG8_SA(0, 1), cA + hstep, voffA);
        if (wr == 1) PG8_BAR;
        PG8_WAIT_V(2); PG8_BAR;
        PG8_STAGE(PG8_SB(1, 0), cB + kstep, voffB); PG8_STAGE(PG8_SA(1, 0), cA + kstep, voffA); PG8_STAGE(PG8_SB(1, 1), cB + hstep + kstep, voffB);
        PG8_WAIT_V(6); PG8_BAR;
    } else {
        PG8_STAGE(PG8_SB(0, 0), cB, voffB); PG8_STAGE(PG8_SA(0, 0), cA, voffA); PG8_STAGE(PG8_SB(0, 1), cB + hstep, voffB); PG8_STAGE(PG8_SA(0, 1), cA + hstep, voffA);
        if (wr == 1) PG8_BAR;
        PG8_WAIT_V(4); PG8_BAR;
        PG8_STAGE(PG8_SB(1, 0), cB + kstep, voffB); PG8_STAGE(PG8_SA(1, 0), cA + kstep, voffA); PG8_STAGE(PG8_SB(1, 1), cB + hstep + kstep, voffB);
        PG8_WAIT_V(6); PG8_BAR;
    }
    for (;;) {
        const bool has_next = S.next(ui + 1, nxt);
        const char* nA = has_next ? (const char*)g.A + (size_t)nxt.pm * tstep + (size_t)nxt.ks * g.ksb : cA; const char* nB = has_next ? (const char*)g.Bt + (size_t)nxt.pn * tstep + (size_t)nxt.ks * g.ksb : cB;
        for (int t = 0; t < nt; t += 2) {
            const bool last = (t == nt - 2);
            const char* a1 = cA + (size_t)(t + 1) * kstep;
            const char* a2 = last ? nA : cA + (size_t)(t + 2) * kstep; const char* b2 = last ? nB : cB + (size_t)(t + 2) * kstep;
            const char* a3 = a2 + kstep; const char* b3 = b2 + kstep;
            if (last && has_next) S.a_ready(nxt);
            if constexpr (SP2) {
            PG8_LDB(B0, 0, 0); PG8_LDB(B1, 0, 1); PG8_SCHED; PG8_LDA(At, 0, 0); PG8_STAGE(PG8_SA(1, 1), a1 + hstep, voffA);
            PG8_WAIT_V(8); PG8_WAIT_L(0); PG8_BAR; PG8_MMA(0, 0, At, B0); PG8_MMA(0, 1, At, B1); PG8_BAR; PG8_SCHED;
            PG8_LDA(At, 0, 1); PG8_STAGE(PG8_SB(0, 0), b2, voffB); PG8_STAGE(PG8_SB(0, 1), b2 + hstep, voffB); PG8_STAGE(PG8_SA(0, 0), a2, voffA);
            PG8_WAIT_V(8); PG8_WAIT_L(0); PG8_BAR; PG8_MMA(1, 0, At, B0); PG8_MMA(1, 1, At, B1); PG8_BAR; PG8_SCHED;
            PG8_LDB(B0, 1, 0); PG8_LDB(B1, 1, 1); PG8_SCHED; PG8_LDA(At, 1, 0); PG8_STAGE(PG8_SA(0, 1), a2 + hstep, voffA);
            PG8_WAIT_V(8); PG8_WAIT_L(0); PG8_BAR; PG8_MMA(0, 0, At, B0); PG8_MMA(0, 1, At, B1); PG8_BAR; PG8_SCHED;
            PG8_LDA(At, 1, 1); PG8_STAGE(PG8_SB(1, 0), b3, voffB); PG8_STAGE(PG8_SB(1, 1), b3 + hstep, voffB); PG8_STAGE(PG8_SA(1, 0), a3, voffA);
            PG8_WAIT_V(8); PG8_WAIT_L(0); PG8_BAR; PG8_MMA(1, 0, At, B0); PG8_MMA(1, 1, At, B1); PG8_BAR; PG8_SCHED;
            } else {
            PG8_LDB(B0, 0, 0); PG8_SCHED; PG8_LDA(At, 0, 0); PG8_STAGE(PG8_SA(1, 1), a1 + hstep, voffA);
            PG8_WAIT_L(8); PG8_BAR; PG8_WAIT_L(0); PG8_MMA(0, 0, At, B0); PG8_BAR; PG8_SCHED;
            PG8_LDB(B1, 0, 1); PG8_STAGE(PG8_SB(0, 0), b2, voffB);
            PG8_BAR; PG8_WAIT_L(0); PG8_MMA(0, 1, At, B1); PG8_BAR;
            PG8_LDA(At, 0, 1); PG8_STAGE(PG8_SA(0, 0), a2, voffA);
            PG8_BAR; PG8_WAIT_L(0); PG8_MMA(1, 0, At, B0); PG8_BAR; PG8_SCHED;
            PG8_STAGE(PG8_SB(0, 1), b2 + hstep, voffB);
            PG8_WAIT_V(6); PG8_BAR; PG8_MMA(1, 1, At, B1); PG8_BAR;
            PG8_LDB(B0, 1, 0); PG8_SCHED; PG8_LDA(At, 1, 0); PG8_STAGE(PG8_SA(0, 1), a2 + hstep, voffA);
            PG8_WAIT_L(8); PG8_BAR; PG8_WAIT_L(0); PG8_MMA(0, 0, At, B0); PG8_BAR; PG8_SCHED;
            PG8_LDB(B1, 1, 1); PG8_STAGE(PG8_SB(1, 0), b3, voffB);
            PG8_BAR; PG8_WAIT_L(0); PG8_MMA(0, 1, At, B1); PG8_BAR;
            PG8_LDA(At, 1, 1); PG8_STAGE(PG8_SA(1, 0), a3, voffA);
            PG8_BAR; PG8_WAIT_L(0); PG8_MMA(1, 0, At, B0); PG8_BAR; PG8_SCHED;
            PG8_STAGE(PG8_SB(1, 1), b3 + hstep, voffB);
            PG8_WAIT_V(6); PG8_BAR; PG8_MMA(1, 1, At, B1); PG8_BAR;
            }
        }
        if constexpr (ALIGN_EPI) { if (wr == 0) PG8_BAR; }
        if constexpr (!Epi::AFTER_DRAIN) { E(acc, cur, wr, wc, fr, fq); S.done(cur); }
        if (!has_next) break;
        if (!(Epi::SEGS && cur.ks < 2)) {
#pragma unroll
        for (int a = 0; a < 2; ++a)
#pragma unroll
            for (int b = 0; b < 2; ++b)
#pragma unroll
                for (int m = 0; m < 4; ++m)
#pragma unroll
                    for (int n = 0; n < 2; ++n) acc[a][b][m][n] = (f32x4){0.f, 0.f, 0.f, 0.f};
        }
        cur = nxt; cA = nA; cB = nB; ++ui;
        if constexpr (ALIGN_EPI) { if (wr == 1) PG8_BAR; }
    }
    PG8_WAIT_V(0);
    if constexpr (!ALIGN_EPI) { if (wr == 0) PG8_BAR; }
    PG8_BAR;
    if constexpr (Epi::AFTER_DRAIN) { E.fused(acc, cur, wr, wc, fr, fq, lds, wid, lane); S.done(cur); }
#undef PG8_SA
#undef PG8_SB
#undef PG8_STAGE
#undef PG8_LDA
#undef PG8_LDB
#undef PG8_MMA
#undef PG8_WAIT_V
#undef PG8_WAIT_L
#undef PG8_BAR
#undef PG8_SCHED
}
}

namespace attn_body {
using bf16=__hip_bfloat16;
using bf16x8=__attribute__((ext_vector_type(8)))short;
using s16x4=__attribute__((ext_vector_type(4)))short;
using f32x16=__attribute__((ext_vector_type(16)))float;
using u32x4=__attribute__((ext_vector_type(4)))unsigned;
constexpr int BATCH=8,NHEAD=8,SEQ=4096,D=64,QP=3584,OP=1536;
constexpr int NW=8,QBLK=32,QB=QBLK*NW,KVBLK=64,NQB=SEQ/QB;
constexpr int ATTN_UNIT_ROWS=QB;
__device__ __forceinline__ int crow(int r,int hi){return (r&3)+8*(r>>2)+4*hi;}
#define SBAR() __builtin_amdgcn_sched_barrier(0)
__device__ __forceinline__ void cmask(f32x16&p0,f32x16&p1,int jb,int qrel,int hi){
  const float NEG=-INFINITY; int kb=64*jb+4*hi;
  #pragma unroll
  for(int r=0;r<16;++r){int kv=kb+(r&3)+8*(r>>2); if(kv>qrel)p0[r]=NEG; if(kv+32>qrel)p1[r]=NEG;}
}

constexpr int NSLOT=3, SLOTB=8192;
constexpr int LDS_K=0, LDS_V=NSLOT*SLOTB, LDS_WS=2*NSLOT*SLOTB, LDS_OST=LDS_WS+NW*64*4, LDS_BYTES=LDS_OST+NW*4096;
constexpr float C2=0.125f*1.4426950408889634f;
__device__ __forceinline__ void glds16(const void*gsrc,unsigned lds_dst){unsigned keep;
  asm volatile("s_mov_b32 %0, m0\n\ts_mov_b32 m0, %2\n\ts_nop 0\n\tglobal_load_lds_dwordx4 %1, off\n\ts_mov_b32 m0, %0":"=&s"(keep):"v"(gsrc),"s"(lds_dst):"memory");}
__device__ __forceinline__ float max3f(float a,float b,float c){float r;asm("v_max3_f32 %0, %1, %2, %3":"=v"(r):"v"(a),"v"(b),"v"(c));return r;}
__device__ __forceinline__ float max2f(float a,float b){float r;asm("v_max_f32_e32 %0, %1, %2":"=v"(r):"v"(a),"v"(b));return r;}
__device__ __forceinline__ float fadd_s(float a,float b){float r;asm("v_add_f32_e32 %0, %1, %2":"=v"(r):"v"(a),"v"(b));return r;}
__device__ __forceinline__ float fsub_s(float a,float b){float r;asm("v_sub_f32_e32 %0, %1, %2":"=v"(r):"v"(a),"v"(b));return r;}
typedef float f32x2_t __attribute__((ext_vector_type(2))); typedef __bf16 bf16x2_t __attribute__((ext_vector_type(2)));
__device__ __forceinline__ unsigned cvtpk_s(float lo,float hi){f32x2_t v={lo,hi};bf16x2_t b=__builtin_convertvector(v,bf16x2_t);return __builtin_bit_cast(unsigned,b);}
#define WAIT_BAR(N) asm volatile("s_waitcnt vmcnt(" #N ") lgkmcnt(0)\n\ts_barrier":::"memory")

__device__ __forceinline__ void qkt(f32x16&p0,f32x16&p1,const char*Kslot,const bf16x8*qr,int r32,int hi){
  const char*kb=Kslot+hi*1024+r32*16;
  #pragma unroll
  for(int d0=0;d0<4;++d0){
    const bf16x8 b0=*reinterpret_cast<const bf16x8*>(kb+d0*2048);
    const bf16x8 b1=*reinterpret_cast<const bf16x8*>(kb+d0*2048+512);
    p0=__builtin_amdgcn_mfma_f32_32x32x16_bf16(b0,qr[d0],p0,0,0,0);p1=__builtin_amdgcn_mfma_f32_32x32x16_bf16(b1,qr[d0],p1,0,0,0);}
}
typedef __attribute__((address_space(3))) const char* lds_cptr;
typedef short v4i16_t __attribute__((ext_vector_type(4)));
__device__ __forceinline__ void kload8(bf16x8*kf,lds_cptr kp){
  kf[0]=*(const __attribute__((address_space(3))) bf16x8*)(kp);      kf[1]=*(const __attribute__((address_space(3))) bf16x8*)(kp+512);
  kf[2]=*(const __attribute__((address_space(3))) bf16x8*)(kp+2048); kf[3]=*(const __attribute__((address_space(3))) bf16x8*)(kp+2560);
  kf[4]=*(const __attribute__((address_space(3))) bf16x8*)(kp+4096); kf[5]=*(const __attribute__((address_space(3))) bf16x8*)(kp+4608);
  kf[6]=*(const __attribute__((address_space(3))) bf16x8*)(kp+6144); kf[7]=*(const __attribute__((address_space(3))) bf16x8*)(kp+6656);
}
__device__ __forceinline__ void kload2(bf16x8*kf,lds_cptr kp,int j){ kf[2*j]=*(const __attribute__((address_space(3))) bf16x8*)(kp+j*2048); kf[2*j+1]=*(const __attribute__((address_space(3))) bf16x8*)(kp+j*2048+512); }
__device__ __forceinline__ s16x4 vtr(lds_cptr p){ return __builtin_bit_cast(s16x4,__builtin_amdgcn_ds_read_tr16_b64_v4i16((__attribute__((address_space(3))) v4i16_t*)p)); }
__device__ __forceinline__ float rowmax(const f32x16&p0,const f32x16&p1){
  float a=max3f(p0[0],p0[1],p1[0]),b=max3f(p0[2],p0[3],p1[1]);a=max3f(a,p1[2],p1[3]);
  #pragma unroll
  for(int r=4;r<16;r+=4){a=max3f(a,p0[r],p0[r+1]);b=max3f(b,p0[r+2],p0[r+3]);a=max3f(a,p1[r],p1[r+1]);b=max3f(b,p1[r+2],p1[r+3]);}
  const float m=max2f(a,b);
  auto rr=__builtin_amdgcn_permlane32_swap(__float_as_uint(m),__float_as_uint(m),false,false);
  return max2f(__uint_as_float(rr[0]),__uint_as_float(rr[1]));
}
__device__ __forceinline__ void pv(f32x16*o,int vb,bf16x8 pa0,bf16x8 pa1,bf16x8 pa2,bf16x8 pa3){
  #pragma unroll
  for(int d0=0;d0<2;++d0){s16x4 lo[4],hi[4];
    #pragma unroll
    for(int ks=0;ks<4;++ks){
      asm volatile("ds_read_b64_tr_b16 %0,%1 offset:%c2":"=&v"(lo[ks]):"v"(vb),"i"(d0*4096+ks*1024):"memory");
      asm volatile("ds_read_b64_tr_b16 %0,%1 offset:%c2":"=&v"(hi[ks]):"v"(vb),"i"(d0*4096+ks*1024+512):"memory");}
    asm volatile("s_waitcnt lgkmcnt(0)":::"memory");SBAR();
    #define PK(k) (bf16x8){lo[k][0],lo[k][1],lo[k][2],lo[k][3],hi[k][0],hi[k][1],hi[k][2],hi[k][3]}
    o[d0]=__builtin_amdgcn_mfma_f32_32x32x16_bf16(pa0,PK(0),o[d0],0,0,0);
    o[d0]=__builtin_amdgcn_mfma_f32_32x32x16_bf16(pa1,PK(1),o[d0],0,0,0);
    o[d0]=__builtin_amdgcn_mfma_f32_32x32x16_bf16(pa2,PK(2),o[d0],0,0,0);
    o[d0]=__builtin_amdgcn_mfma_f32_32x32x16_bf16(pa3,PK(3),o[d0],0,0,0);
    #undef PK
  }
}

#ifndef ATTN_STORE16
#define ATTN_STORE16(p,v) (*(u32x4*)(p)=(v))
#endif
template<int THRL> __device__ __forceinline__ void attn_unit(int b,int h,int qb,const bf16*Q,const bf16*__restrict__ K,const bf16*__restrict__ V,bf16*O,const unsigned*__restrict__ SEL,char*shm){
  int tid_=threadIdx.x; asm volatile("":"+v"(tid_)); const int tid=tid_,lane=tid&63,r32=lane&31,hi=lane>>5; const int wid=__builtin_amdgcn_readfirstlane(tid>>6);
  const long rowbase=(long)b*SEQ; const int q0=qb*QB;
  const bf16*Qw=Q+(rowbase+q0+wid*QBLK)*QP+h*D;
  const bf16*Kh=K+rowbase*QP+h*D,*Vh=V+rowbase*QP+h*D;
  const unsigned lds0=(unsigned)(uintptr_t)shm;
  float*wsf=(float*)(shm+LDS_WS)+wid*64;
  const bf16*ksrc=Kh+(long)lane*QP+wid*8;
  const bf16*vsrc=Vh+(long)(16*(wid&3)+(lane>>2))*QP+(wid>>2)*32+(lane&3)*8;
  const unsigned kdst=lds0+LDS_K+wid*1024, vdst=lds0+LDS_V+wid*1024;
  #define KT(t) (((t)<4)?(NT-4+(t)):((t)-4))
  #define DMA_K(t,slot) glds16(ksrc+(long)KT(t)*KVBLK*QP,(unsigned)__builtin_amdgcn_readfirstlane(kdst+(slot)))
  #define DMA_V(t,slot) glds16(vsrc+(long)KT(t)*KVBLK*QP,(unsigned)__builtin_amdgcn_readfirstlane(vdst+(slot)))
  const int vb0=(int)(lds0+LDS_V)+((lane>>4)&1)*32+(lane&3)*8+(4*hi+((lane&15)>>2))*64;
  const char*Kbase=shm+LDS_K; bf16x8 kf[8];
  const lds_cptr shm3=(lds_cptr)shm; const lds_cptr kp0=shm3+LDS_K+hi*1024+r32*16; const lds_cptr vp0=shm3+LDS_V+((lane>>4)&1)*32+(lane&3)*8+(4*hi+((lane&15)>>2))*64;
  const int NT=(q0+QB)/KVBLK;
  DMA_K(0,0);DMA_V(0,0);DMA_K(1,SLOTB);
  const unsigned selm=SEL[((long)(b*NHEAD+h))*SEQ+q0+wid*QBLK+r32];
  const float sl2=__builtin_amdgcn_exp2f(-(float)(h+1))*1.4426950408889634f;
  bf16x8 qr[4];
  #pragma unroll
  for(int d0=0;d0<4;++d0)qr[d0]=*reinterpret_cast<const bf16x8*>(&Qw[(long)r32*QP+d0*16+hi*8]);
  float mhat=0.f,l_reg=0.f;f32x16 o[2];o[0]=f32x16{};o[1]=f32x16{};
  #define CINIT(C0,C1,t) do{ const int kt_=KT(t); const bool on_=((t)<4)||(((selm>>(kt_>>2))&1u)!=0u); \
    const float bs_=on_?(sl2*(float)(64*kt_-q0+4*hi)-mhat):-1e30f; const float s32_=32.f*sl2; \
    _Pragma("unroll") for(int r=0;r<16;++r)C0[r]=__builtin_fmaf(sl2,(float)((r&3)+8*(r>>2)),bs_); \
    _Pragma("unroll") for(int r=0;r<16;++r)C1[r]=C0[r]+s32_; }while(0)
  const int qrel=wid*QBLK+r32;
  #define CMASK(P0,P1,t) do{ if((t)<4)cmask(P0,P1,(t),qrel,hi); }while(0)
  bool resc=false;
  #define START(P0,P1) do{ const float rm=rowmax(P0,P1); resc=false; \
    { const float dl=rm; mhat=fadd_s(mhat,dl); \
      _Pragma("unroll") for(int r=0;r<16;++r){P0[r]=fsub_s(P0[r],dl);P1[r]=fsub_s(P1[r],dl);} } \
    _Pragma("unroll") for(int r=0;r<16;++r)P0[r]=__builtin_amdgcn_exp2f(P0[r]); }while(0)
  #define RESC() do{ if(resc){ asm volatile("s_waitcnt lgkmcnt(0)":::"memory"); \
      _Pragma("unroll") for(int d_=0;d_<2;++d_) _Pragma("unroll") for(int r=0;r<16;++r)o[d_][r]*=wsf[crow(r,hi)]; } }while(0)
  f32x16 pA0,pA1,pB0,pB1;
  int sl_prev=0,sl_cur=0,sl_next=SLOTB;
  #define ROT() do{sl_prev=sl_cur;sl_cur=sl_next;sl_next=(sl_next==(NSLOT-1)*SLOTB)?0:sl_next+SLOTB;}while(0)
  DMA_K(2,2*SLOTB);
  WAIT_BAR(3);
  CINIT(pA0,pA1,0); qkt(pA0,pA1,Kbase,qr,r32,hi);asm volatile("s_nop 15\n\ts_nop 7":"+v"(pA0),"+v"(pA1));CMASK(pA0,pA1,0);
  START(pA0,pA1);
  _Pragma("unroll") for(int r=0;r<16;++r)pA1[r]=__builtin_amdgcn_exp2f(pA1[r]);
  WAIT_BAR(0);
  DMA_K(3,0);DMA_V(1,SLOTB);
  ROT();
  kload8(kf,kp0+sl_cur);
  WAIT_BAR(2);
  s16x4 vlo[8],vhi[8]; u32x4 pw0,pw1,pw2,pw3;
  #define PKW(P,B) cvtpk_s(P[B],P[B+1])
  #define PAF(k) __builtin_bit_cast(bf16x8,pw##k)
  #define VFR(i) (bf16x8){vlo[i][0],vlo[i][1],vlo[i][2],vlo[i][3],vhi[i][0],vhi[i][1],vhi[i][2],vhi[i][3]}
  #define PIN(x) asm volatile("":"+v"(x))
  #define MX3(a,b,c) __builtin_fmaxf(__builtin_fmaxf((a),(b)),(c))
  #define GAPA(MF,A0,A1,A2,A3,W0,W1,PW) do{ MF; sacc+=A0; sacc+=A1; sacc+=A2; sacc+=A3; PIN(sacc); W0; W1; PIN(PW); SBAR(); }while(0)
  #define EX(v) __builtin_amdgcn_exp2f(v)
  #define GAPB(MF,X,B) do{ MF; X[B]=EX(X[B]); X[B+1]=EX(X[B+1]); X[B+2]=EX(X[B+2]); X[B+3]=EX(X[B+3]); PIN(X); SBAR(); }while(0)
  #define VRD(i) do{ vlo[i]=vtr(vp_+(((i)>>2)*4096+((i)&3)*1024)); vhi[i]=vtr(vp_+(((i)>>2)*4096+((i)&3)*1024+512)); }while(0)
  #define KRD(G,j) do{ if(G){ kload2(kf,kp0+sl_next,j); SBAR(); } }while(0)
  #define STEP(C0,C1,P0,P1,t,GK,GV,GL) do{ SBAR(); CINIT(C0,C1,t); SBAR(); \
    const lds_cptr vp_=vp0+sl_prev; \
    VRD(0); SBAR(); float sacc=(P0[0]+P0[1]); \
    GAPA(C0=__builtin_amdgcn_mfma_f32_32x32x16_bf16(kf[0],qr[0],C0,0,0,0), P0[2],P0[3],P0[4],P0[5],     pw0[0]=PKW(P0,0), pw0[1]=PKW(P0,2), pw0); \
    VRD(4); SBAR(); GAPA(C1=__builtin_amdgcn_mfma_f32_32x32x16_bf16(kf[1],qr[0],C1,0,0,0), P0[6],P0[7],P0[8],P0[9],     pw0[2]=PKW(P0,4), pw0[3]=PKW(P0,6), pw0); \
    VRD(1); SBAR(); GAPA(C0=__builtin_amdgcn_mfma_f32_32x32x16_bf16(kf[2],qr[1],C0,0,0,0),   P0[10],P0[11],P0[12],P0[13], pw1[0]=PKW(P0,8), pw1[1]=PKW(P0,10), pw1); \
    VRD(5); SBAR(); GAPA(C1=__builtin_amdgcn_mfma_f32_32x32x16_bf16(kf[3],qr[1],C1,0,0,0),   P0[14],P0[15],P1[0],P1[1],   pw1[2]=PKW(P0,12),pw1[3]=PKW(P0,14), pw1); \
    VRD(2); SBAR(); GAPA(C0=__builtin_amdgcn_mfma_f32_32x32x16_bf16(kf[4],qr[2],C0,0,0,0),   P1[2],P1[3],P1[4],P1[5],     pw2[0]=PKW(P1,0), pw2[1]=PKW(P1,2), pw2); \
    VRD(6); SBAR(); GAPA(C1=__builtin_amdgcn_mfma_f32_32x32x16_bf16(kf[5],qr[2],C1,0,0,0),   P1[6],P1[7],P1[8],P1[9],     pw2[2]=PKW(P1,4), pw2[3]=PKW(P1,6), pw2); \
    VRD(3); SBAR(); GAPA(C0=__builtin_amdgcn_mfma_f32_32x32x16_bf16(kf[6],qr[3],C0,0,0,0),   P1[10],P1[11],P1[12],P1[13], pw3[0]=PKW(P1,8), pw3[1]=PKW(P1,10), pw3); \
    VRD(7); SBAR(); GAPA(C1=__builtin_amdgcn_mfma_f32_32x32x16_bf16(kf[7],qr[3],C1,0,0,0),   P1[14],P1[15],0.f,0.f,       pw3[2]=PKW(P1,12),pw3[3]=PKW(P1,14), pw3); \
    l_reg+=sacc; \
    if(GK){DMA_K((t)+3,sl_cur);} if(GV){DMA_V((t)+1,sl_next);} \
    CMASK(C0,C1,t); \
    { float a=MX3(C0[0],C0[1],C1[0]),b=MX3(C0[2],C0[3],C1[1]); a=MX3(a,C1[2],C1[3]); \
      _Pragma("unroll") for(int r=4;r<16;r+=4){a=MX3(a,C0[r],C0[r+1]);b=MX3(b,C0[r+2],C0[r+3]);a=MX3(a,C1[r],C1[r+1]);b=MX3(b,C1[r+2],C1[r+3]);} \
      float rm=__builtin_fmaxf(a,b); { auto rr=__builtin_amdgcn_permlane32_swap(__float_as_uint(rm),__float_as_uint(rm),false,false); rm=__builtin_fmaxf(__uint_as_float(rr[0]),__uint_as_float(rr[1])); } \
      resc=false; \
      if(__builtin_expect(__any(rm>(float)THRL),0)){ const float dl=__builtin_fmaxf(rm,0.f); mhat+=dl; \
        _Pragma("unroll") for(int r=0;r<16;++r){C0[r]-=dl;C1[r]-=dl;} \
        const float f=__builtin_amdgcn_exp2f(-dl); l_reg*=f; if(hi==0)wsf[r32]=f; resc=true; } } \
    SBAR(); \
    GAPB(o[0]=__builtin_amdgcn_mfma_f32_32x32x16_bf16(PAF(0),VFR(0),o[0],0,0,0), C0,0); \
    GAPB(o[1]=__builtin_amdgcn_mfma_f32_32x32x16_bf16(PAF(0),VFR(4),o[1],0,0,0), C0,4); \
    KRD(GL,0); GAPB(o[0]=__builtin_amdgcn_mfma_f32_32x32x16_bf16(PAF(1),VFR(1),o[0],0,0,0), C0,8); \
    KRD(GL,1); GAPB(o[1]=__builtin_amdgcn_mfma_f32_32x32x16_bf16(PAF(1),VFR(5),o[1],0,0,0), C0,12); \
    KRD(GL,2); GAPB(o[0]=__builtin_amdgcn_mfma_f32_32x32x16_bf16(PAF(2),VFR(2),o[0],0,0,0), C1,0); \
    KRD(GL,3); GAPB(o[1]=__builtin_amdgcn_mfma_f32_32x32x16_bf16(PAF(2),VFR(6),o[1],0,0,0), C1,4); \
    GAPB(o[0]=__builtin_amdgcn_mfma_f32_32x32x16_bf16(PAF(3),VFR(3),o[0],0,0,0), C1,8); \
    GAPB(o[1]=__builtin_amdgcn_mfma_f32_32x32x16_bf16(PAF(3),VFR(7),o[1],0,0,0), C1,12); \
    }while(0)
  int t=1;
  for(;t+5<NT;t+=2){
    STEP(pB0,pB1,pA0,pA1,t,true,true,true);     WAIT_BAR(2); RESC(); ROT();
    STEP(pA0,pA1,pB0,pB1,t+1,true,true,true);   WAIT_BAR(2); RESC(); ROT();
  }
  #define ENDW(tt) do{ if((tt)+3<NT){WAIT_BAR(2);} else if((tt)+2<NT){WAIT_BAR(1);} else {WAIT_BAR(0);} }while(0)
  for(;t+1<NT;t+=2){
    STEP(pB0,pB1,pA0,pA1,t,(t+3<NT),(t+1<NT),(t+1<NT));       ENDW(t);   RESC(); ROT();
    STEP(pA0,pA1,pB0,pB1,t+1,(t+4<NT),(t+2<NT),(t+2<NT));     ENDW(t+1); RESC(); ROT();
  }
  STEP(pB0,pB1,pA0,pA1,NT-1,false,false,false); RESC();
  { float sacc=pB0[0]+pB0[1]; _Pragma("unroll") for(int r=2;r<16;++r)sacc+=pB0[r]; _Pragma("unroll") for(int r=0;r<16;++r)sacc+=pB1[r]; l_reg+=sacc;
    pw0=(u32x4){PKW(pB0,0),PKW(pB0,2),PKW(pB0,4),PKW(pB0,6)};pw1=(u32x4){PKW(pB0,8),PKW(pB0,10),PKW(pB0,12),PKW(pB0,14)};pw2=(u32x4){PKW(pB1,0),PKW(pB1,2),PKW(pB1,4),PKW(pB1,6)};pw3=(u32x4){PKW(pB1,8),PKW(pB1,10),PKW(pB1,12),PKW(pB1,14)};
    SBAR(); pv(o,vb0+sl_cur,PAF(0),PAF(1),PAF(2),PAF(3)); }
  #undef PKW
  #undef PAF
  #undef VFR
  #undef PIN
  #undef MX3
  #undef GAPA
  #undef GAPB
  #undef EX
  #undef VRD
  #undef KRD
  #undef STEP
  #undef ENDW
  {auto rr=__builtin_amdgcn_permlane32_swap(__float_as_uint(l_reg),__float_as_uint(l_reg),false,false);l_reg=__uint_as_float(rr[0])+__uint_as_float(rr[1]);}
  if(hi==0)wsf[32+r32]=l_reg;asm volatile("s_waitcnt lgkmcnt(0)":::"memory");
  float rli[16];
  #pragma unroll
  for(int r=0;r<16;++r)rli[r]=__builtin_amdgcn_rcpf(wsf[32+crow(r,hi)]);
  bf16*Ow=O+(rowbase+q0+wid*QBLK)*OP+h*D;
  { bf16*stg=(bf16*)(shm+LDS_OST)+wid*2048;
    #pragma unroll
    for(int r=0;r<16;++r){const int orow=crow(r,hi);
      #pragma unroll
      for(int d0=0;d0<2;++d0)stg[orow*64+d0*32+r32]=__float2bfloat16(o[d0][r]*rli[r]);}
    asm volatile("s_waitcnt lgkmcnt(0)":::"memory");
    #pragma unroll
    for(int i=0;i<4;++i){const int row=i*8+(lane>>3),ch=lane&7; const u32x4 v=*(const u32x4*)(stg+row*64+ch*8); ATTN_STORE16(Ow+(long)row*OP+ch*8,v);} }
  asm volatile("s_waitcnt lgkmcnt(0)\n\ts_barrier":::"memory");
  #undef DMA_K
  #undef DMA_V
  #undef KT
  #undef CINIT
  #undef CMASK
  #undef START
  #undef RESC
  #undef ROT
}
constexpr int ATTN_LDS_BYTES=LDS_BYTES;
struct AttnTensors { const bf16* Q; const bf16* K; const bf16* V; bf16* O; const unsigned* SEL; };
struct AttnUnit { int bh; int qb; };
struct StaticOrder {
  int vcu, G;
  __device__ __forceinline__ StaticOrder(int grid,int vcu_):vcu(vcu_),G(grid){}
  __device__ __forceinline__ bool next(int i,AttnUnit&u)const{
    if(G==256){ if(i>=4)return false; const int c=vcu&3; u.bh=vcu>>2; u.qb=(i==0)?15-c:(i==1)?11-c:(i==2)?4+c:c; return true; }
    const int L=i*G+vcu; if(L>=BATCH*NHEAD*NQB)return false; u.qb=NQB-1-L/(BATCH*NHEAD); u.bh=L%(BATCH*NHEAD); return true; }
  __device__ __forceinline__ void a_ready(const AttnUnit&)const{}
  __device__ __forceinline__ void done(const AttnUnit&)const{}
};
template<class Sched,int THRL=8> __device__ __forceinline__ void attn_phase(char*lds,const AttnTensors&T,const Sched&S){
  AttnUnit u;
  for(int i=0;S.next(i,u);++i){ S.a_ready(u); attn_unit<THRL>(u.bh/NHEAD,u.bh%NHEAD,u.qb,T.Q,T.K,T.V,T.O,T.SEL,lds); S.done(u); }
}
#undef SBAR
#undef WAIT_BAR
}

#define GAS __attribute__((address_space(1)))
#define LAS __attribute__((address_space(3)))
typedef unsigned short bf16;
typedef unsigned v4u __attribute__((ext_vector_type(4)));
typedef float f32x4 __attribute__((ext_vector_type(4)));
typedef short bf16x8 __attribute__((ext_vector_type(8)));
typedef GAS unsigned gu32;
typedef GAS unsigned long long gu64;
#define RLX_AGENT __ATOMIC_RELAXED, __HIP_MEMORY_SCOPE_AGENT
#define LDS_WAIT() asm volatile("s_waitcnt lgkmcnt(0)" ::: "memory")
#define VM_WAIT() asm volatile("s_waitcnt vmcnt(0)" ::: "memory")
__device__ __forceinline__ unsigned long long rt() { return __builtin_amdgcn_s_memrealtime(); }
__device__ __forceinline__ unsigned f2bf(float f) { unsigned u = __builtin_bit_cast(unsigned, f); return (u + 0x7fffu + ((u >> 16) & 1u)) >> 16; }
__device__ __forceinline__ unsigned pk2(float lo, float hi) { return f2bf(lo) | (f2bf(hi) << 16); }

#define XB_TMO      128
#define XB_XCNT(j)  (256  + 64 * (j))
#define XB_XSUB(j)  (1280 + 64 * (j))
#define XB_XGEN(j)  (2304 + 64 * (j))
#define XB_TOP      3328
#define XB_TOPGEN   3392
#define XCD_BAR_WORDS 3456
#define XB_SPIN_CAP (1u << 18)

__device__ __forceinline__ unsigned xb_ld(unsigned* p)              { return __hip_atomic_load(p, __ATOMIC_RELAXED, __HIP_MEMORY_SCOPE_AGENT); }
__device__ __forceinline__ unsigned xb_add(unsigned* p, unsigned v) { return __hip_atomic_fetch_add(p, v, __ATOMIC_RELAXED, __HIP_MEMORY_SCOPE_AGENT); }
__device__ __forceinline__ unsigned xb_xcc_id() { return (unsigned)__builtin_amdgcn_s_getreg((3 << 11) | 20) & 0xFu; }
#define XB_SPIN(cond, bar) do { unsigned _sp = 0; while (cond) { __builtin_amdgcn_s_sleep(1); \
    if ((++_sp & 255u) == 0u) { if (xb_ld(&(bar)[XB_TMO])) break; if (_sp > XB_SPIN_CAP) { atomicAdd(&(bar)[XB_TMO], 1u); break; } } } } while (0)

struct XcdBarrier {
    unsigned* bar; unsigned x;
    volatile LAS unsigned* st;
};

__device__ __forceinline__ XcdBarrier xcd_barrier_post(unsigned* bar, volatile LAS unsigned* st) {
    XcdBarrier b; b.bar = bar; b.x = xb_xcc_id(); b.st = st;
    if (threadIdx.x == 0) (void)xb_add(&bar[XB_XCNT(b.x)], 1u);
    return b;
}
__device__ __forceinline__ void xcd_barrier_complete(unsigned* bar, unsigned x, unsigned& nloc, unsigned& nx) {
    const unsigned G = gridDim.x * gridDim.y * gridDim.z;
    unsigned sum, cnt, mine, sp = 0u;
    for (;;) {
        sum = 0u; cnt = 0u; mine = 0u;
#pragma unroll
        for (unsigned j = 0; j < 16; ++j) { const unsigned c = xb_ld(&bar[XB_XCNT(j)]); sum += c; cnt += (c > 0u) ? 1u : 0u; mine = (j == x) ? c : mine; }
        if (sum == G) break;
        __builtin_amdgcn_s_sleep(1);
        if ((++sp & 255u) == 0u) { if (xb_ld(&bar[XB_TMO])) break; if (sp > XB_SPIN_CAP) { atomicAdd(&bar[XB_TMO], 1u); break; } }
    }
    nloc = mine > 0u ? mine : 1u; nx = cnt > 0u ? cnt : 1u;
}

__device__ __forceinline__ void xcd_barrier(const XcdBarrier& b) {
    asm volatile("s_waitcnt vmcnt(0)" ::: "memory");
    __syncthreads();
    if (threadIdx.x == 0) {
        unsigned* bar = b.bar;
        __builtin_amdgcn_s_waitcnt(0);
        unsigned nloc = b.st[0], nx = b.st[1];
        if (nloc == 0u) { xcd_barrier_complete(bar, b.x, nloc, nx); b.st[0] = nloc; b.st[1] = nx; }
        const unsigned old = xb_add(&bar[XB_XSUB(b.x)], 1u);
        const unsigned gen = old / nloc;
        if (old + 1u == (gen + 1u) * nloc) {
            __builtin_amdgcn_fence(__ATOMIC_RELEASE, "agent");
            asm volatile("s_waitcnt vmcnt(0)" ::: "memory");
            const unsigned og = xb_add(&bar[XB_TOP], 1u);
            const unsigned tg = og / nx;
            if (og + 1u == (tg + 1u) * nx) xb_add(&bar[XB_TOPGEN], 1u);
            else XB_SPIN(xb_ld(&bar[XB_TOPGEN]) == tg, bar);
            __builtin_amdgcn_fence(__ATOMIC_ACQUIRE, "agent");
            xb_add(&bar[XB_XGEN(b.x)], 1u);
            asm volatile("s_waitcnt vmcnt(0)" ::: "memory");
        } else {
            XB_SPIN(xb_ld(&bar[XB_XGEN(b.x)]) == gen, bar);
            __builtin_amdgcn_fence(__ATOMIC_ACQUIRE, "agent");
            asm volatile("s_waitcnt vmcnt(0)" ::: "memory");
        }
    }
    __syncthreads();
}


constexpr int NWAVES = 8;
constexpr int RING_OFF = 0, RING_BYTES = 131072;
constexpr int LDSCTL_OFF = RING_BYTES, MISC_OFF = LDSCTL_OFF + 320;
constexpr int LDS_BYTES = 147456;
constexpr int CW_TMO = 0, CW_CODE = 1, CW_BAR = 4096;
constexpr int N_PHASES = 19;

struct Frame {
    LAS unsigned char* lds;
    volatile LAS unsigned* MISC;
    gu32* ctl;
    int tid, lane, wave, vcu, G;
};
struct Args { const float* in[18]; float* out; unsigned char* ws; int ph_lo, ph_hi, li, pad; };

__device__ __forceinline__ float wave_sum(float v) {
#pragma unroll
    for (int o = 1; o < 64; o <<= 1) v += __shfl_xor(v, o);
    return v;
}

struct PrepSeg { const float* W; const float* gain; bf16* dst; int ldin, col0, N, K, ldout, seg, seg_stride; };
__device__ __forceinline__ void prep_item(const PrepSeg& s, LAS float* scr, int item, int lane) {
    const int nblk = s.N / 32, kb = item / nblk, nb = item % nblk, k0 = 64 * kb, n0 = 32 * nb;
#pragma unroll 8
    for (int i = 0; i < 32; ++i) { const int kk = 2 * i + (lane >> 5); const float g = s.gain ? s.gain[k0 + kk] : 1.f; scr[kk * 33 + (lane & 31)] = s.W[(size_t)(k0 + kk) * s.ldin + s.col0 + n0 + (lane & 31)] * g; }
    LDS_WAIT(); asm volatile("" ::: "memory");
    const int c = lane & 7;
#pragma unroll
    for (int j = 0; j < 4; ++j) { const int n = n0 + (lane >> 3) + 8 * j; const LAS float* p = scr + (8 * c) * 33 + (lane >> 3) + 8 * j;
        v4u o; o.x = pk2(p[0 * 33], p[1 * 33]); o.y = pk2(p[2 * 33], p[3 * 33]); o.z = pk2(p[4 * 33], p[5 * 33]); o.w = pk2(p[6 * 33], p[7 * 33]);
        const int drow = (n / s.seg) * s.seg_stride + (n % s.seg);
        *(GAS v4u*)(s.dst + (size_t)drow * s.ldout + k0 + 8 * c) = o; }
    LDS_WAIT(); asm volatile("" ::: "memory");
}
constexpr int NSEG = 14;
__device__ const int SEG_DSTC[9] = {C_MQ, C_MK, C_MV, C_GQ, C_GK, C_GV, C_GR, C_PU, 0};
__device__ const int SEG_SRCC[9] = {O_MQ, O_MK, O_MV, O_GQ, O_GK, O_GV, O_GR, O_PU, O_GATE};
__device__ const int SEG_NN[9] = {512, 512, 512, 256, 256, 512, 512, 512, NGATE};
__device__ __forceinline__ void get_seg(const Args& a, int l, int s, PrepSeg& d) {
    unsigned char* wl = a.ws + WS_W + (size_t)l * W_LAYER;
    const float* win = a.in[2] + (size_t)l * DM * DIN; const float* gpre = a.in[1] + l * DM; const float* gffn = a.in[13] + l * DM;
    d.seg = 1 << 30; d.seg_stride = 0; d.gain = nullptr; d.col0 = 0;
    if (s < 9) {
        d.W = win; d.gain = gpre; d.ldin = DIN; d.col0 = SEG_SRCC[s]; d.N = SEG_NN[s]; d.K = DM; d.ldout = DM;
        d.dst = (s < 8) ? (bf16*)(wl + W_IN) + (size_t)SEG_DSTC[s] * DM : (bf16*)(wl + W_GATE);
    } else if (s == 9)  { d.W = a.in[8] + (size_t)l * 512 * 1024; d.ldin = 1024; d.N = 1024; d.K = 512; d.ldout = KBR; d.dst = (bf16*)(wl + W_BR); }
    else if (s == 10) { d.W = a.in[10] + (size_t)l * 512 * 1024; d.ldin = 1024; d.N = 1024; d.K = 512; d.ldout = KBR; d.dst = (bf16*)(wl + W_BR) + 1024; }
    else if (s == 11) { d.W = a.in[11] + (size_t)l * 1024 * 1024; d.ldin = 1024; d.N = 1024; d.K = 1024; d.ldout = DM; d.dst = (bf16*)(wl + W_OUT); }
    else if (s == 12) { d.W = a.in[14] + (size_t)l * DM * DFF; d.gain = gffn; d.ldin = DFF; d.N = DFF; d.K = DM; d.ldout = DM; d.dst = (bf16*)(wl + W_GU); d.seg = 128; d.seg_stride = 256; }
    else              { d.W = a.in[15] + (size_t)l * DM * DFF; d.gain = gffn; d.ldin = DFF; d.N = DFF; d.K = DM; d.ldout = DM; d.dst = (bf16*)(wl + W_GU) + (size_t)128 * DM; d.seg = 128; d.seg_stride = 256; }
}
__device__ __forceinline__ void p0_prologue(Frame& F, const Args& a) {
    int tid_ = threadIdx.x; asm volatile("" : "+v"(tid_)); const int tid = tid_, lane = tid & 63;
    LAS float* scr = (LAS float*)(F.lds + RING_OFF + F.wave * 16384);
    const int gw = F.vcu * NWAVES + F.wave, NGW = F.G * NWAVES;
    int base = 0;
    for (int l = 0; l < DEPTH; ++l) {
        for (int s = 0; s < NSEG + 1; ++s) {
            PrepSeg d;
            if (s < NSEG) get_seg(a, l, s, d);
            else { d.W = a.in[16] + (size_t)l * DFF * DM; d.gain = nullptr; d.ldin = DM; d.col0 = 0; d.N = DM; d.K = DFF; d.ldout = DFF; d.dst = (bf16*)(a.ws + WS_W + (size_t)l * W_LAYER + W_DN); d.seg = 1 << 30; d.seg_stride = 0; }
            const int nitems = (d.K / 64) * (d.N / 32);
            int first = gw - (base % NGW); if (first < 0) first += NGW;
            for (int it = first; it < nitems; it += NGW) prep_item(d, scr, it, lane);
            base += nitems;
        }
        const float* wp = a.in[6] + (size_t)l * 4 * 128 * 128; const float* sc = a.in[7] + l * 512; const float* Wb = a.in[9] + (size_t)l * 512 * 1024;
        bf16* WBR_t = (bf16*)(a.ws + WS_W + (size_t)l * W_LAYER + W_BR);
        for (int idx = (F.vcu * NWAVES * 64) + tid; idx < 64 * 1024; idx += F.G * NWAVES * 64) {
            const int n = idx & 1023, c8 = idx >> 10, g = c8 >> 4, c0 = (c8 & 15) * 8;
            float s8[8];
#pragma unroll
            for (int i = 0; i < 8; ++i) s8[i] = 0.f;
            for (int d = 0; d < 128; ++d) { const float wb = sc[g * 128 + d] * Wb[(size_t)(g * 128 + d) * 1024 + n];
#pragma unroll
                for (int i = 0; i < 8; ++i) s8[i] += wp[((size_t)g * 128 + c0 + i) * 128 + d] * wb; }
            v4u o; o.x = pk2(s8[0], s8[1]); o.y = pk2(s8[2], s8[3]); o.z = pk2(s8[4], s8[5]); o.w = pk2(s8[6], s8[7]);
            *(GAS v4u*)(WBR_t + (size_t)n * KBR + 512 + g * 128 + c0) = o;
        }
    }
}
__device__ __forceinline__ void rows_phase(Frame& F, const float* xsrc, const bf16* Fin, const float* wpost, float* xdst, bf16* XB, float* R, float* G1, const float* g1_win, const float* g1_gain) {
    int tid_ = threadIdx.x; asm volatile("" : "+v"(tid_)); const int tid = tid_;
    LAS float* wt = (LAS float*)(F.lds + RING_OFF);
    if (g1_win) {
        for (int idx = tid; idx < 16 * 1024; idx += NWAVES * 64) { const int k = idx >> 4, j = idx & 15; wt[j * 1024 + k] = g1_gain[k] * g1_win[(size_t)k * DIN + O_G1 + j]; }
        __syncthreads();
    }
    const int gw = F.vcu * NWAVES + F.wave, NGW = F.G * NWAVES, lane = tid & 63;
    for (int m = gw; m < M; m += NGW) {
        const GAS f32x4* xr = (const GAS f32x4*)(xsrc + (size_t)m * DM) + lane;
        f32x4 v[4];
#pragma unroll
        for (int j = 0; j < 4; ++j) v[j] = xr[64 * j];
        if (Fin) {
            const GAS unsigned long long* fr8 = (const GAS unsigned long long*)(Fin + (size_t)m * DM) + lane;
            f32x4 f[4]; float s = 0.f;
#pragma unroll
            for (int j = 0; j < 4; ++j) { const unsigned long long w = fr8[64 * j]; const unsigned lo = (unsigned)w, hi = (unsigned)(w >> 32);
                f[j] = (f32x4){__uint_as_float(lo << 16), __uint_as_float(lo & 0xffff0000u), __uint_as_float(hi << 16), __uint_as_float(hi & 0xffff0000u)};
                s += (f[j].x * f[j].x + f[j].y * f[j].y) + (f[j].z * f[j].z + f[j].w * f[j].w); }
            const float rf = 1.f / sqrtf(wave_sum(s) * (1.f / DM) + EPS);
#pragma unroll
            for (int j = 0; j < 4; ++j) { const f32x4 w = ((const GAS f32x4*)wpost)[64 * j + lane]; v[j] = v[j] + f[j] * rf * w; }
        }
        if (xdst) { GAS f32x4* xo = (GAS f32x4*)(xdst + (size_t)m * DM) + lane;
#pragma unroll
            for (int j = 0; j < 4; ++j) xo[64 * j] = v[j]; }
        if (XB) {
            float s = 0.f;
#pragma unroll
            for (int j = 0; j < 4; ++j) s += (v[j].x * v[j].x + v[j].y * v[j].y) + (v[j].z * v[j].z + v[j].w * v[j].w);
            const float r = 1.f / sqrtf(wave_sum(s) * (1.f / DM) + EPS);
            GAS unsigned long long* o8 = (GAS unsigned long long*)(XB + (size_t)m * DM) + lane;
#pragma unroll
            for (int j = 0; j < 4; ++j) o8[64 * j] = (unsigned long long)pk2(v[j].x, v[j].y) | ((unsigned long long)pk2(v[j].z, v[j].w) << 32);
            if (lane == 0) R[m] = r;
            if (g1_win) {
                float mine = 0.f;
#pragma unroll
                for (int jj = 0; jj < 16; ++jj) { float d = 0.f;
#pragma unroll
                    for (int j = 0; j < 4; ++j) { const f32x4 w = *(const LAS f32x4*)(wt + jj * 1024 + 4 * (64 * j + lane)); d += (v[j].x * w.x + v[j].y * w.y) + (v[j].z * w.z + v[j].w * w.w); }
                    d = wave_sum(d); if (lane == jj) mine = d; }
                if (lane < 16) G1[(size_t)m * 16 + lane] = mine * r;
            }
        }
    }
    if (g1_win) __syncthreads();
}


constexpr size_t WS_SEL = 5 * MiB;
__device__ __forceinline__ void kmean_phase(Frame& F, const bf16* PM, float* KM) {
    int tid_ = threadIdx.x; asm volatile("" : "+v"(tid_)); const int lane = tid_ & 63;
    const int gw = F.vcu * NWAVES + F.wave, NGW = F.G * NWAVES;
    for (int u = gw; u < BATCH * 16 * 8; u += NGW) {
        const int h = u & 7, n = (u >> 3) & 15, b = u >> 7;
        const bf16* p = PM + ((size_t)b * SEQ + n * 256) * NMIX + C_MK + h * 64 + lane;
        float s0 = 0.f, s1 = 0.f, s2 = 0.f, s3 = 0.f;
        for (int i = 0; i < 256; i += 4) { s0 += __uint_as_float((unsigned)p[(size_t)i * NMIX] << 16); s1 += __uint_as_float((unsigned)p[(size_t)(i + 1) * NMIX] << 16);
            s2 += __uint_as_float((unsigned)p[(size_t)(i + 2) * NMIX] << 16); s3 += __uint_as_float((unsigned)p[(size_t)(i + 3) * NMIX] << 16); }
        KM[(((size_t)b * 8 + h) * 16 + n) * 64 + lane] = ((s0 + s1) + (s2 + s3)) * (1.f / 256.f);
    }
}
__device__ __forceinline__ void topk_phase(Frame& F, const bf16* PM, const float* KM, unsigned* SEL) {
    int tid_ = threadIdx.x; asm volatile("" : "+v"(tid_)); const int lane = tid_ & 63;
    const int gw = F.vcu * NWAVES + F.wave, NGW = F.G * NWAVES;
    for (int u = gw; u < (M / 64) * 8; u += NGW) {
        const int h = u & 7, m0 = (u >> 3) * 64, m = m0 + lane, b = m0 >> 12, j = (m0 & (SEQ - 1)) >> 8;
        float q[64];
        const unsigned* qp = (const unsigned*)(PM + (size_t)m * NMIX + C_MQ + h * 64);
#pragma unroll
        for (int d = 0; d < 32; ++d) { const unsigned w = qp[d]; q[2 * d] = __uint_as_float(w << 16); q[2 * d + 1] = __uint_as_float(w & 0xffff0000u); }
        float b0 = -3e38f, b1 = -3e38f, b2 = -3e38f; int i0 = -1, i1 = -1, i2 = -1;
        for (int n = 0; n < j; ++n) {
            const float* km = KM + (((size_t)b * 8 + h) * 16 + n) * 64;
            float g = 0.f;
#pragma unroll
            for (int d = 0; d < 64; ++d) g += q[d] * km[d];
            if (g > b0) { b2 = b1; i2 = i1; b1 = b0; i1 = i0; b0 = g; i0 = n; }
            else if (g > b1) { b2 = b1; i2 = i1; b1 = g; i1 = n; }
            else if (g > b2) { b2 = g; i2 = n; }
        }
        unsigned sel = 0u;
        if (i0 >= 0) sel |= 1u << i0;
        if (i1 >= 0) sel |= 1u << i1;
        if (i2 >= 0) sel |= 1u << i2;
        SEL[((size_t)b * 8 + h) * SEQ + (m & (SEQ - 1))] = sel;
    }
}

__global__ void __launch_bounds__(NWAVES * 64, 2) mega_fwd(Args args) {
    extern __shared__ __attribute__((aligned(16))) unsigned char lds[];
    Frame F;
    F.lds = (LAS unsigned char*)lds;
    F.MISC = (volatile LAS unsigned*)(F.lds + MISC_OFF);
    F.tid = threadIdx.x; F.lane = F.tid & 63; F.wave = __builtin_amdgcn_readfirstlane(F.tid >> 6);
    F.G = gridDim.x; { const int bx = blockIdx.x; F.vcu = (F.G % 8 == 0) ? (bx % 8) * (F.G / 8) + bx / 8 : bx; }
    unsigned char* ws = args.ws;
    F.ctl = (gu32*)(ws + WS_CTL);
    for (int u = F.tid; u < (LDS_BYTES - LDSCTL_OFF) / 4; u += NWAVES * 64) ((LAS unsigned*)(F.lds + LDSCTL_OFF))[u] = 0u;
    __syncthreads();
    XcdBarrier bar = xcd_barrier_post((unsigned*)(F.ctl + CW_BAR) + args.li * XCD_BAR_WORDS, F.MISC + 8);
    const int lo = args.ph_lo, hi = args.ph_hi;
#define IN(k) (lo <= (k) && (k) < hi)
#define SEAM(k) do { if (IN(k) && IN((k) + 1)) xcd_barrier(bar); } while (0)
    const float* x = args.in[0]; float* out = args.out;
    float* R = (float*)(ws + WS_R); float* G1 = (float*)(ws + WS_G1);
    bf16* XB = (bf16*)(ws + WS_XB); bf16* PM = (bf16*)(ws + WS_PM); bf16* MO = (bf16*)(ws + WS_MO);
    bf16* GATES = (bf16*)(ws + WS_GATES); bf16* MIXED = (bf16*)(ws + WS_MIXED); bf16* F1 = (bf16*)(ws + WS_F1); bf16* HDN = (bf16*)(ws + WS_HDN); bf16* F2 = (bf16*)(ws + WS_F2);

    if (IN(0)) { p0_prologue(F, args); __syncthreads();     rows_phase(F, x, nullptr, nullptr, nullptr, XB, R, G1, args.in[2], args.in[1]); }
    SEAM(0);
    for (int l = 0; l < DEPTH; ++l) {
        const int pb = 1 + 9 * l;
        unsigned char* wl = ws + WS_W + (size_t)l * W_LAYER;
        const bf16* WIN_t = (const bf16*)(wl + W_IN); const bf16* WGATE_t = (const bf16*)(wl + W_GATE); const bf16* WBR_t = (const bf16*)(wl + W_BR);
        const bf16* WOUT_t = (const bf16*)(wl + W_OUT); const bf16* WGU_t = (const bf16*)(wl + W_GU); const bf16* WDN_t = (const bf16*)(wl + W_DN);
        if (IN(pb + 0)) {
            pg8::Gemm g{XB, WIN_t, M, NMIX, DM, DM, 0}; pg8::StaticOrder S; S.init(M, NMIX, F.G, (int)blockIdx.x);
            pg8::EpiProj E{PM, R};
            pg8::gemm_phase<pg8::EpiProj, pg8::StaticOrder, true, true>(F.lds + RING_OFF, g, S, E);
        }
        SEAM(pb + 0);
        if (IN(pb + 1)) {
            float* KM = (float*)(ws + WS_KM); unsigned* SEL = (unsigned*)(ws + WS_SEL);
            kmean_phase(F, PM, KM); xcd_barrier(bar);
            topk_phase(F, PM, KM, SEL); xcd_barrier(bar);
            const attn_body::AttnTensors AT{(const attn_body::bf16*)(PM + C_MQ), (const attn_body::bf16*)(PM + C_MK), (const attn_body::bf16*)(PM + C_MV), (attn_body::bf16*)(MO + 1024), SEL};
            const attn_body::StaticOrder S((int)F.G, F.vcu);
            attn_body::attn_phase<attn_body::StaticOrder>((char*)lds + RING_OFF, AT, S);
        }
        SEAM(pb + 1);
        if (IN(pb + 2)) {
            pg8::Gemm g{XB, WGATE_t, M, NGATE, DM, DM, 0}; pg8::StaticOrder S; S.init(M, NGATE, F.G, (int)blockIdx.x);
            pg8::EpiSig E{GATES, R};
            pg8::gemm_phase<pg8::EpiSig, pg8::StaticOrder, true, true>(F.lds + RING_OFF, g, S, E);
        }
        SEAM(pb + 2);
        if (IN(pb + 3)) {
            pg8::Gemm g{MO, WBR_t, M, DM, KBR, 512, 1024}; pg8::SegOrder3 S; S.S.init(M, DM, F.G, (int)blockIdx.x);
            pg8::EpiMixed E{MIXED, GATES};
            pg8::gemm_phase<pg8::EpiMixed, pg8::SegOrder3, true, true>(F.lds + RING_OFF, g, S, E);
        }
        SEAM(pb + 3);
        if (IN(pb + 4)) {
            pg8::Gemm g{MIXED, WOUT_t, M, DM, DM, DM, 0}; pg8::StaticOrder S; S.init(M, DM, F.G, (int)blockIdx.x);
            pg8::EpiPlain E{F1};
            pg8::gemm_phase<pg8::EpiPlain, pg8::StaticOrder, true, true>(F.lds + RING_OFF, g, S, E);
        }
        SEAM(pb + 4);
        if (IN(pb + 5)) rows_phase(F, l == 0 ? x : out, F1, args.in[12] + l * DM, out, XB, R, nullptr, nullptr, nullptr);
        SEAM(pb + 5);
        if (IN(pb + 6)) {
            pg8::Gemm g{XB, WGU_t, M, 2 * DFF, DM, DM, 0}; pg8::StaticOrder S; S.init(M, 2 * DFF, F.G, (int)blockIdx.x);
            pg8::EpiSwiglu E{HDN, R};
            pg8::gemm_phase<pg8::EpiSwiglu, pg8::StaticOrder, true, true>(F.lds + RING_OFF, g, S, E);
        }
        SEAM(pb + 6);
        if (IN(pb + 7)) {
            pg8::Gemm g{HDN, WDN_t, M, DM, DFF, DFF, 0}; pg8::StaticOrder S; S.init(M, DM, F.G, (int)blockIdx.x);
            pg8::EpiPlain E{F2};
            pg8::gemm_phase<pg8::EpiPlain, pg8::StaticOrder, true, true>(F.lds + RING_OFF, g, S, E);
        }
        SEAM(pb + 7);
        if (IN(pb + 8)) {
            const bool last = (l == DEPTH - 1);
            rows_phase(F, out, F2, args.in[17] + l * DM, out, last ? nullptr : XB, last ? nullptr : R, last ? nullptr : G1,
                       last ? nullptr : args.in[2] + (size_t)(l + 1) * DM * DIN, last ? nullptr : args.in[1] + (l + 1) * DM);
        }
        SEAM(pb + 8);
    }
#undef IN
#undef SEAM
}

__device__ __forceinline__ float bf2f(unsigned v) { return __uint_as_float(v << 16); }
__global__ void k_gla_gate(const float* __restrict__ G1, const float* __restrict__ w2, const float* __restrict__ bg, float* LA) {
    const int m = blockIdx.x, c = threadIdx.x;
    float s = bg[c];
#pragma unroll
    for (int j = 0; j < 16; ++j) s += G1[m * 16 + j] * w2[j * 256 + c];
    const float ls = fminf(s, 0.f) - log1pf(__expf(-fabsf(s)));
    LA[(size_t)m * 256 + c] = ls * (1.f / 16.f);
}
__global__ void __launch_bounds__(64) k_gla_scan(const bf16_t* __restrict__ PM, const float* __restrict__ LA, bf16_t* MO) {
    __shared__ float qs[64 * 64], ks[64 * 64], as[64 * 64];
    const int bh = blockIdx.x, b = bh >> 2, h = bh & 3, tid = threadIdx.x, col = blockIdx.y * 64 + tid;
    float S[64];
#pragma unroll
    for (int d = 0; d < 64; ++d) S[d] = 0.f;
    for (int c = 0; c < 64; ++c) {
        const size_t row0 = (size_t)b * SEQ + c * 64;
        __syncthreads();
        for (int t = 0; t < 64; ++t) {
            qs[t * 64 + tid] = bf2f(PM[(row0 + t) * NMIX + C_GQ + h * 64 + tid]);
            ks[t * 64 + tid] = bf2f(PM[(row0 + t) * NMIX + C_GK + h * 64 + tid]);
            as[t * 64 + tid] = __expf(LA[(row0 + t) * 256 + h * 64 + tid]);
        }
        __syncthreads();
        for (int t = 0; t < 64; ++t) {
            const float v = bf2f(PM[(row0 + t) * NMIX + C_GV + h * 128 + col]);
            float o = 0.f;
#pragma unroll
            for (int d = 0; d < 64; ++d) { S[d] = as[t * 64 + d] * S[d] + ks[t * 64 + d] * v; o += qs[t * 64 + d] * S[d]; }
            MO[(row0 + t) * KBR + h * 128 + col] = f2bf(o);
        }
    }
}
__global__ void k_gla_post(const bf16_t* __restrict__ PM, const float* __restrict__ norm_w, bf16_t* MO) {
    const int m = blockIdx.x, h = threadIdx.x >> 6, lane = threadIdx.x & 63;
    const unsigned ow = *(const unsigned*)(MO + (size_t)m * KBR + h * 128 + lane * 2);
    const float o0 = bf2f(ow & 0xffffu), o1 = bf2f(ow >> 16);
    const float ss = wave_sum(o0 * o0 + o1 * o1);
    const float rn = rsqrtf(ss * (1.f / 128.f) + EPS);
    const unsigned rw = *(const unsigned*)(PM + (size_t)m * NMIX + C_GR + h * 128 + lane * 2);
    const float y0 = o0 * rn * norm_w[lane * 2] * bf2f(rw & 0xffffu), y1 = o1 * rn * norm_w[lane * 2 + 1] * bf2f(rw >> 16);
    *(unsigned*)(MO + (size_t)m * KBR + h * 128 + lane * 2) = (unsigned)f2bf(y0) | ((unsigned)f2bf(y1) << 16);
}
__global__ void k_pool(const bf16_t* __restrict__ PM, bf16_t* MO) {
    const int m = blockIdx.x, t = m & (SEQ - 1);
    for (int c = threadIdx.x; c < 512; c += 256) {
        const int w = 2 << (c >> 7);
        const int cnt = (t + 1 < w) ? (t + 1) : w;
        float s = 0.f;
        for (int i = 0; i < cnt; ++i) s += bf2f(PM[(size_t)(m - i) * NMIX + C_PU + c]);
        const float u = bf2f(PM[(size_t)m * NMIX + C_PU + c]);
        MO[(size_t)m * KBR + 512 + c] = f2bf(s / (float)cnt - u);
    }
}

extern "C" void kernel_launch(void* const* d_in, const int* in_sizes, int n_in, void* d_out, int out_size, void* d_ws, size_t ws_size, hipStream_t stream) {
    static int grid = 0;
    if (grid == 0) {
        if (n_in != 18 || in_sizes[0] != M * DM || out_size != M * DM || ws_size < WS_END) { fprintf(stderr, "kernel_launch: unexpected shapes (n_in %d, out %d, ws %zu); nothing launched\n", n_in, out_size, ws_size); grid = -1; return; }
        int dev = 0, cus = 0, per_cu = 0;
        if (hipGetDevice(&dev) != hipSuccess || hipDeviceGetAttribute(&cus, hipDeviceAttributeMultiprocessorCount, dev) != hipSuccess) { grid = -1; return; }
        if (hipFuncSetAttribute((const void*)mega_fwd, hipFuncAttributeMaxDynamicSharedMemorySize, LDS_BYTES) != hipSuccess) { fprintf(stderr, "kernel_launch: hipFuncSetAttribute failed\n"); grid = -1; return; }
        if (hipOccupancyMaxActiveBlocksPerMultiprocessor(&per_cu, (const void*)mega_fwd, NWAVES * 64, LDS_BYTES) != hipSuccess || per_cu < 1) { fprintf(stderr, "kernel_launch: occupancy query reports %d blocks per CU; nothing launched\n", per_cu); (void)hipGetLastError(); grid = -1; return; }
        grid = cus;
    }
    if (grid < 0) return;
    if (hipMemsetAsync((char*)d_ws + WS_CTL, 0, CTL_ZERO_BYTES, stream) != hipSuccess) return;
    Args a{};
    for (int i = 0; i < 18; ++i) a.in[i] = (const float*)d_in[i];
    a.out = (float*)d_out; a.ws = (unsigned char*)d_ws;
    unsigned char* ws = (unsigned char*)d_ws;
    float* G1 = (float*)(ws + WS_G1); float* LA = (float*)(ws + WS_SP);
    bf16_t* PM = (bf16_t*)(ws + WS_PM); bf16_t* MO = (bf16_t*)(ws + WS_MO);
    const float* gla_w_g2 = (const float*)d_in[3]; const float* gla_b_g = (const float*)d_in[4]; const float* gla_norm = (const float*)d_in[5];
    const int cuts[4] = {0, 2, 11, N_PHASES};
    for (int li = 0; li < 3; ++li) {
        a.ph_lo = cuts[li]; a.ph_hi = cuts[li + 1]; a.li = li;
        hipLaunchKernelGGL(mega_fwd, dim3(grid), dim3(NWAVES * 64), LDS_BYTES, stream, a);
        if (li < 2) {
            const int l = li;
            k_gla_gate<<<M, 256, 0, stream>>>(G1, gla_w_g2 + l * 16 * 256, gla_b_g + l * 256, LA);
            k_gla_scan<<<dim3(BATCH * 4, 2), 64, 0, stream>>>(PM, LA, MO);
            k_gla_post<<<M, 256, 0, stream>>>(PM, gla_norm + l * 128, MO);
            k_pool<<<M, 256, 0, stream>>>(PM, MO);
        }
    }
}
```

```cpp
#include <hip/hip_runtime.h>
#include <hip/hip_bf16.h>
#include <cmath>
#include <stdint.h>
#include <cstdio>

constexpr int BATCH = 8, SEQ = 4096, DM = 1024, M = BATCH * SEQ, DEPTH = 2;
constexpr int DIN = 6672, NMIX = 3584, NGATE = 3072, DFF = 2816, KBR = 1536;
constexpr int C_MQ = 0, C_MK = 512, C_MV = 1024, C_GQ = 1536, C_GK = 1792, C_GV = 2048, C_GR = 2560, C_PU = 3072;
constexpr int O_GQ = 0, O_GK = 256, O_GV = 512, O_G1 = 1024, O_GR = 1040, O_PU = 1552, O_MQ = 2064, O_MK = 2576, O_MV = 3088, O_GATE = 3600;
constexpr float EPS = 1e-6f;

constexpr size_t MiB = 1u << 20;
constexpr size_t WS_CTL = 0, CTL_ZERO_BYTES = 1 * MiB;
constexpr size_t WS_R = 1 * MiB;
constexpr size_t WS_G1 = 2 * MiB;
constexpr size_t WS_KM = 4 * MiB;
constexpr size_t WS_W = 6 * MiB, W_LAYER = 35 * MiB;
constexpr size_t W_IN = 0, W_GATE = 7 * MiB, W_BR = 13 * MiB, W_OUT = 16 * MiB, W_GU = 18 * MiB, W_DN = 29 * MiB;
constexpr size_t WS_XB = 76 * MiB;
constexpr size_t WS_PM = 140 * MiB;
constexpr size_t WS_MO = 364 * MiB;
constexpr size_t WS_UT = 460 * MiB;
constexpr size_t WS_EF = 492 * MiB;
constexpr size_t WS_GATES = WS_PM;
constexpr size_t WS_MIXED = WS_XB;
constexpr size_t WS_F1 = WS_MO;
constexpr size_t WS_HDN = WS_PM;
constexpr size_t WS_F2 = WS_MO;
constexpr size_t WS_END = 512 * MiB;

typedef unsigned short bf16_t;
namespace pg8 {
#define PG8_LAS __attribute__((address_space(3)))
typedef unsigned short bf16_t;
typedef short bf16x8 __attribute__((ext_vector_type(8)));
typedef float f32x4 __attribute__((ext_vector_type(4)));
typedef unsigned u32x4 __attribute__((ext_vector_type(4)));
constexpr int BM = 256, BK = 64, HALF = 128, HTB = HALF * BK * 2  , STAGE_BYTES = 8 * HTB, NXCD = 8, WGM = 8;

__host__ __device__ __forceinline__ int lds_byte(int r, int c) { const int st = (r >> 4) * 2 + (c >> 5), rr = r & 15, cc = c & 31, ob = rr * 64 + cc * 2; return st * 1024 + (ob ^ (((ob >> 9) & 1) << 5)); }
__host__ __device__ __forceinline__ void stage_rc(int b, int& R, int& C) { const int st = b / 1024, sb = b % 1024, swz = sb ^ (((sb >> 9) & 1) << 5); R = (st >> 1) * 16 + swz / 64; C = (st & 1) * 32 + (swz % 64) / 2; }
__host__ __device__ __forceinline__ int perm32(int rho) { const int n = rho >> 4, i = rho & 15; return 8 * (i >> 2) + 4 * n + (i & 3); }

struct Unit { int pm, pn, ks; };
struct Gemm { const bf16_t* A; const bf16_t* Bt; int M, N, K, Kt, ksb; };

struct StaticOrder {
    int nM, nN, nwg, G, c;
    __host__ __device__ void init(int M, int N, int G_, int c_) { nM = M / BM; nN = N / BM; nwg = nM * nN; G = G_; c = c_; }
    __host__ __device__ bool next(int i, Unit& u) const {
        const long L = (long)i * G + c; if (L >= nwg) return false;
        int wgid = (int)L; { const int q = nwg / NXCD, r = nwg % NXCD, xcd = wgid % NXCD, off = wgid / NXCD; wgid = (xcd < r ? xcd * (q + 1) : r * (q + 1) + (xcd - r) * q) + off; }
        const int nig = WGM * nN, gid = wgid / nig, fm = gid * WGM, gsz = (nM - fm) < WGM ? (nM - fm) : WGM;
        u.pm = fm + ((wgid % nig) % gsz); u.pn = (wgid % nig) / gsz; u.ks = 0; return true;
    }
    __device__ __forceinline__ void a_ready(const Unit&) const {}
    __device__ __forceinline__ void done(const Unit&) const {}
};

__device__ __forceinline__ unsigned cvt_pk_bf16(float lo, float hi) { unsigned r; asm volatile("v_cvt_pk_bf16_f32 %0, %1, %2" : "=v"(r) : "v"(lo), "v"(hi)); return r; }
struct SegOrder3 {
    StaticOrder S;
    __device__ __forceinline__ bool next(int i, Unit& u) const { const int q = i / 3; if (!S.next(q, u)) return false; u.ks = i - 3 * q; return true; }
    __device__ __forceinline__ void a_ready(const Unit&) const {}
    __device__ __forceinline__ void done(const Unit&) const {}
};
__device__ __forceinline__ float fast_sigmoid(float x) { return __builtin_amdgcn_rcpf(1.f + __expf(-x)); }
__device__ __forceinline__ float bflo(unsigned w) { return __uint_as_float(w << 16); }
__device__ __forceinline__ float bfhi(unsigned w) { return __uint_as_float(w & 0xffff0000u); }
struct EpiProj {
    static constexpr bool PERM = true, AFTER_DRAIN = false, SEGS = false;
    bf16_t* O; const float* R;
    __device__ __forceinline__ void operator()(const f32x4 (&acc)[2][2][4][2], const Unit& u, int wr, int wc, int fr, int fq) const {
        const int pn = u.pn; const float cs = (pn < 2) ? 0.125f * 1.4426950408889634f : (pn == 6) ? 0.125f : 1.f; const bool silu = (pn == 10 || pn == 11);
        const int row0 = u.pm * BM + wr * 64 + fr, col0 = pn * BM + wc * 32 + 8 * fq;
#pragma unroll
        for (int ai = 0; ai < 2; ++ai)
#pragma unroll
            for (int m = 0; m < 4; ++m) { const int row = row0 + ai * HALF + m * 16; const float r = R[row] * cs; bf16_t* rowp = O + (size_t)row * 3584 + col0;
#pragma unroll
                for (int bj = 0; bj < 2; ++bj) { f32x4 v0 = acc[ai][bj][m][0] * r, v1 = acc[ai][bj][m][1] * r;
                    if (silu) {
#pragma unroll
                        for (int i = 0; i < 4; ++i) { v0[i] = v0[i] * fast_sigmoid(v0[i]); v1[i] = v1[i] * fast_sigmoid(v1[i]); } }
                    u32x4 w; w.x = cvt_pk_bf16(v0[0], v0[1]); w.y = cvt_pk_bf16(v0[2], v0[3]); w.z = cvt_pk_bf16(v1[0], v1[1]); w.w = cvt_pk_bf16(v1[2], v1[3]);
                    *(u32x4*)(rowp + bj * HALF) = w; } }
    }
};
struct EpiSig {
    static constexpr bool PERM = true, AFTER_DRAIN = false, SEGS = false;
    bf16_t* O; const float* R;
    __device__ __forceinline__ void operator()(const f32x4 (&acc)[2][2][4][2], const Unit& u, int wr, int wc, int fr, int fq) const {
        const int row0 = u.pm * BM + wr * 64 + fr, col0 = u.pn * BM + wc * 32 + 8 * fq;
#pragma unroll
        for (int ai = 0; ai < 2; ++ai)
#pragma unroll
            for (int m = 0; m < 4; ++m) { const int row = row0 + ai * HALF + m * 16; const float r = R[row]; bf16_t* rowp = O + (size_t)row * 3072 + col0;
#pragma unroll
                for (int bj = 0; bj < 2; ++bj) { f32x4 v0 = acc[ai][bj][m][0] * r, v1 = acc[ai][bj][m][1] * r;
#pragma unroll
                    for (int i = 0; i < 4; ++i) { v0[i] = fmaxf(fast_sigmoid(v0[i]), 1e-18f); v1[i] = fmaxf(fast_sigmoid(v1[i]), 1e-18f); }
                    u32x4 w; w.x = cvt_pk_bf16(v0[0], v0[1]); w.y = cvt_pk_bf16(v0[2], v0[3]); w.z = cvt_pk_bf16(v1[0], v1[1]); w.w = cvt_pk_bf16(v1[2], v1[3]);
                    *(u32x4*)(rowp + bj * HALF) = w; } }
    }
};
struct EpiPlain {
    static constexpr bool PERM = true, AFTER_DRAIN = false, SEGS = false;
    bf16_t* O;
    __device__ __forceinline__ void operator()(const f32x4 (&acc)[2][2][4][2], const Unit& u, int wr, int wc, int fr, int fq) const {
        const int row0 = u.pm * BM + wr * 64 + fr, col0 = u.pn * BM + wc * 32 + 8 * fq;
#pragma unroll
        for (int ai = 0; ai < 2; ++ai)
#pragma unroll
            for (int m = 0; m < 4; ++m) { bf16_t* rowp = O + (size_t)(row0 + ai * HALF + m * 16) * 1024 + col0;
#pragma unroll
                for (int bj = 0; bj < 2; ++bj) { const f32x4 v0 = acc[ai][bj][m][0], v1 = acc[ai][bj][m][1];
                    u32x4 w; w.x = cvt_pk_bf16(v0[0], v0[1]); w.y = cvt_pk_bf16(v0[2], v0[3]); w.z = cvt_pk_bf16(v1[0], v1[1]); w.w = cvt_pk_bf16(v1[2], v1[3]);
                    *(u32x4*)(rowp + bj * HALF) = w; } }
    }
};
struct EpiSwiglu {
    static constexpr bool PERM = true, AFTER_DRAIN = false, SEGS = false;
    bf16_t* O; const float* R;
    __device__ __forceinline__ void operator()(const f32x4 (&acc)[2][2][4][2], const Unit& u, int wr, int wc, int fr, int fq) const {
        const int row0 = u.pm * BM + wr * 64 + fr, col0 = u.pn * HALF + wc * 32 + 8 * fq;
#pragma unroll
        for (int ai = 0; ai < 2; ++ai)
#pragma unroll
            for (int m = 0; m < 4; ++m) { const int row = row0 + ai * HALF + m * 16; const float r = R[row];
                f32x4 h0, h1;
#pragma unroll
                for (int i = 0; i < 4; ++i) { const float g0 = acc[ai][0][m][0][i] * r, g1 = acc[ai][0][m][1][i] * r;
                    h0[i] = g0 * fast_sigmoid(g0) * (acc[ai][1][m][0][i] * r); h1[i] = g1 * fast_sigmoid(g1) * (acc[ai][1][m][1][i] * r); }
                u32x4 w; w.x = cvt_pk_bf16(h0[0], h0[1]); w.y = cvt_pk_bf16(h0[2], h0[3]); w.z = cvt_pk_bf16(h1[0], h1[1]); w.w = cvt_pk_bf16(h1[2], h1[3]);
                *(u32x4*)(O + (size_t)row * 2816 + col0) = w; }
    }
};
struct EpiMixed {
    static constexpr bool PERM = true, AFTER_DRAIN = false, SEGS = true;
    bf16_t* O; const bf16_t* G;
    __device__ __forceinline__ void operator()(f32x4 (&acc)[2][2][4][2], const Unit& u, int wr, int wc, int fr, int fq) const {
        const int row0 = u.pm * BM + wr * 64 + fr, col0 = u.pn * BM + wc * 32 + 8 * fq;
        if (u.ks < 2) {
            const char* gb = (const char*)G + (size_t)u.ks * 2048;
#pragma unroll
            for (int ai = 0; ai < 2; ++ai)
#pragma unroll
                for (int m = 0; m < 4; ++m) { const unsigned off = ((unsigned)(row0 + ai * HALF + m * 16) * 3072u + (unsigned)col0) * 2u;
#pragma unroll
                    for (int bj = 0; bj < 2; ++bj) { const u32x4 a = *(const u32x4*)(gb + off + bj * 256), b = *(const u32x4*)(gb + off + 2048 + bj * 256);
                        f32x4 r0, r1;
                        r0[0] = bflo(a.x) * __builtin_amdgcn_rcpf(bflo(b.x)); r0[1] = bfhi(a.x) * __builtin_amdgcn_rcpf(bfhi(b.x));
                        r0[2] = bflo(a.y) * __builtin_amdgcn_rcpf(bflo(b.y)); r0[3] = bfhi(a.y) * __builtin_amdgcn_rcpf(bfhi(b.y));
                        r1[0] = bflo(a.z) * __builtin_amdgcn_rcpf(bflo(b.z)); r1[1] = bfhi(a.z) * __builtin_amdgcn_rcpf(bfhi(b.z));
                        r1[2] = bflo(a.w) * __builtin_amdgcn_rcpf(bflo(b.w)); r1[3] = bfhi(a.w) * __builtin_amdgcn_rcpf(bfhi(b.w));
                        acc[ai][bj][m][0] *= r0; acc[ai][bj][m][1] *= r1; }
                    asm volatile("" ::: "memory"); }
        } else {
#pragma unroll
            for (int ai = 0; ai < 2; ++ai)
#pragma unroll
                for (int m = 0; m < 4; ++m) { const int row = row0 + ai * HALF + m * 16; const bf16_t* gp = G + (size_t)row * 3072 + 2048 + col0; bf16_t* rowp = O + (size_t)row * 1024 + col0;
#pragma unroll
                    for (int bj = 0; bj < 2; ++bj) { const u32x4 a = *(const u32x4*)(gp + bj * HALF); const f32x4 v0 = acc[ai][bj][m][0], v1 = acc[ai][bj][m][1];
                        u32x4 w; w.x = cvt_pk_bf16(v0[0] * bflo(a.x), v0[1] * bfhi(a.x)); w.y = cvt_pk_bf16(v0[2] * bflo(a.y), v0[3] * bfhi(a.y));
                        w.z = cvt_pk_bf16(v1[0] * bflo(a.z), v1[1] * bfhi(a.z)); w.w = cvt_pk_bf16(v1[2] * bflo(a.w), v1[3] * bfhi(a.w));
                        *(u32x4*)(rowp + bj * HALF) = w; }
                    asm volatile("" ::: "memory"); }
        }
    }
};

template <class Epi, class Sched, bool ALIGN_EPI = false, bool SP2 = false>
__device__ __forceinline__ void gemm_phase(PG8_LAS unsigned char* lds, const Gemm g, const Sched& S, const Epi& E) {
    int tid_ = threadIdx.x; asm volatile("" : "+v"(tid_));
    const int tid = tid_, wid = __builtin_amdgcn_readfirstlane(tid >> 6), lane = tid & 63, wr = wid >> 2, wc = wid & 3, fr = lane & 15, fq = lane >> 4;
    const int K = g.K, nt = g.Kt / BK;
    unsigned voffA[2], voffB[2];
#pragma unroll
    for (int i = 0; i < 2; ++i) { int R, C; stage_rc(tid * 16 + i * 8192, R, C); const int Rb = Epi::PERM ? ((R & ~31) + perm32(R & 31)) : R;
        voffA[i] = (unsigned)(R * K + C) * 2u; voffB[i] = (unsigned)(Rb * K + C) * 2u; }
    const size_t kstep = (size_t)(BK * 2);
    const size_t hstep = (size_t)HALF * K * 2;
    const size_t tstep = 2 * hstep;
    const unsigned ldsw = (unsigned)wid * 1024u;
    const int aoff = lds_byte(wr * 64 + fr, fq * 8), boff = lds_byte(wc * 32 + fr, fq * 8);
#define PG8_SA(b, h) (((b) * 2 + (h)) * HTB)
#define PG8_SB(b, h) ((4 + (b) * 2 + (h)) * HTB)
#define PG8_STAGE(bufoff, gbase, voff) do { _Pragma("unroll") for (int _i = 0; _i < 2; ++_i) \
        __builtin_amdgcn_global_load_lds((const unsigned*)((const char*)(gbase) + (voff)[_i]), (PG8_LAS unsigned*)(lds + (bufoff) + ldsw + _i * 8192), 16, 0, 0); } while (0)
#define PG8_LDA(dst, b, h) do { _Pragma("unroll") for (int m = 0; m < 4; ++m) _Pragma("unroll") for (int k = 0; k < 2; ++k) dst[m][k] = *(const PG8_LAS bf16x8*)(lds + PG8_SA(b, h) + aoff + m * 2048 + k * 1024); } while (0)
#define PG8_LDB(dst, b, h) do { _Pragma("unroll") for (int n = 0; n < 2; ++n) _Pragma("unroll") for (int k = 0; k < 2; ++k) dst[n][k] = *(const PG8_LAS bf16x8*)(lds + PG8_SB(b, h) + boff + n * 2048 + k * 1024); } while (0)
#define PG8_MMA(ai, bj, At, Bt) do { __builtin_amdgcn_s_setprio(1); _Pragma("unroll") for (int m = 0; m < 4; ++m) _Pragma("unroll") for (int n = 0; n < 2; ++n) _Pragma("unroll") for (int k = 0; k < 2; ++k) \
        acc[ai][bj][m][n] = __builtin_amdgcn_mfma_f32_16x16x32_bf16(Bt[n][k], At[m][k], acc[ai][bj][m][n], 0, 0, 0); __builtin_amdgcn_s_setprio(0); } while (0)
#define PG8_WAIT_V(n) asm volatile("s_waitcnt vmcnt(" #n ")" ::: "memory")
#define PG8_WAIT_L(n) asm volatile("s_waitcnt lgkmcnt(" #n ")" ::: "memory")
#define PG8_BAR __builtin_amdgcn_s_barrier()
#define PG8_SCHED __builtin_amdgcn_sched_barrier(0)
    Unit cur, nxt; int ui = 0;
    if (!S.next(0, cur)) return;
    f32x4 acc[2][2][4][2];
#pragma unroll
    for (int a = 0; a < 2; ++a)
#pragma unroll
        for (int b = 0; b < 2; ++b)
#pragma unroll
            for (int m = 0; m < 4; ++m)
#pragma unroll
                for (int n = 0; n < 2; ++n) acc[a][b][m][n] = (f32x4){0.f, 0.f, 0.f, 0.f};
    bf16x8 At[4][2], B0[2][2], B1[2][2];
    const char* cA = (const char*)g.A + (size_t)cur.pm * tstep + (size_t)cur.ks * g.ksb; const char* cB = (const char*)g.Bt + (size_t)cur.pn * tstep + (size_t)cur.ks * g.ksb;
    S.a_ready(cur);
    if constexpr (SP2) {
        PG8_STAGE(PG8_SB(0, 0), cB, voffB); PG8_STAGE(PG8_SB(0, 1), cB + hstep, voffB); PG8_STAGE(PG8_SA(0, 0), cA, voffA); PG8_STAGE(PG8_SA(0, 1), cA + hstep, voffA);
        if (wr == 1) PG8_BAR;
        PG8_WAIT_V(2); PG8_BAR;
        PG8_STAGE(PG8_SB(1, 0), cB + kstep, voffB); PG8_STAGE(PG8_SA(1, 0), cA + kstep, voffA); PG8_STAGE(PG8_SB(1, 1), cB + hstep + kstep, voffB);
        PG8_WAIT_V(6); PG8_BAR;
    } else {
        PG8_STAGE(PG8_SB(0, 0), cB, voffB); PG8_STAGE(PG8_SA(0, 0), cA, voffA); PG8_STAGE(PG8_SB(0, 1), cB + hstep, voffB); PG8_STAGE(PG8_SA(0, 1), cA + hstep, voffA);
        if (wr == 1) PG8_BAR;
        PG8_WAIT_V(4); PG8_BAR;
        PG8_STAGE(PG8_SB(1, 0), cB + kstep, voffB); PG8_STAGE(PG8_SA(1, 0), cA + kstep, voffA); PG8_STAGE(PG8_SB(1, 1), cB + hstep + kstep, voffB);
        PG8_WAIT_V(6); PG8_BAR;
    }
    for (;;) {
        const bool has_next = S.next(ui + 1, nxt);
        const char* nA = has_next ? (const char*)g.A + (size_t)nxt.pm * tstep + (size_t)nxt.ks * g.ksb : cA; const char* nB = has_next ? (const char*)g.Bt + (size_t)nxt.pn * tstep + (size_t)nxt.ks * g.ksb : cB;
        for (int t = 0; t < nt; t += 2) {
            const bool last = (t == nt - 2);
            const char* a1 = cA + (size_t)(t + 1) * kstep;
            const char* a2 = last ? nA : cA + (size_t)(t + 2) * kstep; const char* b2 = last ? nB : cB + (size_t)(t + 2) * kstep;
            const char* a3 = a2 + kstep; const char* b3 = b2 + kstep;
            if (last && has_next) S.a_ready(nxt);
            if constexpr (SP2) {
            PG8_LDB(B0, 0, 0); PG8_LDB(B1, 0, 1); PG8_SCHED; PG8_LDA(At, 0, 0); PG8_STAGE(PG8_SA(1, 1), a1 + hstep, voffA);
            PG8_WAIT_V(8); PG8_WAIT_L(0); PG8_BAR; PG8_MMA(0, 0, At, B0); PG8_MMA(0, 1, At, B1); PG8_BAR; PG8_SCHED;
            PG8_LDA(At, 0, 1); PG8_STAGE(PG8_SB(0, 0), b2, voffB); PG8_STAGE(PG8_SB(0, 1), b2 + hstep, voffB); PG8_STAGE(PG8_SA(0, 0), a2, voffA);
            PG8_WAIT_V(8); PG8_WAIT_L(0); PG8_BAR; PG8_MMA(1, 0, At, B0); PG8_MMA(1, 1, At, B1); PG8_BAR; PG8_SCHED;
            PG8_LDB(B0, 1, 0); PG8_LDB(B1, 1, 1); PG8_SCHED; PG8_LDA(At, 1, 0); PG8_STAGE(PG8_SA(0, 1), a2 + hstep, voffA);
            PG8_WAIT_V(8); PG8_WAIT_L(0); PG8_BAR; PG8_MMA(0, 0, At, B0); PG8_MMA(0, 1, At, B1); PG8_BAR; PG8_SCHED;
            PG8_LDA(At, 1, 1); PG8_STAGE(PG8_SB(1, 0), b3, voffB); PG8_STAGE(PG8_SB(1, 1), b3 + hstep, voffB); PG8_STAGE(PG8_SA(1, 0), a3, voffA);
            PG8_WAIT_V(8); PG8_WAIT_L(0); PG8_BAR; PG8_MMA(1, 0, At, B0); PG8_MMA(1, 1, At, B1); PG8_BAR; PG8_SCHED;
            } else {
            PG8_LDB(B0, 0, 0); PG8_SCHED; PG8_LDA(At, 0, 0); PG8_STAGE(PG8_SA(1, 1), a1 + hstep, voffA);
            PG8_WAIT_L(8); PG8_BAR; PG8_WAIT_L(0); PG8_MMA(0, 0, At, B0); PG8_BAR; PG8_SCHED;
            PG8_LDB(B1, 0, 1); PG8_STAGE(PG8_SB(0, 0), b2, voffB);
            PG8_BAR; PG8_WAIT_L(0); PG8_MMA(0, 1, At, B1); PG8_BAR;
            PG8_LDA(At, 0, 1); PG8_STAGE(PG8_SA(0, 0), a2, voffA);
            PG8_BAR; PG8_WAIT_L(0); PG8_MMA(1, 0, At, B0); PG8_BAR; PG8_SCHED;
            PG8_STAGE(PG8_SB(0, 1), b2 + hstep, voffB);
            PG8_WAIT_V(6); PG8_BAR; PG8_MMA(1, 1, At, B1); PG8_BAR;
            PG8_LDB(B0, 1, 0); PG8_SCHED; PG8_LDA(At, 1, 0); PG8_STAGE(PG8_SA(0, 1), a2 + hstep, voffA);
            PG8_WAIT_L(8); PG8_BAR; PG8_WAIT_L(0); PG8_MMA(0, 0, At, B0); PG8_BAR; PG8_SCHED;
            PG8_LDB(B1, 1, 1); PG8_STAGE(PG8_SB(1, 0), b3, voffB);
            PG8_BAR; PG8_WAIT_L(0); PG8_MMA(0, 1, At, B1); PG8_BAR;
            PG8_LDA(At, 1, 1); PG8_STAGE(PG8_SA(1, 0), a3, voffA);
            PG8_BAR; PG8_WAIT_L(0); PG8_MMA(1, 0, At, B0); PG8_BAR; PG8_SCHED;
            PG8_STAGE(PG8_SB(1, 1), b3 + hstep, voffB);
            PG8_WAIT_V(6); PG8_BAR; PG8_MMA(1, 1, At, B1); PG8_BAR;
            }
        }
        if constexpr (ALIGN_EPI) { if (wr == 0) PG8_BAR; }
        if constexpr (!Epi::AFTER_DRAIN) { E(acc, cur, wr, wc, fr, fq); S.done(cur); }
        if (!has_next) break;
        if (!(Epi::SEGS && cur.ks < 2)) {
#pragma unroll
        for (int a = 0; a < 2; ++a)
#pragma unroll
            for (int b = 0; b < 2; ++b)
#pragma unroll
                for (int m = 0; m < 4; ++m)
#pragma unroll
                    for (int n = 0; n < 2; ++n) acc[a][b][m][n] = (f32x4){0.f, 0.f, 0.f, 0.f};
        }
        cur = nxt; cA = nA; cB = nB; ++ui;
        if constexpr (ALIGN_EPI) { if (wr == 1) PG8_BAR; }
    }
    PG8_WAIT_V(0);
    if constexpr (!ALIGN_EPI) { if (wr == 0) PG8_BAR; }
    PG8_BAR;
    if constexpr (Epi::AFTER_DRAIN) { E.fused(acc, cur, wr, wc, fr, fq, lds, wid, lane); S.done(cur); }
#undef PG8_SA
#undef PG8_SB
#undef PG8_STAGE
#undef PG8_LDA
#undef PG8_LDB
#undef PG8_MMA
#undef PG8_WAIT_V
#undef PG8_WAIT_L
#undef PG8_BAR
#undef PG8_SCHED
}
}

namespace attn_body {
using bf16=__hip_bfloat16;
using bf16x8=__attribute__((ext_vector_type(8)))short;
using s16x4=__attribute__((ext_vector_type(4)))short;
using f32x16=__attribute__((ext_vector_type(16)))float;
using u32x4=__attribute__((ext_vector_type(4)))unsigned;
constexpr int BATCH=8,NHEAD=8,SEQ=4096,D=64,QP=3584,OP=1536;
constexpr int NW=8,QBLK=32,QB=QBLK*NW,KVBLK=64,NQB=SEQ/QB;
constexpr int ATTN_UNIT_ROWS=QB;
__device__ __forceinline__ int crow(int r,int hi){return (r&3)+8*(r>>2)+4*hi;}
#define SBAR() __builtin_amdgcn_sched_barrier(0)
__device__ __forceinline__ void cmask(f32x16&p0,f32x16&p1,int jb,int qrel,int hi){
  const float NEG=-INFINITY; int kb=64*jb+4*hi;
  #pragma unroll
  for(int r=0;r<16;++r){int kv=kb+(r&3)+8*(r>>2); if(kv>qrel)p0[r]=NEG; if(kv+32>qrel)p1[r]=NEG;}
}

constexpr int NSLOT=3, SLOTB=8192;
constexpr int LDS_K=0, LDS_V=NSLOT*SLOTB, LDS_WS=2*NSLOT*SLOTB, LDS_OST=LDS_WS+NW*64*4, LDS_BYTES=LDS_OST+NW*4096;
constexpr float C2=0.125f*1.4426950408889634f;
__device__ __forceinline__ void glds16(const void*gsrc,unsigned lds_dst){unsigned keep;
  asm volatile("s_mov_b32 %0, m0\n\ts_mov_b32 m0, %2\n\ts_nop 0\n\tglobal_load_lds_dwordx4 %1, off\n\ts_mov_b32 m0, %0":"=&s"(keep):"v"(gsrc),"s"(lds_dst):"memory");}
__device__ __forceinline__ float max3f(float a,float b,float c){float r;asm("v_max3_f32 %0, %1, %2, %3":"=v"(r):"v"(a),"v"(b),"v"(c));return r;}
__device__ __forceinline__ float max2f(float a,float b){float r;asm("v_max_f32_e32 %0, %1, %2":"=v"(r):"v"(a),"v"(b));return r;}
__device__ __forceinline__ float fadd_s(float a,float b){float r;asm("v_add_f32_e32 %0, %1, %2":"=v"(r):"v"(a),"v"(b));return r;}
__device__ __forceinline__ float fsub_s(float a,float b){float r;asm("v_sub_f32_e32 %0, %1, %2":"=v"(r):"v"(a),"v"(b));return r;}
typedef float f32x2_t __attribute__((ext_vector_type(2))); typedef __bf16 bf16x2_t __attribute__((ext_vector_type(2)));
__device__ __forceinline__ unsigned cvtpk_s(float lo,float hi){f32x2_t v={lo,hi};bf16x2_t b=__builtin_convertvector(v,bf16x2_t);return __builtin_bit_cast(unsigned,b);}
#define WAIT_BAR(N) asm volatile("s_waitcnt vmcnt(" #N ") lgkmcnt(0)\n\ts_barrier":::"memory")

__device__ __forceinline__ void qkt(f32x16&p0,f32x16&p1,const char*Kslot,const bf16x8*qr,int r32,int hi){
  const char*kb=Kslot+hi*1024+r32*16;
  #pragma unroll
  for(int d0=0;d0<4;++d0){
    const bf16x8 b0=*reinterpret_cast<const bf16x8*>(kb+d0*2048);
    const bf16x8 b1=*reinterpret_cast<const bf16x8*>(kb+d0*2048+512);
    p0=__builtin_amdgcn_mfma_f32_32x32x16_bf16(b0,qr[d0],p0,0,0,0);p1=__builtin_amdgcn_mfma_f32_32x32x16_bf16(b1,qr[d0],p1,0,0,0);}
}
typedef __attribute__((address_space(3))) const char* lds_cptr;
typedef short v4i16_t __attribute__((ext_vector_type(4)));
__device__ __forceinline__ void kload8(bf16x8*kf,lds_cptr kp){
  kf[0]=*(const __attribute__((address_space(3))) bf16x8*)(kp);      kf[1]=*(const __attribute__((address_space(3))) bf16x8*)(kp+512);
  kf[2]=*(const __attribute__((address_space(3))) bf16x8*)(kp+2048); kf[3]=*(const __attribute__((address_space(3))) bf16x8*)(kp+2560);
  kf[4]=*(const __attribute__((address_space(3))) bf16x8*)(kp+4096); kf[5]=*(const __attribute__((address_space(3))) bf16x8*)(kp+4608);
  kf[6]=*(const __attribute__((address_space(3))) bf16x8*)(kp+6144); kf[7]=*(const __attribute__((address_space(3))) bf16x8*)(kp+6656);
}
__device__ __forceinline__ void kload2(bf16x8*kf,lds_cptr kp,int j){ kf[2*j]=*(const __attribute__((address_space(3))) bf16x8*)(kp+j*2048); kf[2*j+1]=*(const __attribute__((address_space(3))) bf16x8*)(kp+j*2048+512); }
__device__ __forceinline__ s16x4 vtr(lds_cptr p){ return __builtin_bit_cast(s16x4,__builtin_amdgcn_ds_read_tr16_b64_v4i16((__attribute__((address_space(3))) v4i16_t*)p)); }
__device__ __forceinline__ float rowmax(const f32x16&p0,const f32x16&p1){
  float a=max3f(p0[0],p0[1],p1[0]),b=max3f(p0[2],p0[3],p1[1]);a=max3f(a,p1[2],p1[3]);
  #pragma unroll
  for(int r=4;r<16;r+=4){a=max3f(a,p0[r],p0[r+1]);b=max3f(b,p0[r+2],p0[r+3]);a=max3f(a,p1[r],p1[r+1]);b=max3f(b,p1[r+2],p1[r+3]);}
  const float m=max2f(a,b);
  auto rr=__builtin_amdgcn_permlane32_swap(__float_as_uint(m),__float_as_uint(m),false,false);
  return max2f(__uint_as_float(rr[0]),__uint_as_float(rr[1]));
}
__device__ __forceinline__ void pv(f32x16*o,int vb,bf16x8 pa0,bf16x8 pa1,bf16x8 pa2,bf16x8 pa3){
  #pragma unroll
  for(int d0=0;d0<2;++d0){s16x4 lo[4],hi[4];
    #pragma unroll
    for(int ks=0;ks<4;++ks){
      asm volatile("ds_read_b64_tr_b16 %0,%1 offset:%c2":"=&v"(lo[ks]):"v"(vb),"i"(d0*4096+ks*1024):"memory");
      asm volatile("ds_read_b64_tr_b16 %0,%1 offset:%c2":"=&v"(hi[ks]):"v"(vb),"i"(d0*4096+ks*1024+512):"memory");}
    asm volatile("s_waitcnt lgkmcnt(0)":::"memory");SBAR();
    #define PK(k) (bf16x8){lo[k][0],lo[k][1],lo[k][2],lo[k][3],hi[k][0],hi[k][1],hi[k][2],hi[k][3]}
    o[d0]=__builtin_amdgcn_mfma_f32_32x32x16_bf16(pa0,PK(0),o[d0],0,0,0);
    o[d0]=__builtin_amdgcn_mfma_f32_32x32x16_bf16(pa1,PK(1),o[d0],0,0,0);
    o[d0]=__builtin_amdgcn_mfma_f32_32x32x16_bf16(pa2,PK(2),o[d0],0,0,0);
    o[d0]=__builtin_amdgcn_mfma_f32_32x32x16_bf16(pa3,PK(3),o[d0],0,0,0);
    #undef PK
  }
}

#ifndef ATTN_STORE16
#define ATTN_STORE16(p,v) (*(u32x4*)(p)=(v))
#endif
template<int THRL> __device__ __forceinline__ void attn_unit(int b,int h,int qb,const bf16*Q,const bf16*__restrict__ K,const bf16*__restrict__ V,bf16*O,const unsigned*__restrict__ SEL,char*shm){
  int tid_=threadIdx.x; asm volatile("":"+v"(tid_)); const int tid=tid_,lane=tid&63,r32=lane&31,hi=lane>>5; const int wid=__builtin_amdgcn_readfirstlane(tid>>6);
  const long rowbase=(long)b*SEQ; const int q0=qb*QB;
  const bf16*Qw=Q+(rowbase+q0+wid*QBLK)*QP+h*D;
  const bf16*Kh=K+rowbase*QP+h*D,*Vh=V+rowbase*QP+h*D;
  const unsigned lds0=(unsigned)(uintptr_t)shm;
  float*wsf=(float*)(shm+LDS_WS)+wid*64;
  const bf16*ksrc=Kh+(long)lane*QP+wid*8;
  const bf16*vsrc=Vh+(long)(16*(wid&3)+(lane>>2))*QP+(wid>>2)*32+(lane&3)*8;
  const unsigned kdst=lds0+LDS_K+wid*1024, vdst=lds0+LDS_V+wid*1024;
  #define KT(t) (((t)<4)?(NT-4+(t)):((t)-4))
  #define DMA_K(t,slot) glds16(ksrc+(long)KT(t)*KVBLK*QP,(unsigned)__builtin_amdgcn_readfirstlane(kdst+(slot)))
  #define DMA_V(t,slot) glds16(vsrc+(long)KT(t)*KVBLK*QP,(unsigned)__builtin_amdgcn_readfirstlane(vdst+(slot)))
  const int vb0=(int)(lds0+LDS_V)+((lane>>4)&1)*32+(lane&3)*8+(4*hi+((lane&15)>>2))*64;
  const char*Kbase=shm+LDS_K; bf16x8 kf[8];
  const lds_cptr shm3=(lds_cptr)shm; const lds_cptr kp0=shm3+LDS_K+hi*1024+r32*16; const lds_cptr vp0=shm3+LDS_V+((lane>>4)&1)*32+(lane&3)*8+(4*hi+((lane&15)>>2))*64;
  const int NT=(q0+QB)/KVBLK;
  DMA_K(0,0);DMA_V(0,0);DMA_K(1,SLOTB);
  const unsigned selm=SEL[((long)(b*NHEAD+h))*SEQ+q0+wid*QBLK+r32];
  const float sl2=__builtin_amdgcn_exp2f(-(float)(h+1))*1.4426950408889634f;
  bf16x8 qr[4];
  #pragma unroll
  for(int d0=0;d0<4;++d0)qr[d0]=*reinterpret_cast<const bf16x8*>(&Qw[(long)r32*QP+d0*16+hi*8]);
  float mhat=0.f,l_reg=0.f;f32x16 o[2];o[0]=f32x16{};o[1]=f32x16{};
  #define CINIT(C0,C1,t) do{ const int kt_=KT(t); const bool on_=((t)<4)||(((selm>>(kt_>>2))&1u)!=0u); \
    const float bs_=on_?(sl2*(float)(64*kt_-q0+4*hi)-mhat):-1e30f; const float s32_=32.f*sl2; \
    _Pragma("unroll") for(int r=0;r<16;++r)C0[r]=__builtin_fmaf(sl2,(float)((r&3)+8*(r>>2)),bs_); \
    _Pragma("unroll") for(int r=0;r<16;++r)C1[r]=C0[r]+s32_; }while(0)
  const int qrel=wid*QBLK+r32;
  #define CMASK(P0,P1,t) do{ if((t)<4)cmask(P0,P1,(t),qrel,hi); }while(0)
  bool resc=false;
  #define START(P0,P1) do{ const float rm=rowmax(P0,P1); resc=false; \
    { const float dl=rm; mhat=fadd_s(mhat,dl); \
      _Pragma("unroll") for(int r=0;r<16;++r){P0[r]=fsub_s(P0[r],dl);P1[r]=fsub_s(P1[r],dl);} } \
    _Pragma("unroll") for(int r=0;r<16;++r)P0[r]=__builtin_amdgcn_exp2f(P0[r]); }while(0)
  #define RESC() do{ if(resc){ asm volatile("s_waitcnt lgkmcnt(0)":::"memory"); \
      _Pragma("unroll") for(int d_=0;d_<2;++d_) _Pragma("unroll") for(int r=0;r<16;++r)o[d_][r]*=wsf[crow(r,hi)]; } }while(0)
  f32x16 pA0,pA1,pB0,pB1;
  int sl_prev=0,sl_cur=0,sl_next=SLOTB;
  #define ROT() do{sl_prev=sl_cur;sl_cur=sl_next;sl_next=(sl_next==(NSLOT-1)*SLOTB)?0:sl_next+SLOTB;}while(0)
  DMA_K(2,2*SLOTB);
  WAIT_BAR(3);
  CINIT(pA0,pA1,0); qkt(pA0,pA1,Kbase,qr,r32,hi);asm volatile("s_nop 15\n\ts_nop 7":"+v"(pA0),"+v"(pA1));CMASK(pA0,pA1,0);
  START(pA0,pA1);
  _Pragma("unroll") for(int r=0;r<16;++r)pA1[r]=__builtin_amdgcn_exp2f(pA1[r]);
  WAIT_BAR(0);
  DMA_K(3,0);DMA_V(1,SLOTB);
  ROT();
  kload8(kf,kp0+sl_cur);
  WAIT_BAR(2);
  s16x4 vlo[8],vhi[8]; u32x4 pw0,pw1,pw2,pw3;
  #define PKW(P,B) cvtpk_s(P[B],P[B+1])
  #define PAF(k) __builtin_bit_cast(bf16x8,pw##k)
  #define VFR(i) (bf16x8){vlo[i][0],vlo[i][1],vlo[i][2],vlo[i][3],vhi[i][0],vhi[i][1],vhi[i][2],vhi[i][3]}
  #define PIN(x) asm volatile("":"+v"(x))
  #define MX3(a,b,c) __builtin_fmaxf(__builtin_fmaxf((a),(b)),(c))
  #define GAPA(MF,A0,A1,A2,A3,W0,W1,PW) do{ MF; sacc+=A0; sacc+=A1; sacc+=A2; sacc+=A3; PIN(sacc); W0; W1; PIN(PW); SBAR(); }while(0)
  #define EX(v) __builtin_amdgcn_exp2f(v)
  #define GAPB(MF,X,B) do{ MF; X[B]=EX(X[B]); X[B+1]=EX(X[B+1]); X[B+2]=EX(X[B+2]); X[B+3]=EX(X[B+3]); PIN(X); SBAR(); }while(0)
  #define VRD(i) do{ vlo[i]=vtr(vp_+(((i)>>2)*4096+((i)&3)*1024)); vhi[i]=vtr(vp_+(((i)>>2)*4096+((i)&3)*1024+512)); }while(0)
  #define KRD(G,j) do{ if(G){ kload2(kf,kp0+sl_next,j); SBAR(); } }while(0)
  #define STEP(C0,C1,P0,P1,t,GK,GV,GL) do{ SBAR(); CINIT(C0,C1,t); SBAR(); \
    const lds_cptr vp_=vp0+sl_prev; \
    VRD(0); SBAR(); float sacc=(P0[0]+P0[1]); \
    GAPA(C0=__builtin_amdgcn_mfma_f32_32x32x16_bf16(kf[0],qr[0],C0,0,0,0), P0[2],P0[3],P0[4],P0[5],     pw0[0]=PKW(P0,0), pw0[1]=PKW(P0,2), pw0); \
    VRD(4); SBAR(); GAPA(C1=__builtin_amdgcn_mfma_f32_32x32x16_bf16(kf[1],qr[0],C1,0,0,0), P0[6],P0[7],P0[8],P0[9],     pw0[2]=PKW(P0,4), pw0[3]=PKW(P0,6), pw0); \
    VRD(1); SBAR(); GAPA(C0=__builtin_amdgcn_mfma_f32_32x32x16_bf16(kf[2],qr[1],C0,0,0,0),   P0[10],P0[11],P0[12],P0[13], pw1[0]=PKW(P0,8), pw1[1]=PKW(P0,10), pw1); \
    VRD(5); SBAR(); GAPA(C1=__builtin_amdgcn_mfma_f32_32x32x16_bf16(kf[3],qr[1],C1,0,0,0),   P0[14],P0[15],P1[0],P1[1],   pw1[2]=PKW(P0,12),pw1[3]=PKW(P0,14), pw1); \
    VRD(2); SBAR(); GAPA(C0=__builtin_amdgcn_mfma_f32_32x32x16_bf16(kf[4],qr[2],C0,0,0,0),   P1[2],P1[3],P1[4],P1[5],     pw2[0]=PKW(P1,0), pw2[1]=PKW(P1,2), pw2); \
    VRD(6); SBAR(); GAPA(C1=__builtin_amdgcn_mfma_f32_32x32x16_bf16(kf[5],qr[2],C1,0,0,0),   P1[6],P1[7],P1[8],P1[9],     pw2[2]=PKW(P1,4), pw2[3]=PKW(P1,6), pw2); \
    VRD(3); SBAR(); GAPA(C0=__builtin_amdgcn_mfma_f32_32x32x16_bf16(kf[6],qr[3],C0,0,0,0),   P1[10],P1[11],P1[12],P1[13], pw3[0]=PKW(P1,8), pw3[1]=PKW(P1,10), pw3); \
    VRD(7); SBAR(); GAPA(C1=__builtin_amdgcn_mfma_f32_32x32x16_bf16(kf[7],qr[3],C1,0,0,0),   P1[14],P1[15],0.f,0.f,       pw3[2]=PKW(P1,12),pw3[3]=PKW(P1,14), pw3); \
    l_reg+=sacc; \
    if(GK){DMA_K((t)+3,sl_cur);} if(GV){DMA_V((t)+1,sl_next);} \
    CMASK(C0,C1,t); \
    { float a=MX3(C0[0],C0[1],C1[0]),b=MX3(C0[2],C0[3],C1[1]); a=MX3(a,C1[2],C1[3]); \
      _Pragma("unroll") for(int r=4;r<16;r+=4){a=MX3(a,C0[r],C0[r+1]);b=MX3(b,C0[r+2],C0[r+3]);a=MX3(a,C1[r],C1[r+1]);b=MX3(b,C1[r+2],C1[r+3]);} \
      float rm=__builtin_fmaxf(a,b); { auto rr=__builtin_amdgcn_permlane32_swap(__float_as_uint(rm),__float_as_uint(rm),false,false); rm=__builtin_fmaxf(__uint_as_float(rr[0]),__uint_as_float(rr[1])); } \
      resc=false; \
      if(__builtin_expect(__any(rm>(float)THRL),0)){ const float dl=__builtin_fmaxf(rm,0.f); mhat+=dl; \
        _Pragma("unroll") for(int r=0;r<16;++r){C0[r]-=dl;C1[r]-=dl;} \
        const float f=__builtin_amdgcn_exp2f(-dl); l_reg*=f; if(hi==0)wsf[r32]=f; resc=true; } } \
    SBAR(); \
    GAPB(o[0]=__builtin_amdgcn_mfma_f32_32x32x16_bf16(PAF(0),VFR(0),o[0],0,0,0), C0,0); \
    GAPB(o[1]=__builtin_amdgcn_mfma_f32_32x32x16_bf16(PAF(0),VFR(4),o[1],0,0,0), C0,4); \
    KRD(GL,0); GAPB(o[0]=__builtin_amdgcn_mfma_f32_32x32x16_bf16(PAF(1),VFR(1),o[0],0,0,0), C0,8); \
    KRD(GL,1); GAPB(o[1]=__builtin_amdgcn_mfma_f32_32x32x16_bf16(PAF(1),VFR(5),o[1],0,0,0), C0,12); \
    KRD(GL,2); GAPB(o[0]=__builtin_amdgcn_mfma_f32_32x32x16_bf16(PAF(2),VFR(2),o[0],0,0,0), C1,0); \
    KRD(GL,3); GAPB(o[1]=__builtin_amdgcn_mfma_f32_32x32x16_bf16(PAF(2),VFR(6),o[1],0,0,0), C1,4); \
    GAPB(o[0]=__builtin_amdgcn_mfma_f32_32x32x16_bf16(PAF(3),VFR(3),o[0],0,0,0), C1,8); \
    GAPB(o[1]=__builtin_amdgcn_mfma_f32_32x32x16_bf16(PAF(3),VFR(7),o[1],0,0,0), C1,12); \
    }while(0)
  int t=1;
  for(;t+5<NT;t+=2){
    STEP(pB0,pB1,pA0,pA1,t,true,true,true);     WAIT_BAR(2); RESC(); ROT();
    STEP(pA0,pA1,pB0,pB1,t+1,true,true,true);   WAIT_BAR(2); RESC(); ROT();
  }
  #define ENDW(tt) do{ if((tt)+3<NT){WAIT_BAR(2);} else if((tt)+2<NT){WAIT_BAR(1);} else {WAIT_BAR(0);} }while(0)
  for(;t+1<NT;t+=2){
    STEP(pB0,pB1,pA0,pA1,t,(t+3<NT),(t+1<NT),(t+1<NT));       ENDW(t);   RESC(); ROT();
    STEP(pA0,pA1,pB0,pB1,t+1,(t+4<NT),(t+2<NT),(t+2<NT));     ENDW(t+1); RESC(); ROT();
  }
  STEP(pB0,pB1,pA0,pA1,NT-1,false,false,false); RESC();
  { float sacc=pB0[0]+pB0[1]; _Pragma("unroll") for(int r=2;r<16;++r)sacc+=pB0[r]; _Pragma("unroll") for(int r=0;r<16;++r)sacc+=pB1[r]; l_reg+=sacc;
    pw0=(u32x4){PKW(pB0,0),PKW(pB0,2),PKW(pB0,4),PKW(pB0,6)};pw1=(u32x4){PKW(pB0,8),PKW(pB0,10),PKW(pB0,12),PKW(pB0,14)};pw2=(u32x4){PKW(pB1,0),PKW(pB1,2),PKW(pB1,4),PKW(pB1,6)};pw3=(u32x4){PKW(pB1,8),PKW(pB1,10),PKW(pB1,12),PKW(pB1,14)};
    SBAR(); pv(o,vb0+sl_cur,PAF(0),PAF(1),PAF(2),PAF(3)); }
  #undef PKW
  #undef PAF
  #undef VFR
  #undef PIN
  #undef MX3
  #undef GAPA
  #undef GAPB
  #undef EX
  #undef VRD
  #undef KRD
  #undef STEP
  #undef ENDW
  {auto rr=__builtin_amdgcn_permlane32_swap(__float_as_uint(l_reg),__float_as_uint(l_reg),false,false);l_reg=__uint_as_float(rr[0])+__uint_as_float(rr[1]);}
  if(hi==0)wsf[32+r32]=l_reg;asm volatile("s_waitcnt lgkmcnt(0)":::"memory");
  float rli[16];
  #pragma unroll
  for(int r=0;r<16;++r)rli[r]=__builtin_amdgcn_rcpf(wsf[32+crow(r,hi)]);
  bf16*Ow=O+(rowbase+q0+wid*QBLK)*OP+h*D;
  { bf16*stg=(bf16*)(shm+LDS_OST)+wid*2048;
    #pragma unroll
    for(int r=0;r<16;++r){const int orow=crow(r,hi);
      #pragma unroll
      for(int d0=0;d0<2;++d0)stg[orow*64+d0*32+r32]=__float2bfloat16(o[d0][r]*rli[r]);}
    asm volatile("s_waitcnt lgkmcnt(0)":::"memory");
    #pragma unroll
    for(int i=0;i<4;++i){const int row=i*8+(lane>>3),ch=lane&7; const u32x4 v=*(const u32x4*)(stg+row*64+ch*8); ATTN_STORE16(Ow+(long)row*OP+ch*8,v);} }
  asm volatile("s_waitcnt lgkmcnt(0)\n\ts_barrier":::"memory");
  #undef DMA_K
  #undef DMA_V
  #undef KT
  #undef CINIT
  #undef CMASK
  #undef START
  #undef RESC
  #undef ROT
}
constexpr int ATTN_LDS_BYTES=LDS_BYTES;
struct AttnTensors { const bf16* Q; const bf16* K; const bf16* V; bf16* O; const unsigned* SEL; };
struct AttnUnit { int bh; int qb; };
struct StaticOrder {
  int vcu, G;
  __device__ __forceinline__ StaticOrder(int grid,int vcu_):vcu(vcu_),G(grid){}
  __device__ __forceinline__ bool next(int i,AttnUnit&u)const{
    if(G==256){ if(i>=4)return false; const int c=vcu&3; u.bh=vcu>>2; u.qb=(i==0)?15-c:(i==1)?11-c:(i==2)?4+c:c; return true; }
    const int L=i*G+vcu; if(L>=BATCH*NHEAD*NQB)return false; u.qb=NQB-1-L/(BATCH*NHEAD); u.bh=L%(BATCH*NHEAD); return true; }
  __device__ __forceinline__ void a_ready(const AttnUnit&)const{}
  __device__ __forceinline__ void done(const AttnUnit&)const{}
};
template<class Sched,int THRL=8> __device__ __forceinline__ void attn_phase(char*lds,const AttnTensors&T,const Sched&S){
  AttnUnit u;
  for(int i=0;S.next(i,u);++i){ S.a_ready(u); attn_unit<THRL>(u.bh/NHEAD,u.bh%NHEAD,u.qb,T.Q,T.K,T.V,T.O,T.SEL,lds); S.done(u); }
}
#undef SBAR
#undef WAIT_BAR
}

#define GAS __attribute__((address_space(1)))
#define LAS __attribute__((address_space(3)))
typedef unsigned short bf16;
typedef unsigned v4u __attribute__((ext_vector_type(4)));
typedef float f32x4 __attribute__((ext_vector_type(4)));
typedef short bf16x8 __attribute__((ext_vector_type(8)));
typedef GAS unsigned gu32;
typedef GAS unsigned long long gu64;
#define RLX_AGENT __ATOMIC_RELAXED, __HIP_MEMORY_SCOPE_AGENT
#define LDS_WAIT() asm volatile("s_waitcnt lgkmcnt(0)" ::: "memory")
#define VM_WAIT() asm volatile("s_waitcnt vmcnt(0)" ::: "memory")
__device__ __forceinline__ unsigned long long rt() { return __builtin_amdgcn_s_memrealtime(); }
__device__ __forceinline__ unsigned f2bf(float f) { unsigned u = __builtin_bit_cast(unsigned, f); return (u + 0x7fffu + ((u >> 16) & 1u)) >> 16; }
__device__ __forceinline__ unsigned pk2(float lo, float hi) { return f2bf(lo) | (f2bf(hi) << 16); }

#define XB_TMO      128
#define XB_XCNT(j)  (256  + 64 * (j))
#define XB_XSUB(j)  (1280 + 64 * (j))
#define XB_XGEN(j)  (2304 + 64 * (j))
#define XB_TOP      3328
#define XB_TOPGEN   3392
#define XCD_BAR_WORDS 3456
#define XB_SPIN_CAP (1u << 18)

__device__ __forceinline__ unsigned xb_ld(unsigned* p)              { return __hip_atomic_load(p, __ATOMIC_RELAXED, __HIP_MEMORY_SCOPE_AGENT); }
__device__ __forceinline__ unsigned xb_add(unsigned* p, unsigned v) { return __hip_atomic_fetch_add(p, v, __ATOMIC_RELAXED, __HIP_MEMORY_SCOPE_AGENT); }
__device__ __forceinline__ unsigned xb_xcc_id() { return (unsigned)__builtin_amdgcn_s_getreg((3 << 11) | 20) & 0xFu; }
#define XB_SPIN(cond, bar) do { unsigned _sp = 0; while (cond) { __builtin_amdgcn_s_sleep(1); \
    if ((++_sp & 255u) == 0u) { if (xb_ld(&(bar)[XB_TMO])) break; if (_sp > XB_SPIN_CAP) { atomicAdd(&(bar)[XB_TMO], 1u); break; } } } } while (0)

struct XcdBarrier {
    unsigned* bar; unsigned x;
    volatile LAS unsigned* st;
};

__device__ __forceinline__ XcdBarrier xcd_barrier_post(unsigned* bar, volatile LAS unsigned* st) {
    XcdBarrier b; b.bar = bar; b.x = xb_xcc_id(); b.st = st;
    if (threadIdx.x == 0) (void)xb_add(&bar[XB_XCNT(b.x)], 1u);
    return b;
}
__device__ __forceinline__ void xcd_barrier_complete(unsigned* bar, unsigned x, unsigned& nloc, unsigned& nx) {
    const unsigned G = gridDim.x * gridDim.y * gridDim.z;
    unsigned sum, cnt, mine, sp = 0u;
    for (;;) {
        sum = 0u; cnt = 0u; mine = 0u;
#pragma unroll
        for (unsigned j = 0; j < 16; ++j) { const unsigned c = xb_ld(&bar[XB_XCNT(j)]); sum += c; cnt += (c > 0u) ? 1u : 0u; mine = (j == x) ? c : mine; }
        if (sum == G) break;
        __builtin_amdgcn_s_sleep(1);
        if ((++sp & 255u) == 0u) { if (xb_ld(&bar[XB_TMO])) break; if (sp > XB_SPIN_CAP) { atomicAdd(&bar[XB_TMO], 1u); break; } }
    }
    nloc = mine > 0u ? mine : 1u; nx = cnt > 0u ? cnt : 1u;
}

__device__ __forceinline__ void xcd_barrier(const XcdBarrier& b) {
    asm volatile("s_waitcnt vmcnt(0)" ::: "memory");
    __syncthreads();
    if (threadIdx.x == 0) {
        unsigned* bar = b.bar;
        __builtin_amdgcn_s_waitcnt(0);
        unsigned nloc = b.st[0], nx = b.st[1];
        if (nloc == 0u) { xcd_barrier_complete(bar, b.x, nloc, nx); b.st[0] = nloc; b.st[1] = nx; }
        const unsigned old = xb_add(&bar[XB_XSUB(b.x)], 1u);
        const unsigned gen = old / nloc;
        if (old + 1u == (gen + 1u) * nloc) {
            __builtin_amdgcn_fence(__ATOMIC_RELEASE, "agent");
            asm volatile("s_waitcnt vmcnt(0)" ::: "memory");
            const unsigned og = xb_add(&bar[XB_TOP], 1u);
            const unsigned tg = og / nx;
            if (og + 1u == (tg + 1u) * nx) xb_add(&bar[XB_TOPGEN], 1u);
            else XB_SPIN(xb_ld(&bar[XB_TOPGEN]) == tg, bar);
            __builtin_amdgcn_fence(__ATOMIC_ACQUIRE, "agent");
            xb_add(&bar[XB_XGEN(b.x)], 1u);
            asm volatile("s_waitcnt vmcnt(0)" ::: "memory");
        } else {
            XB_SPIN(xb_ld(&bar[XB_XGEN(b.x)]) == gen, bar);
            __builtin_amdgcn_fence(__ATOMIC_ACQUIRE, "agent");
            asm volatile("s_waitcnt vmcnt(0)" ::: "memory");
        }
    }
    __syncthreads();
}


constexpr int NWAVES = 8;
constexpr int RING_OFF = 0, RING_BYTES = 131072;
constexpr int LDSCTL_OFF = RING_BYTES, MISC_OFF = LDSCTL_OFF + 320;
constexpr int LDS_BYTES = 147456;
constexpr int CW_TMO = 0, CW_CODE = 1, CW_BAR = 4096;
constexpr int N_PHASES = 19;

struct Frame {
    LAS unsigned char* lds;
    volatile LAS unsigned* MISC;
    gu32* ctl;
    int tid, lane, wave, vcu, G;
};
struct Args { const float* in[18]; float* out; unsigned char* ws; int ph_lo, ph_hi, li, pad; };

__device__ __forceinline__ float wave_sum(float v) {
#pragma unroll
    for (int o = 1; o < 64; o <<= 1) v += __shfl_xor(v, o);
    return v;
}

struct PrepSeg { const float* W; const float* gain; bf16* dst; int ldin, col0, N, K, ldout, seg, seg_stride; };
__device__ __forceinline__ void prep_item(const PrepSeg& s, LAS float* scr, int item, int lane) {
    const int nblk = s.N / 32, kb = item / nblk, nb = item % nblk, k0 = 64 * kb, n0 = 32 * nb;
#pragma unroll 8
    for (int i = 0; i < 32; ++i) { const int kk = 2 * i + (lane >> 5); const float g = s.gain ? s.gain[k0 + kk] : 1.f; scr[kk * 33 + (lane & 31)] = s.W[(size_t)(k0 + kk) * s.ldin + s.col0 + n0 + (lane & 31)] * g; }
    LDS_WAIT(); asm volatile("" ::: "memory");
    const int c = lane & 7;
#pragma unroll
    for (int j = 0; j < 4; ++j) { const int n = n0 + (lane >> 3) + 8 * j; const LAS float* p = scr + (8 * c) * 33 + (lane >> 3) + 8 * j;
        v4u o; o.x = pk2(p[0 * 33], p[1 * 33]); o.y = pk2(p[2 * 33], p[3 * 33]); o.z = pk2(p[4 * 33], p[5 * 33]); o.w = pk2(p[6 * 33], p[7 * 33]);
        const int drow = (n / s.seg) * s.seg_stride + (n % s.seg);
        *(GAS v4u*)(s.dst + (size_t)drow * s.ldout + k0 + 8 * c) = o; }
    LDS_WAIT(); asm volatile("" ::: "memory");
}
constexpr int NSEG = 14;
__device__ const int SEG_DSTC[9] = {C_MQ, C_MK, C_MV, C_GQ, C_GK, C_GV, C_GR, C_PU, 0};
__device__ const int SEG_SRCC[9] = {O_MQ, O_MK, O_MV, O_GQ, O_GK, O_GV, O_GR, O_PU, O_GATE};
__device__ const int SEG_NN[9] = {512, 512, 512, 256, 256, 512, 512, 512, NGATE};
__device__ __forceinline__ void get_seg(const Args& a, int l, int s, PrepSeg& d) {
    unsigned char* wl = a.ws + WS_W + (size_t)l * W_LAYER;
    const float* win = a.in[2] + (size_t)l * DM * DIN; const float* gpre = a.in[1] + l * DM; const float* gffn = a.in[13] + l * DM;
    d.seg = 1 << 30; d.seg_stride = 0; d.gain = nullptr; d.col0 = 0;
    if (s < 9) {
        d.W = win; d.gain = gpre; d.ldin = DIN; d.col0 = SEG_SRCC[s]; d.N = SEG_NN[s]; d.K = DM; d.ldout = DM;
        d.dst = (s < 8) ? (bf16*)(wl + W_IN) + (size_t)SEG_DSTC[s] * DM : (bf16*)(wl + W_GATE);
    } else if (s == 9)  { d.W = a.in[8] + (size_t)l * 512 * 1024; d.ldin = 1024; d.N = 1024; d.K = 512; d.ldout = KBR; d.dst = (bf16*)(wl + W_BR); }
    else if (s == 10) { d.W = a.in[10] + (size_t)l * 512 * 1024; d.ldin = 1024; d.N = 1024; d.K = 512; d.ldout = KBR; d.dst = (bf16*)(wl + W_BR) + 1024; }
    else if (s == 11) { d.W = a.in[11] + (size_t)l * 1024 * 1024; d.ldin = 1024; d.N = 1024; d.K = 1024; d.ldout = DM; d.dst = (bf16*)(wl + W_OUT); }
    else if (s == 12) { d.W = a.in[14] + (size_t)l * DM * DFF; d.gain = gffn; d.ldin = DFF; d.N = DFF; d.K = DM; d.ldout = DM; d.dst = (bf16*)(wl + W_GU); d.seg = 128; d.seg_stride = 256; }
    else              { d.W = a.in[15] + (size_t)l * DM * DFF; d.gain = gffn; d.ldin = DFF; d.N = DFF; d.K = DM; d.ldout = DM; d.dst = (bf16*)(wl + W_GU) + (size_t)128 * DM; d.seg = 128; d.seg_stride = 256; }
}
__device__ __forceinline__ void p0_prologue(Frame& F, const Args& a) {
    int tid_ = threadIdx.x; asm volatile("" : "+v"(tid_)); const int tid = tid_, lane = tid & 63;
    LAS float* scr = (LAS float*)(F.lds + RING_OFF + F.wave * 16384);
    const int gw = F.vcu * NWAVES + F.wave, NGW = F.G * NWAVES;
    int base = 0;
    for (int l = 0; l < DEPTH; ++l) {
        for (int s = 0; s < NSEG + 1; ++s) {
            PrepSeg d;
            if (s < NSEG) get_seg(a, l, s, d);
            else { d.W = a.in[16] + (size_t)l * DFF * DM; d.gain = nullptr; d.ldin = DM; d.col0 = 0; d.N = DM; d.K = DFF; d.ldout = DFF; d.dst = (bf16*)(a.ws + WS_W + (size_t)l * W_LAYER + W_DN); d.seg = 1 << 30; d.seg_stride = 0; }
            const int nitems = (d.K / 64) * (d.N / 32);
            int first = gw - (base % NGW); if (first < 0) first += NGW;
            for (int it = first; it < nitems; it += NGW) prep_item(d, scr, it, lane);
            base += nitems;
        }
        const float* wp = a.in[6] + (size_t)l * 4 * 128 * 128; const float* sc = a.in[7] + l * 512; const float* Wb = a.in[9] + (size_t)l * 512 * 1024;
        bf16* WBR_t = (bf16*)(a.ws + WS_W + (size_t)l * W_LAYER + W_BR);
        for (int idx = (F.vcu * NWAVES * 64) + tid; idx < 64 * 1024; idx += F.G * NWAVES * 64) {
            const int n = idx & 1023, c8 = idx >> 10, g = c8 >> 4, c0 = (c8 & 15) * 8;
            float s8[8];
#pragma unroll
            for (int i = 0; i < 8; ++i) s8[i] = 0.f;
            for (int d = 0; d < 128; ++d) { const float wb = sc[g * 128 + d] * Wb[(size_t)(g * 128 + d) * 1024 + n];
#pragma unroll
                for (int i = 0; i < 8; ++i) s8[i] += wp[((size_t)g * 128 + c0 + i) * 128 + d] * wb; }
            v4u o; o.x = pk2(s8[0], s8[1]); o.y = pk2(s8[2], s8[3]); o.z = pk2(s8[4], s8[5]); o.w = pk2(s8[6], s8[7]);
            *(GAS v4u*)(WBR_t + (size_t)n * KBR + 512 + g * 128 + c0) = o;
        }
    }
}
__device__ __forceinline__ void rows_phase(Frame& F, const float* xsrc, const bf16* Fin, const float* wpost, float* xdst, bf16* XB, float* R, float* G1, const float* g1_win, const float* g1_gain) {
    int tid_ = threadIdx.x; asm volatile("" : "+v"(tid_)); const int tid = tid_;
    LAS float* wt = (LAS float*)(F.lds + RING_OFF);
    if (g1_win) {
        for (int idx = tid; idx < 16 * 1024; idx += NWAVES * 64) { const int k = idx >> 4, j = idx & 15; wt[j * 1024 + k] = g1_gain[k] * g1_win[(size_t)k * DIN + O_G1 + j]; }
        __syncthreads();
    }
    const int gw = F.vcu * NWAVES + F.wave, NGW = F.G * NWAVES, lane = tid & 63;
    for (int m = gw; m < M; m += NGW) {
        const GAS f32x4* xr = (const GAS f32x4*)(xsrc + (size_t)m * DM) + lane;
        f32x4 v[4];
#pragma unroll
        for (int j = 0; j < 4; ++j) v[j] = xr[64 * j];
        if (Fin) {
            const GAS unsigned long long* fr8 = (const GAS unsigned long long*)(Fin + (size_t)m * DM) + lane;
            f32x4 f[4]; float s = 0.f;
#pragma unroll
            for (int j = 0; j < 4; ++j) { const unsigned long long w = fr8[64 * j]; const unsigned lo = (unsigned)w, hi = (unsigned)(w >> 32);
                f[j] = (f32x4){__uint_as_float(lo << 16), __uint_as_float(lo & 0xffff0000u), __uint_as_float(hi << 16), __uint_as_float(hi & 0xffff0000u)};
                s += (f[j].x * f[j].x + f[j].y * f[j].y) + (f[j].z * f[j].z + f[j].w * f[j].w); }
            const float rf = 1.f / sqrtf(wave_sum(s) * (1.f / DM) + EPS);
#pragma unroll
            for (int j = 0; j < 4; ++j) { const f32x4 w = ((const GAS f32x4*)wpost)[64 * j + lane]; v[j] = v[j] + f[j] * rf * w; }
        }
        if (xdst) { GAS f32x4* xo = (GAS f32x4*)(xdst + (size_t)m * DM) + lane;
#pragma unroll
            for (int j = 0; j < 4; ++j) xo[64 * j] = v[j]; }
        if (XB) {
            float s = 0.f;
#pragma unroll
            for (int j = 0; j < 4; ++j) s += (v[j].x * v[j].x + v[j].y * v[j].y) + (v[j].z * v[j].z + v[j].w * v[j].w);
            const float r = 1.f / sqrtf(wave_sum(s) * (1.f / DM) + EPS);
            GAS unsigned long long* o8 = (GAS unsigned long long*)(XB + (size_t)m * DM) + lane;
#pragma unroll
            for (int j = 0; j < 4; ++j) o8[64 * j] = (unsigned long long)pk2(v[j].x, v[j].y) | ((unsigned long long)pk2(v[j].z, v[j].w) << 32);
            if (lane == 0) R[m] = r;
            if (g1_win) {
                float mine = 0.f;
#pragma unroll
                for (int jj = 0; jj < 16; ++jj) { float d = 0.f;
#pragma unroll
                    for (int j = 0; j < 4; ++j) { const f32x4 w = *(const LAS f32x4*)(wt + jj * 1024 + 4 * (64 * j + lane)); d += (v[j].x * w.x + v[j].y * w.y) + (v[j].z * w.z + v[j].w * w.w); }
                    d = wave_sum(d); if (lane == jj) mine = d; }
                if (lane < 16) G1[(size_t)m * 16 + lane] = mine * r;
            }
        }
    }
    if (g1_win) __syncthreads();
}


constexpr size_t WS_SEL = 5 * MiB;
__device__ __forceinline__ void kmean_phase(Frame& F, const bf16* PM, float* KM) {
    int tid_ = threadIdx.x; asm volatile("" : "+v"(tid_)); const int lane = tid_ & 63;
    const int gw = F.vcu * NWAVES + F.wave, NGW = F.G * NWAVES;
    for (int u = gw; u < BATCH * 16 * 8; u += NGW) {
        const int h = u & 7, n = (u >> 3) & 15, b = u >> 7;
        const bf16* p = PM + ((size_t)b * SEQ + n * 256) * NMIX + C_MK + h * 64 + lane;
        float s0 = 0.f, s1 = 0.f, s2 = 0.f, s3 = 0.f;
        for (int i = 0; i < 256; i += 4) { s0 += __uint_as_float((unsigned)p[(size_t)i * NMIX] << 16); s1 += __uint_as_float((unsigned)p[(size_t)(i + 1) * NMIX] << 16);
            s2 += __uint_as_float((unsigned)p[(size_t)(i + 2) * NMIX] << 16); s3 += __uint_as_float((unsigned)p[(size_t)(i + 3) * NMIX] << 16); }
        KM[(((size_t)b * 8 + h) * 16 + n) * 64 + lane] = ((s0 + s1) + (s2 + s3)) * (1.f / 256.f);
    }
}
__device__ __forceinline__ void topk_phase(Frame& F, const bf16* PM, const float* KM, unsigned* SEL) {
    int tid_ = threadIdx.x; asm volatile("" : "+v"(tid_)); const int lane = tid_ & 63;
    const int gw = F.vcu * NWAVES + F.wave, NGW = F.G * NWAVES;
    for (int u = gw; u < (M / 64) * 8; u += NGW) {
        const int h = u & 7, m0 = (u >> 3) * 64, m = m0 + lane, b = m0 >> 12, j = (m0 & (SEQ - 1)) >> 8;
        float q[64];
        const unsigned* qp = (const unsigned*)(PM + (size_t)m * NMIX + C_MQ + h * 64);
#pragma unroll
        for (int d = 0; d < 32; ++d) { const unsigned w = qp[d]; q[2 * d] = __uint_as_float(w << 16); q[2 * d + 1] = __uint_as_float(w & 0xffff0000u); }
        float b0 = -3e38f, b1 = -3e38f, b2 = -3e38f; int i0 = -1, i1 = -1, i2 = -1;
        for (int n = 0; n < j; ++n) {
            const float* km = KM + (((size_t)b * 8 + h) * 16 + n) * 64;
            float g = 0.f;
#pragma unroll
            for (int d = 0; d < 64; ++d) g += q[d] * km[d];
            if (g > b0) { b2 = b1; i2 = i1; b1 = b0; i1 = i0; b0 = g; i0 = n; }
            else if (g > b1) { b2 = b1; i2 = i1; b1 = g; i1 = n; }
            else if (g > b2) { b2 = g; i2 = n; }
        }
        unsigned sel = 0u;
        if (i0 >= 0) sel |= 1u << i0;
        if (i1 >= 0) sel |= 1u << i1;
        if (i2 >= 0) sel |= 1u << i2;
        SEL[((size_t)b * 8 + h) * SEQ + (m & (SEQ - 1))] = sel;
    }
}

namespace gla {
typedef short bf16x8 __attribute__((ext_vector_type(8)));
typedef float f32x4 __attribute__((ext_vector_type(4)));
constexpr int LP = 72, LPB = LP * 2;
constexpr int L_QD = 0, L_KI = 9216, L_KIT = 18432, L_VT = 27648, L_AT = 46080, L_SEG = 55296, L_RED = 57344, L_RN = 59392, L_END = 59648;
constexpr int NUNITS = BATCH * 4 * 64;
__device__ __forceinline__ bf16x8 frag(const LAS unsigned char* base, int row0, int k0, int lane) {
    return *(const LAS bf16x8*)(base + (row0 + (lane & 15)) * LPB + (k0 + 8 * (lane >> 4)) * 2);
}
__device__ __forceinline__ void load_vt(LAS unsigned char* lds, const bf16* PM, size_t m0, int h, int w, int lane) {
#pragma unroll
    for (int tt = 0; tt < 8; ++tt) { const int t = 8 * w + tt;
        const unsigned vw = *(const GAS unsigned*)(PM + (m0 + t) * NMIX + C_GV + h * 128 + 2 * lane);
        *(LAS unsigned short*)(lds + L_VT + (2 * lane) * LPB + t * 2) = (unsigned short)(vw & 0xffffu);
        *(LAS unsigned short*)(lds + L_VT + (2 * lane + 1) * LPB + t * 2) = (unsigned short)(vw >> 16); }
}
__device__ __forceinline__ void prep_unit(int u, LAS unsigned char* lds, bf16* PM, const float* G1, const float* w2, const float* bg, bf16* UT, float* EF, int w, int lane) {
    const int bh = u >> 6, c = u & 63, b = bh >> 2, h = bh & 3; const size_t m0 = (size_t)b * SEQ + c * 64;
    float wj[16];
#pragma unroll
    for (int j = 0; j < 16; ++j) wj[j] = w2[j * 256 + h * 64 + lane];
    const float bias = bg[h * 64 + lane];
    float cs[8]; float run = 0.f;
#pragma unroll
    for (int tt = 0; tt < 8; ++tt) { const float* g = G1 + (m0 + 8 * w + tt) * 16; float x = bias;
#pragma unroll
        for (int j = 0; j < 16; ++j) x += g[j] * wj[j];
        const float ls = fminf(x, 0.f) - __logf(1.f + __expf(-fabsf(x)));
        run += ls * (1.f / 16.f); cs[tt] = run; }
    LAS float* seg = (LAS float*)(lds + L_SEG);
    seg[w * 64 + lane] = run;
    load_vt(lds, PM, m0, h, w, lane);
    __syncthreads();
    float prefix = 0.f, ref = 0.f, tot = 0.f;
#pragma unroll
    for (int ww = 0; ww < 8; ++ww) { const float s = seg[ww * 64 + lane]; if (ww < w) prefix += s; if (ww < 4) ref += s; tot += s; }
#pragma unroll
    for (int tt = 0; tt < 8; ++tt) { const int t = 8 * w + tt; const float bc = prefix + cs[tt];
        const float e1 = __expf(bc - ref), e2 = __builtin_amdgcn_rcpf(e1);
        bf16* qp = PM + (m0 + t) * NMIX + C_GQ + h * 64 + lane; bf16* kp = PM + (m0 + t) * NMIX + C_GK + h * 64 + lane;
        const float q = __uint_as_float((unsigned)*qp << 16), k = __uint_as_float((unsigned)*kp << 16);
        const unsigned qi = f2bf(q * e1), ki = f2bf(k * e2);
        *qp = (bf16)qi; *kp = (bf16)ki;
        *(LAS unsigned short*)(lds + L_KIT + lane * LPB + t * 2) = (unsigned short)ki; }
    if (w == 0) { float* ef = EF + (size_t)u * 192; ef[lane] = __expf(tot); ef[64 + lane] = __expf(tot - ref); ef[128 + lane] = __expf(ref); }
    __syncthreads();
    const bf16x8 bv0 = frag(lds + L_VT, 16 * w, 0, lane), bv1 = frag(lds + L_VT, 16 * w, 32, lane);
#pragma unroll
    for (int dt = 0; dt < 4; ++dt) {
        const bf16x8 a0 = frag(lds + L_KIT, 16 * dt, 0, lane), a1 = frag(lds + L_KIT, 16 * dt, 32, lane);
        f32x4 acc = {0.f, 0.f, 0.f, 0.f};
        acc = __builtin_amdgcn_mfma_f32_16x16x32_bf16(a0, bv0, acc, 0, 0, 0);
        acc = __builtin_amdgcn_mfma_f32_16x16x32_bf16(a1, bv1, acc, 0, 0, 0);
        const int v = 16 * w + (lane & 15), d0 = 16 * dt + 4 * (lane >> 4);
        const unsigned long long pk = (unsigned long long)pk2(acc[0], acc[1]) | ((unsigned long long)pk2(acc[2], acc[3]) << 32);
        *(GAS unsigned long long*)(UT + ((size_t)u * 128 + v) * 64 + d0) = pk; }
    __syncthreads();
}
__device__ __forceinline__ void scan_phase(Frame& F, bf16* UT, const float* EF, int tid) {
    for (int idx = F.vcu * (NWAVES * 64) + tid; idx < BATCH * 4 * 128 * 32; idx += F.G * NWAVES * 64) {
        const int dp = idx & 31, v = (idx >> 5) & 127, bh = idx >> 12;
        float s0 = 0.f, s1 = 0.f;
        for (int cb = 0; cb < 64; cb += 8) {
            unsigned uw[8]; float ea0[8], ea1[8], eb0[8], eb1[8], ec0[8], ec1[8];
#pragma unroll
            for (int i = 0; i < 8; ++i) { const size_t u = (size_t)bh * 64 + cb + i;
                uw[i] = *(const GAS unsigned*)(UT + (u * 128 + v) * 64 + 2 * dp); const float* ef = EF + u * 192 + 2 * dp;
                ea0[i] = ef[0]; ea1[i] = ef[1]; eb0[i] = ef[64]; eb1[i] = ef[65]; ec0[i] = ef[128]; ec1[i] = ef[129]; }
#pragma unroll
            for (int i = 0; i < 8; ++i) { const size_t u = (size_t)bh * 64 + cb + i;
                const float u0 = __uint_as_float(uw[i] << 16), u1 = __uint_as_float(uw[i] & 0xffff0000u);
                *(GAS unsigned*)(UT + (u * 128 + v) * 64 + 2 * dp) = pk2(ec0[i] * s0, ec1[i] * s1);
                s0 = ea0[i] * s0 + eb0[i] * u0; s1 = ea1[i] * s1 + eb1[i] * u1; }
        }
    }
}
__device__ __forceinline__ void out_unit(int u, LAS unsigned char* lds, const bf16* PM, const bf16* UT, const float* nw, bf16* MO, int tid, int w, int lane) {
    const int bh = u >> 6, c = u & 63, b = bh >> 2, h = bh & 3; const size_t m0 = (size_t)b * SEQ + c * 64;
    { const int row = tid >> 3, ch = tid & 7;
        const v4u qv = *(const GAS v4u*)(PM + (m0 + row) * NMIX + C_GQ + h * 64 + ch * 8), kv = *(const GAS v4u*)(PM + (m0 + row) * NMIX + C_GK + h * 64 + ch * 8);
        *(LAS v4u*)(lds + L_QD + row * LPB + ch * 16) = qv; *(LAS v4u*)(lds + L_KI + row * LPB + ch * 16) = kv; }
    load_vt(lds, PM, m0, h, w, lane);
    __syncthreads();
    { const int tt = w >> 1; const bf16x8 a0 = frag(lds + L_QD, 16 * tt, 0, lane), a1 = frag(lds + L_QD, 16 * tt, 32, lane);
#pragma unroll
        for (int i = 0; i < 2; ++i) { const int st = 2 * (w & 1) + i;
            const bf16x8 b0 = frag(lds + L_KI, 16 * st, 0, lane), b1 = frag(lds + L_KI, 16 * st, 32, lane);
            f32x4 acc = {0.f, 0.f, 0.f, 0.f};
            acc = __builtin_amdgcn_mfma_f32_16x16x32_bf16(a0, b0, acc, 0, 0, 0);
            acc = __builtin_amdgcn_mfma_f32_16x16x32_bf16(a1, b1, acc, 0, 0, 0);
            const int s = 16 * st + (lane & 15);
#pragma unroll
            for (int j = 0; j < 4; ++j) { const int t = 16 * tt + 4 * (lane >> 4) + j;
                *(LAS unsigned short*)(lds + L_AT + t * LPB + s * 2) = (unsigned short)f2bf(s <= t ? acc[j] : 0.f); } } }
    __syncthreads();
    const int v = 16 * w + (lane & 15);
    const bf16x8 bs0 = *(const GAS bf16x8*)(UT + ((size_t)u * 128 + v) * 64 + 8 * (lane >> 4)), bs1 = *(const GAS bf16x8*)(UT + ((size_t)u * 128 + v) * 64 + 32 + 8 * (lane >> 4));
    const bf16x8 bv0 = frag(lds + L_VT, 16 * w, 0, lane), bv1 = frag(lds + L_VT, 16 * w, 32, lane);
    f32x4 o[4];
    LAS float* red = (LAS float*)(lds + L_RED);
#pragma unroll
    for (int tt = 0; tt < 4; ++tt) {
        const bf16x8 q0 = frag(lds + L_QD, 16 * tt, 0, lane), q1 = frag(lds + L_QD, 16 * tt, 32, lane), p0 = frag(lds + L_AT, 16 * tt, 0, lane), p1 = frag(lds + L_AT, 16 * tt, 32, lane);
        f32x4 acc = {0.f, 0.f, 0.f, 0.f};
        acc = __builtin_amdgcn_mfma_f32_16x16x32_bf16(q0, bs0, acc, 0, 0, 0);
        acc = __builtin_amdgcn_mfma_f32_16x16x32_bf16(q1, bs1, acc, 0, 0, 0);
        acc = __builtin_amdgcn_mfma_f32_16x16x32_bf16(p0, bv0, acc, 0, 0, 0);
        acc = __builtin_amdgcn_mfma_f32_16x16x32_bf16(p1, bv1, acc, 0, 0, 0);
        o[tt] = acc;
#pragma unroll
        for (int j = 0; j < 4; ++j) { float p = acc[j] * acc[j];
            p += __shfl_xor(p, 1); p += __shfl_xor(p, 2); p += __shfl_xor(p, 4); p += __shfl_xor(p, 8);
            if ((lane & 15) == 0) red[w * 64 + 16 * tt + 4 * (lane >> 4) + j] = p; } }
    __syncthreads();
    LAS float* rn = (LAS float*)(lds + L_RN);
    if (tid < 64) { float s = 0.f;
#pragma unroll
        for (int ww = 0; ww < 8; ++ww) s += red[ww * 64 + tid];
        rn[tid] = 1.f / sqrtf(s * (1.f / 128.f) + EPS); }
    __syncthreads();
    const float nwv = nw[v];
#pragma unroll
    for (int tt = 0; tt < 4; ++tt)
#pragma unroll
        for (int j = 0; j < 4; ++j) { const int t = 16 * tt + 4 * (lane >> 4) + j;
            const float sr = __uint_as_float((unsigned)PM[(m0 + t) * NMIX + C_GR + h * 128 + v] << 16);
            MO[(m0 + t) * KBR + h * 128 + v] = (bf16)f2bf(o[tt][j] * rn[t] * nwv * sr); }
    __syncthreads();
}
__device__ __forceinline__ void pool_phase(Frame& F, const bf16* PM, bf16* MO, int tid) {
    for (int idx = F.vcu * (NWAVES * 64) + tid; idx < M * 64; idx += F.G * NWAVES * 64) {
        const int ch = idx & 63, m = idx >> 6, t = m & (SEQ - 1), win = 2 << (ch >> 4), cnt = (t + 1 < win) ? (t + 1) : win;
        float s[8];
#pragma unroll
        for (int i = 0; i < 8; ++i) s[i] = 0.f;
        v4u x0 = {0u, 0u, 0u, 0u};
        for (int i = 0; i < cnt; ++i) { const v4u x = *(const GAS v4u*)(PM + (size_t)(m - i) * NMIX + C_PU + ch * 8); if (i == 0) x0 = x;
            s[0] += __uint_as_float(x.x << 16); s[1] += __uint_as_float(x.x & 0xffff0000u); s[2] += __uint_as_float(x.y << 16); s[3] += __uint_as_float(x.y & 0xffff0000u);
            s[4] += __uint_as_float(x.z << 16); s[5] += __uint_as_float(x.z & 0xffff0000u); s[6] += __uint_as_float(x.w << 16); s[7] += __uint_as_float(x.w & 0xffff0000u); }
        const float ic = 1.f / (float)cnt;
        v4u o; o.x = pk2(s[0] * ic - __uint_as_float(x0.x << 16), s[1] * ic - __uint_as_float(x0.x & 0xffff0000u)); o.y = pk2(s[2] * ic - __uint_as_float(x0.y << 16), s[3] * ic - __uint_as_float(x0.y & 0xffff0000u));
        o.z = pk2(s[4] * ic - __uint_as_float(x0.z << 16), s[5] * ic - __uint_as_float(x0.z & 0xffff0000u)); o.w = pk2(s[6] * ic - __uint_as_float(x0.w << 16), s[7] * ic - __uint_as_float(x0.w & 0xffff0000u));
        *(GAS v4u*)(MO + (size_t)m * KBR + 512 + ch * 8) = o;
    }
}
}

__global__ void __launch_bounds__(NWAVES * 64, 2) mega_fwd(Args args) {
    extern __shared__ __attribute__((aligned(16))) unsigned char lds[];
    Frame F;
    F.lds = (LAS unsigned char*)lds;
    F.MISC = (volatile LAS unsigned*)(F.lds + MISC_OFF);
    F.tid = threadIdx.x; F.lane = F.tid & 63; F.wave = __builtin_amdgcn_readfirstlane(F.tid >> 6);
    F.G = gridDim.x; { const int bx = blockIdx.x; F.vcu = (F.G % 8 == 0) ? (bx % 8) * (F.G / 8) + bx / 8 : bx; }
    unsigned char* ws = args.ws;
    F.ctl = (gu32*)(ws + WS_CTL);
    for (int u = F.tid; u < (LDS_BYTES - LDSCTL_OFF) / 4; u += NWAVES * 64) ((LAS unsigned*)(F.lds + LDSCTL_OFF))[u] = 0u;
    __syncthreads();
    XcdBarrier bar = xcd_barrier_post((unsigned*)(F.ctl + CW_BAR) + args.li * XCD_BAR_WORDS, F.MISC + 8);
    const int lo = args.ph_lo, hi = args.ph_hi;
#define IN(k) (lo <= (k) && (k) < hi)
#define SEAM(k) do { if (IN(k) && IN((k) + 1)) xcd_barrier(bar); } while (0)
    const float* x = args.in[0]; float* out = args.out;
    float* R = (float*)(ws + WS_R); float* G1 = (float*)(ws + WS_G1);
    bf16* XB = (bf16*)(ws + WS_XB); bf16* PM = (bf16*)(ws + WS_PM); bf16* MO = (bf16*)(ws + WS_MO);
    bf16* GATES = (bf16*)(ws + WS_GATES); bf16* MIXED = (bf16*)(ws + WS_MIXED); bf16* F1 = (bf16*)(ws + WS_F1); bf16* HDN = (bf16*)(ws + WS_HDN); bf16* F2 = (bf16*)(ws + WS_F2);

    if (IN(0)) { p0_prologue(F, args); __syncthreads();     rows_phase(F, x, nullptr, nullptr, nullptr, XB, R, G1, args.in[2], args.in[1]); }
    SEAM(0);
    for (int l = 0; l < DEPTH; ++l) {
        const int pb = 1 + 9 * l;
        unsigned char* wl = ws + WS_W + (size_t)l * W_LAYER;
        const bf16* WIN_t = (const bf16*)(wl + W_IN); const bf16* WGATE_t = (const bf16*)(wl + W_GATE); const bf16* WBR_t = (const bf16*)(wl + W_BR);
        const bf16* WOUT_t = (const bf16*)(wl + W_OUT); const bf16* WGU_t = (const bf16*)(wl + W_GU); const bf16* WDN_t = (const bf16*)(wl + W_DN);
        if (IN(pb + 0)) {
            pg8::Gemm g{XB, WIN_t, M, NMIX, DM, DM, 0}; pg8::StaticOrder S; S.init(M, NMIX, F.G, (int)blockIdx.x);
            pg8::EpiProj E{PM, R};
            pg8::gemm_phase<pg8::EpiProj, pg8::StaticOrder, true, true>(F.lds + RING_OFF, g, S, E);
        }
        SEAM(pb + 0);
        if (IN(pb + 1)) {
            float* KM = (float*)(ws + WS_KM); unsigned* SEL = (unsigned*)(ws + WS_SEL); bf16* UT = (bf16*)(ws + WS_UT); float* EF = (float*)(ws + WS_EF);
            int tid_ = threadIdx.x; asm volatile("" : "+v"(tid_)); const int tid = tid_, lane = tid & 63;
            kmean_phase(F, PM, KM);
            for (int u = F.vcu; u < gla::NUNITS; u += F.G) gla::prep_unit(u, F.lds + RING_OFF, PM, G1, args.in[3] + l * 16 * 256, args.in[4] + l * 256, UT, EF, F.wave, lane);
            gla::pool_phase(F, PM, MO, tid);
            xcd_barrier(bar);
            topk_phase(F, PM, KM, SEL);
            gla::scan_phase(F, UT, EF, tid);
            xcd_barrier(bar);
            const attn_body::AttnTensors AT{(const attn_body::bf16*)(PM + C_MQ), (const attn_body::bf16*)(PM + C_MK), (const attn_body::bf16*)(PM + C_MV), (attn_body::bf16*)(MO + 1024), SEL};
            const attn_body::StaticOrder S((int)F.G, F.vcu);
            attn_body::attn_phase<attn_body::StaticOrder>((char*)lds + RING_OFF, AT, S);
            for (int u = F.vcu; u < gla::NUNITS; u += F.G) gla::out_unit(u, F.lds + RING_OFF, PM, UT, args.in[5] + l * 128, MO, tid, F.wave, lane);
        }
        SEAM(pb + 1);
        if (IN(pb + 2)) {
            pg8::Gemm g{XB, WGATE_t, M, NGATE, DM, DM, 0}; pg8::StaticOrder S; S.init(M, NGATE, F.G, (int)blockIdx.x);
            pg8::EpiSig E{GATES, R};
            pg8::gemm_phase<pg8::EpiSig, pg8::StaticOrder, true, true>(F.lds + RING_OFF, g, S, E);
        }
        SEAM(pb + 2);
        if (IN(pb + 3)) {
            pg8::Gemm g{MO, WBR_t, M, DM, KBR, 512, 1024}; pg8::SegOrder3 S; S.S.init(M, DM, F.G, (int)blockIdx.x);
            pg8::EpiMixed E{MIXED, GATES};
            pg8::gemm_phase<pg8::EpiMixed, pg8::SegOrder3, true, true>(F.lds + RING_OFF, g, S, E);
        }
        SEAM(pb + 3);
        if (IN(pb + 4)) {
            pg8::Gemm g{MIXED, WOUT_t, M, DM, DM, DM, 0}; pg8::StaticOrder S; S.init(M, DM, F.G, (int)blockIdx.x);
            pg8::EpiPlain E{F1};
            pg8::gemm_phase<pg8::EpiPlain, pg8::StaticOrder, true, true>(F.lds + RING_OFF, g, S, E);
        }
        SEAM(pb + 4);
        if (IN(pb + 5)) rows_phase(F, l == 0 ? x : out, F1, args.in[12] + l * DM, out, XB, R, nullptr, nullptr, nullptr);
        SEAM(pb + 5);
        if (IN(pb + 6)) {
            pg8::Gemm g{XB, WGU_t, M, 2 * DFF, DM, DM, 0}; pg8::StaticOrder S; S.init(M, 2 * DFF, F.G, (int)blockIdx.x);
            pg8::EpiSwiglu E{HDN, R};
            pg8::gemm_phase<pg8::EpiSwiglu, pg8::StaticOrder, true, true>(F.lds + RING_OFF, g, S, E);
        }
        SEAM(pb + 6);
        if (IN(pb + 7)) {
            pg8::Gemm g{HDN, WDN_t, M, DM, DFF, DFF, 0}; pg8::StaticOrder S; S.init(M, DM, F.G, (int)blockIdx.x);
            pg8::EpiPlain E{F2};
            pg8::gemm_phase<pg8::EpiPlain, pg8::StaticOrder, true, true>(F.lds + RING_OFF, g, S, E);
        }
        SEAM(pb + 7);
        if (IN(pb + 8)) {
            const bool last = (l == DEPTH - 1);
            rows_phase(F, out, F2, args.in[17] + l * DM, out, last ? nullptr : XB, last ? nullptr : R, last ? nullptr : G1,
                       last ? nullptr : args.in[2] + (size_t)(l + 1) * DM * DIN, last ? nullptr : args.in[1] + (l + 1) * DM);
        }
        SEAM(pb + 8);
    }
#undef IN
#undef SEAM
}

extern "C" void kernel_launch(void* const* d_in, const int* in_sizes, int n_in, void* d_out, int out_size, void* d_ws, size_t ws_size, hipStream_t stream) {
    static int grid = 0;
    if (grid == 0) {
        if (n_in != 18 || in_sizes[0] != M * DM || out_size != M * DM || ws_size < WS_END) { fprintf(stderr, "kernel_launch: unexpected shapes (n_in %d, out %d, ws %zu); nothing launched\n", n_in, out_size, ws_size); grid = -1; return; }
        int dev = 0, cus = 0, per_cu = 0;
        if (hipGetDevice(&dev) != hipSuccess || hipDeviceGetAttribute(&cus, hipDeviceAttributeMultiprocessorCount, dev) != hipSuccess) { grid = -1; return; }
        if (hipFuncSetAttribute((const void*)mega_fwd, hipFuncAttributeMaxDynamicSharedMemorySize, LDS_BYTES) != hipSuccess) { fprintf(stderr, "kernel_launch: hipFuncSetAttribute failed\n"); grid = -1; return; }
        if (hipOccupancyMaxActiveBlocksPerMultiprocessor(&per_cu, (const void*)mega_fwd, NWAVES * 64, LDS_BYTES) != hipSuccess || per_cu < 1) { fprintf(stderr, "kernel_launch: occupancy query reports %d blocks per CU; nothing launched\n", per_cu); (void)hipGetLastError(); grid = -1; return; }
        grid = cus;
    }
    if (grid < 0) return;
    if (hipMemsetAsync((char*)d_ws + WS_CTL, 0, CTL_ZERO_BYTES, stream) != hipSuccess) return;
    Args a{};
    for (int i = 0; i < 18; ++i) a.in[i] = (const float*)d_in[i];
    a.out = (float*)d_out; a.ws = (unsigned char*)d_ws;
    a.ph_lo = 0; a.ph_hi = N_PHASES; a.li = 0;
    hipLaunchKernelGGL(mega_fwd, dim3(grid), dim3(NWAVES * 64), LDS_BYTES, stream, a);
}
```

```cpp
#include <hip/hip_runtime.h>
#include <hip/hip_bf16.h>
#include <cmath>
#include <stdint.h>
#include <cstdio>
#ifndef PROBE_MASK
#define PROBE_MASK 0
#endif

constexpr int BATCH = 8, SEQ = 4096, DM = 1024, M = BATCH * SEQ, DEPTH = 2;
constexpr int DIN = 6672, NMIX = 3584, NGATE = 3072, DFF = 2816, KBR = 1536;
constexpr int C_MQ = 0, C_MK = 512, C_MV = 1024, C_GQ = 1536, C_GK = 1792, C_GV = 2048, C_GR = 2560, C_PU = 3072;
constexpr int O_GQ = 0, O_GK = 256, O_GV = 512, O_G1 = 1024, O_GR = 1040, O_PU = 1552, O_MQ = 2064, O_MK = 2576, O_MV = 3088, O_GATE = 3600;
constexpr float EPS = 1e-6f;

constexpr size_t MiB = 1u << 20;
constexpr size_t WS_CTL = 0, CTL_ZERO_BYTES = 1 * MiB;
constexpr size_t WS_R = 1 * MiB;
constexpr size_t WS_G1 = 2 * MiB;
constexpr size_t WS_KM = 4 * MiB;
constexpr size_t WS_W = 6 * MiB, W_LAYER = 35 * MiB;
constexpr size_t W_IN = 0, W_GATE = 7 * MiB, W_BR = 13 * MiB, W_OUT = 16 * MiB, W_GU = 18 * MiB, W_DN = 29 * MiB;
constexpr size_t WS_XB = 76 * MiB;
constexpr size_t WS_PM = 140 * MiB;
constexpr size_t WS_MO = 364 * MiB;
constexpr size_t WS_UT = 460 * MiB;
constexpr size_t WS_EF = 492 * MiB;
constexpr size_t WS_GATES = WS_PM;
constexpr size_t WS_MIXED = WS_XB;
constexpr size_t WS_F1 = WS_MO;
constexpr size_t WS_HDN = WS_PM;
constexpr size_t WS_F2 = WS_MO;
constexpr size_t WS_END = 512 * MiB;

typedef unsigned short bf16_t;
namespace pg8 {
#define PG8_LAS __attribute__((address_space(3)))
typedef unsigned short bf16_t;
typedef short bf16x8 __attribute__((ext_vector_type(8)));
typedef float f32x4 __attribute__((ext_vector_type(4)));
typedef unsigned u32x4 __attribute__((ext_vector_type(4)));
constexpr int BM = 256, BK = 64, HALF = 128, HTB = HALF * BK * 2  , STAGE_BYTES = 8 * HTB, NXCD = 8, WGM = 8;

__host__ __device__ __forceinline__ int lds_byte(int r, int c) { const int st = (r >> 4) * 2 + (c >> 5), rr = r & 15, cc = c & 31, ob = rr * 64 + cc * 2; return st * 1024 + (ob ^ (((ob >> 9) & 1) << 5)); }
__host__ __device__ __forceinline__ void stage_rc(int b, int& R, int& C) { const int st = b / 1024, sb = b % 1024, swz = sb ^ (((sb >> 9) & 1) << 5); R = (st >> 1) * 16 + swz / 64; C = (st & 1) * 32 + (swz % 64) / 2; }
__host__ __device__ __forceinline__ int perm32(int rho) { const int n = rho >> 4, i = rho & 15; return 8 * (i >> 2) + 4 * n + (i & 3); }

struct Unit { int pm, pn, ks; };
struct Gemm { const bf16_t* A; const bf16_t* Bt; int M, N, K, Kt, ksb; };

struct StaticOrder {
    int nM, nN, nwg, G, c;
    __host__ __device__ void init(int M, int N, int G_, int c_) { nM = M / BM; nN = N / BM; nwg = nM * nN; G = G_; c = c_; }
    __host__ __device__ bool next(int i, Unit& u) const {
        const long L = (long)i * G + c; if (L >= nwg) return false;
        int wgid = (int)L; { const int q = nwg / NXCD, r = nwg % NXCD, xcd = wgid % NXCD, off = wgid / NXCD; wgid = (xcd < r ? xcd * (q + 1) : r * (q + 1) + (xcd - r) * q) + off; }
        const int nig = WGM * nN, gid = wgid / nig, fm = gid * WGM, gsz = (nM - fm) < WGM ? (nM - fm) : WGM;
        u.pm = fm + ((wgid % nig) % gsz); u.pn = (wgid % nig) / gsz; u.ks = 0; return true;
    }
    __device__ __forceinline__ void a_ready(const Unit&) const {}
    __device__ __forceinline__ void done(const Unit&) const {}
};

__device__ __forceinline__ unsigned cvt_pk_bf16(float lo, float hi) { unsigned r; asm volatile("v_cvt_pk_bf16_f32 %0, %1, %2" : "=v"(r) : "v"(lo), "v"(hi)); return r; }
struct SegOrder3 {
    StaticOrder S;
    __device__ __forceinline__ bool next(int i, Unit& u) const { const int q = i / 3; if (!S.next(q, u)) return false; u.ks = i - 3 * q; return true; }
    __device__ __forceinline__ void a_ready(const Unit&) const {}
    __device__ __forceinline__ void done(const Unit&) const {}
};
__device__ __forceinline__ float fast_sigmoid(float x) { return __builtin_amdgcn_rcpf(1.f + __expf(-x)); }
__device__ __forceinline__ float bflo(unsigned w) { return __uint_as_float(w << 16); }
__device__ __forceinline__ float bfhi(unsigned w) { return __uint_as_float(w & 0xffff0000u); }
struct EpiProj {
    static constexpr bool PERM = true, AFTER_DRAIN = false, SEGS = false;
    bf16_t* O; const float* R;
    __device__ __forceinline__ void operator()(const f32x4 (&acc)[2][2][4][2], const Unit& u, int wr, int wc, int fr, int fq) const {
        const int pn = u.pn; const float cs = (pn < 2) ? 0.125f * 1.4426950408889634f : (pn == 6) ? 0.125f : 1.f; const bool silu = (pn == 10 || pn == 11);
        const int row0 = u.pm * BM + wr * 64 + fr, col0 = pn * BM + wc * 32 + 8 * fq;
#pragma unroll
        for (int ai = 0; ai < 2; ++ai)
#pragma unroll
            for (int m = 0; m < 4; ++m) { const int row = row0 + ai * HALF + m * 16; const float r = R[row] * cs; bf16_t* rowp = O + (size_t)row * 3584 + col0;
#pragma unroll
                for (int bj = 0; bj < 2; ++bj) { f32x4 v0 = acc[ai][bj][m][0] * r, v1 = acc[ai][bj][m][1] * r;
                    if (silu) {
#pragma unroll
                        for (int i = 0; i < 4; ++i) { v0[i] = v0[i] * fast_sigmoid(v0[i]); v1[i] = v1[i] * fast_sigmoid(v1[i]); } }
                    u32x4 w; w.x = cvt_pk_bf16(v0[0], v0[1]); w.y = cvt_pk_bf16(v0[2], v0[3]); w.z = cvt_pk_bf16(v1[0], v1[1]); w.w = cvt_pk_bf16(v1[2], v1[3]);
                    *(u32x4*)(rowp + bj * HALF) = w; } }
    }
};
struct EpiSig {
    static constexpr bool PERM = true, AFTER_DRAIN = false, SEGS = false;
    bf16_t* O; const float* R;
    __device__ __forceinline__ void operator()(const f32x4 (&acc)[2][2][4][2], const Unit& u, int wr, int wc, int fr, int fq) const {
        const int row0 = u.pm * BM + wr * 64 + fr, col0 = u.pn * BM + wc * 32 + 8 * fq;
#pragma unroll
        for (int ai = 0; ai < 2; ++ai)
#pragma unroll
            for (int m = 0; m < 4; ++m) { const int row = row0 + ai * HALF + m * 16; const float r = R[row]; bf16_t* rowp = O + (size_t)row * 3072 + col0;
#pragma unroll
                for (int bj = 0; bj < 2; ++bj) { f32x4 v0 = acc[ai][bj][m][0] * r, v1 = acc[ai][bj][m][1] * r;
#pragma unroll
                    for (int i = 0; i < 4; ++i) { v0[i] = fmaxf(fast_sigmoid(v0[i]), 1e-18f); v1[i] = fmaxf(fast_sigmoid(v1[i]), 1e-18f); }
                    u32x4 w; w.x = cvt_pk_bf16(v0[0], v0[1]); w.y = cvt_pk_bf16(v0[2], v0[3]); w.z = cvt_pk_bf16(v1[0], v1[1]); w.w = cvt_pk_bf16(v1[2], v1[3]);
                    *(u32x4*)(rowp + bj * HALF) = w; } }
    }
};
struct EpiPlain {
    static constexpr bool PERM = true, AFTER_DRAIN = false, SEGS = false;
    bf16_t* O;
    __device__ __forceinline__ void operator()(const f32x4 (&acc)[2][2][4][2], const Unit& u, int wr, int wc, int fr, int fq) const {
        const int row0 = u.pm * BM + wr * 64 + fr, col0 = u.pn * BM + wc * 32 + 8 * fq;
#pragma unroll
        for (int ai = 0; ai < 2; ++ai)
#pragma unroll
            for (int m = 0; m < 4; ++m) { bf16_t* rowp = O + (size_t)(row0 + ai * HALF + m * 16) * 1024 + col0;
#pragma unroll
                for (int bj = 0; bj < 2; ++bj) { const f32x4 v0 = acc[ai][bj][m][0], v1 = acc[ai][bj][m][1];
                    u32x4 w; w.x = cvt_pk_bf16(v0[0], v0[1]); w.y = cvt_pk_bf16(v0[2], v0[3]); w.z = cvt_pk_bf16(v1[0], v1[1]); w.w = cvt_pk_bf16(v1[2], v1[3]);
                    *(u32x4*)(rowp + bj * HALF) = w; } }
    }
};
struct EpiSwiglu {
    static constexpr bool PERM = true, AFTER_DRAIN = false, SEGS = false;
    bf16_t* O; const float* R;
    __device__ __forceinline__ void operator()(const f32x4 (&acc)[2][2][4][2], const Unit& u, int wr, int wc, int fr, int fq) const {
        const int row0 = u.pm * BM + wr * 64 + fr, col0 = u.pn * HALF + wc * 32 + 8 * fq;
#pragma unroll
        for (int ai = 0; ai < 2; ++ai)
#pragma unroll
            for (int m = 0; m < 4; ++m) { const int row = row0 + ai * HALF + m * 16; const float r = R[row];
                f32x4 h0, h1;
#pragma unroll
                for (int i = 0; i < 4; ++i) { const float g0 = acc[ai][0][m][0][i] * r, g1 = acc[ai][0][m][1][i] * r;
                    h0[i] = g0 * fast_sigmoid(g0) * (acc[ai][1][m][0][i] * r); h1[i] = g1 * fast_sigmoid(g1) * (acc[ai][1][m][1][i] * r); }
                u32x4 w; w.x = cvt_pk_bf16(h0[0], h0[1]); w.y = cvt_pk_bf16(h0[2], h0[3]); w.z = cvt_pk_bf16(h1[0], h1[1]); w.w = cvt_pk_bf16(h1[2], h1[3]);
                *(u32x4*)(O + (size_t)row * 2816 + col0) = w; }
    }
};
struct EpiMixed {
    static constexpr bool PERM = true, AFTER_DRAIN = false, SEGS = true;
    bf16_t* O; const bf16_t* G;
    __device__ __forceinline__ void operator()(f32x4 (&acc)[2][2][4][2], const Unit& u, int wr, int wc, int fr, int fq) const {
        const int row0 = u.pm * BM + wr * 64 + fr, col0 = u.pn * BM + wc * 32 + 8 * fq;
        if (u.ks < 2) {
            const char* gb = (const char*)G + (size_t)u.ks * 2048;
#pragma unroll
            for (int ai = 0; ai < 2; ++ai)
#pragma unroll
                for (int m = 0; m < 4; ++m) { const unsigned off = ((unsigned)(row0 + ai * HALF + m * 16) * 3072u + (unsigned)col0) * 2u;
#pragma unroll
                    for (int bj = 0; bj < 2; ++bj) { const u32x4 a = *(const u32x4*)(gb + off + bj * 256), b = *(const u32x4*)(gb + off + 2048 + bj * 256);
                        f32x4 r0, r1;
                        r0[0] = bflo(a.x) * __builtin_amdgcn_rcpf(bflo(b.x)); r0[1] = bfhi(a.x) * __builtin_amdgcn_rcpf(bfhi(b.x));
                        r0[2] = bflo(a.y) * __builtin_amdgcn_rcpf(bflo(b.y)); r0[3] = bfhi(a.y) * __builtin_amdgcn_rcpf(bfhi(b.y));
                        r1[0] = bflo(a.z) * __builtin_amdgcn_rcpf(bflo(b.z)); r1[1] = bfhi(a.z) * __builtin_amdgcn_rcpf(bfhi(b.z));
                        r1[2] = bflo(a.w) * __builtin_amdgcn_rcpf(bflo(b.w)); r1[3] = bfhi(a.w) * __builtin_amdgcn_rcpf(bfhi(b.w));
                        acc[ai][bj][m][0] *= r0; acc[ai][bj][m][1] *= r1; }
                    asm volatile("" ::: "memory"); }
        } else {
#pragma unroll
            for (int ai = 0; ai < 2; ++ai)
#pragma unroll
                for (int m = 0; m < 4; ++m) { const int row = row0 + ai * HALF + m * 16; const bf16_t* gp = G + (size_t)row * 3072 + 2048 + col0; bf16_t* rowp = O + (size_t)row * 1024 + col0;
#pragma unroll
                    for (int bj = 0; bj < 2; ++bj) { const u32x4 a = *(const u32x4*)(gp + bj * HALF); const f32x4 v0 = acc[ai][bj][m][0], v1 = acc[ai][bj][m][1];
                        u32x4 w; w.x = cvt_pk_bf16(v0[0] * bflo(a.x), v0[1] * bfhi(a.x)); w.y = cvt_pk_bf16(v0[2] * bflo(a.y), v0[3] * bfhi(a.y));
                        w.z = cvt_pk_bf16(v1[0] * bflo(a.z), v1[1] * bfhi(a.z)); w.w = cvt_pk_bf16(v1[2] * bflo(a.w), v1[3] * bfhi(a.w));
                        *(u32x4*)(rowp + bj * HALF) = w; }
                    asm volatile("" ::: "memory"); }
        }
    }
};

template <class Epi, class Sched, bool ALIGN_EPI = false, bool SP2 = false>
__device__ __forceinline__ void gemm_phase(PG8_LAS unsigned char* lds, const Gemm g, const Sched& S, const Epi& E) {
    int tid_ = threadIdx.x; asm volatile("" : "+v"(tid_));
    const int tid = tid_, wid = __builtin_amdgcn_readfirstlane(tid >> 6), lane = tid & 63, wr = wid >> 2, wc = wid & 3, fr = lane & 15, fq = lane >> 4;
    const int K = g.K, nt = g.Kt / BK;
    unsigned voffA[2], voffB[2];
#pragma unroll
    for (int i = 0; i < 2; ++i) { int R, C; stage_rc(tid * 16 + i * 8192, R, C); const int Rb = Epi::PERM ? ((R & ~31) + perm32(R & 31)) : R;
        voffA[i] = (unsigned)(R * K + C) * 2u; voffB[i] = (unsigned)(Rb * K + C) * 2u; }
    const size_t kstep = (size_t)(BK * 2);
    const size_t hstep = (size_t)HALF * K * 2;
    const size_t tstep = 2 * hstep;
    const unsigned ldsw = (unsigned)wid * 1024u;
    const int aoff = lds_byte(wr * 64 + fr, fq * 8), boff = lds_byte(wc * 32 + fr, fq * 8);
#define PG8_SA(b, h) (((b) * 2 + (h)) * HTB)
#define PG8_SB(b, h) ((4 + (b) * 2 + (h)) * HTB)
#define PG8_STAGE(bufoff, gbase, voff) do { _Pragma("unroll") for (int _i = 0; _i < 2; ++_i) \
        __builtin_amdgcn_global_load_lds((const unsigned*)((const char*)(gbase) + (voff)[_i]), (PG8_LAS unsigned*)(lds + (bufoff) + ldsw + _i * 8192), 16, 0, 0); } while (0)
#define PG8_LDA(dst, b, h) do { _Pragma("unroll") for (int m = 0; m < 4; ++m) _Pragma("unroll") for (int k = 0; k < 2; ++k) dst[m][k] = *(const PG8_LAS bf16x8*)(lds + PG8_SA(b, h) + aoff + m * 2048 + k * 1024); } while (0)
#define PG8_LDB(dst, b, h) do { _Pragma("unroll") for (int n = 0; n < 2; ++n) _Pragma("unroll") for (int k = 0; k < 2; ++k) dst[n][k] = *(const PG8_LAS bf16x8*)(lds + PG8_SB(b, h) + boff + n * 2048 + k * 1024); } while (0)
#define PG8_MMA(ai, bj, At, Bt) do { __builtin_amdgcn_s_setprio(1); _Pragma("unroll") for (int m = 0; m < 4; ++m) _Pragma("unroll") for (int n = 0; n < 2; ++n) _Pragma("unroll") for (int k = 0; k < 2; ++k) \
        acc[ai][bj][m][n] = __builtin_amdgcn_mfma_f32_16x16x32_bf16(Bt[n][k], At[m][k], acc[ai][bj][m][n], 0, 0, 0); __builtin_amdgcn_s_setprio(0); } while (0)
#define PG8_WAIT_V(n) asm volatile("s_waitcnt vmcnt(" #n ")" ::: "memory")
#define PG8_WAIT_L(n) asm volatile("s_waitcnt lgkmcnt(" #n ")" ::: "memory")
#define PG8_BAR __builtin_amdgcn_s_barrier()
#define PG8_SCHED __builtin_amdgcn_sched_barrier(0)
    Unit cur, nxt; int ui = 0;
    if (!S.next(0, cur)) return;
    f32x4 acc[2][2][4][2];
#pragma unroll
    for (int a = 0; a < 2; ++a)
#pragma unroll
        for (int b = 0; b < 2; ++b)
#pragma unroll
            for (int m = 0; m < 4; ++m)
#pragma unroll
                for (int n = 0; n < 2; ++n) acc[a][b][m][n] = (f32x4){0.f, 0.f, 0.f, 0.f};
    bf16x8 At[4][2], B0[2][2], B1[2][2];
    const char* cA = (const char*)g.A + (size_t)cur.pm * tstep + (size_t)cur.ks * g.ksb; const char* cB = (const char*)g.Bt + (size_t)cur.pn * tstep + (size_t)cur.ks * g.ksb;
    S.a_ready(cur);
    if constexpr (SP2) {
        PG8_STAGE(PG8_SB(0, 0), cB, voffB); PG8_STAGE(PG8_SB(0, 1), cB + hstep, voffB); PG8_STAGE(PG8_SA(0, 0), cA, voffA); PG8_STAGE(PG8_SA(0, 1), cA + hstep, voffA);
        if (wr == 1) PG8_BAR;
        PG8_WAIT_V(2); PG8_BAR;
        PG8_STAGE(PG8_SB(1, 0), cB + kstep, voffB); PG8_STAGE(PG8_SA(1, 0), cA + kstep, voffA); PG8_STAGE(PG8_SB(1, 1), cB + hstep + kstep, voffB);
        PG8_WAIT_V(6); PG8_BAR;
    } else {
        PG8_STAGE(PG8_SB(0, 0), cB, voffB); PG8_STAGE(PG8_SA(0, 0), cA, voffA); PG8_STAGE(PG8_SB(0, 1), cB + hstep, voffB); PG8_STAGE(PG8_SA(0, 1), cA + hstep, voffA);
        if (wr == 1) PG8_BAR;
        PG8_WAIT_V(4); PG8_BAR;
        PG8_STAGE(PG8_SB(1, 0), cB + kstep, voffB); PG8_STAGE(PG8_SA(1, 0), cA + kstep, voffA); PG8_STAGE(PG8_SB(1, 1), cB + hstep + kstep, voffB);
        PG8_WAIT_V(6); PG8_BAR;
    }
    for (;;) {
        const bool has_next = S.next(ui + 1, nxt);
        const char* nA = has_next ? (const char*)g.A + (size_t)nxt.pm * tstep + (size_t)nxt.ks * g.ksb : cA; const char* nB = has_next ? (const char*)g.Bt + (size_t)nxt.pn * tstep + (size_t)nxt.ks * g.ksb : cB;
        for (int t = 0; t < nt; t += 2) {
            const bool last = (t == nt - 2);
            const char* a1 = cA + (size_t)(t + 1) * kstep;
            const char* a2 = last ? nA : cA + (size_t)(t + 2) * kstep; const char* b2 = last ? nB : cB + (size_t)(t + 2) * kstep;
            const char* a3 = a2 + kstep; const char* b3 = b2 + kstep;
            if (last && has_next) S.a_ready(nxt);
            if constexpr (SP2) {
            PG8_LDB(B0, 0, 0); PG8_LDB(B1, 0, 1); PG8_SCHED; PG8_LDA(At, 0, 0); PG8_STAGE(PG8_SA(1, 1), a1 + hstep, voffA);
            PG8_WAIT_V(8); PG8_WAIT_L(0); PG8_BAR; PG8_MMA(0, 0, At, B0); PG8_MMA(0, 1, At, B1); PG8_BAR; PG8_SCHED;
            PG8_LDA(At, 0, 1); PG8_STAGE(PG8_SB(0, 0), b2, voffB); PG8_STAGE(PG8_SB(0, 1), b2 + hstep, voffB); PG8_STAGE(PG8_SA(0, 0), a2, voffA);
            PG8_WAIT_V(8); PG8_WAIT_L(0); PG8_BAR; PG8_MMA(1, 0, At, B0); PG8_MMA(1, 1, At, B1); PG8_BAR; PG8_SCHED;
            PG8_LDB(B0, 1, 0); PG8_LDB(B1, 1, 1); PG8_SCHED; PG8_LDA(At, 1, 0); PG8_STAGE(PG8_SA(0, 1), a2 + hstep, voffA);
            PG8_WAIT_V(8); PG8_WAIT_L(0); PG8_BAR; PG8_MMA(0, 0, At, B0); PG8_MMA(0, 1, At, B1); PG8_BAR; PG8_SCHED;
            PG8_LDA(At, 1, 1); PG8_STAGE(PG8_SB(1, 0), b3, voffB); PG8_STAGE(PG8_SB(1, 1), b3 + hstep, voffB); PG8_STAGE(PG8_SA(1, 0), a3, voffA);
            PG8_WAIT_V(8); PG8_WAIT_L(0); PG8_BAR; PG8_MMA(1, 0, At, B0); PG8_MMA(1, 1, At, B1); PG8_BAR; PG8_SCHED;
            } else {
            PG8_LDB(B0, 0, 0); PG8_SCHED; PG8_LDA(At, 0, 0); PG8_STAGE(PG8_SA(1, 1), a1 + hstep, voffA);
            PG8_WAIT_L(8); PG8_BAR; PG8_WAIT_L(0); PG8_MMA(0, 0, At, B0); PG8_BAR; PG8_SCHED;
            PG8_LDB(B1, 0, 1); PG8_STAGE(PG8_SB(0, 0), b2, voffB);
            PG8_BAR; PG8_WAIT_L(0); PG8_MMA(0, 1, At, B1); PG8_BAR;
            PG8_LDA(At, 0, 1); PG8_STAGE(PG8_SA(0, 0), a2, voffA);
            PG8_BAR; PG8_WAIT_L(0); PG8_MMA(1, 0, At, B0); PG8_BAR; PG8_SCHED;
            PG8_STAGE(PG8_SB(0, 1), b2 + hstep, voffB);
            PG8_WAIT_V(6); PG8_BAR; PG8_MMA(1, 1, At, B1); PG8_BAR;
            PG8_LDB(B0, 1, 0); PG8_SCHED; PG8_LDA(At, 1, 0); PG8_STAGE(PG8_SA(0, 1), a2 + hstep, voffA);
            PG8_WAIT_L(8); PG8_BAR; PG8_WAIT_L(0); PG8_MMA(0, 0, At, B0); PG8_BAR; PG8_SCHED;
            PG8_LDB(B1, 1, 1); PG8_STAGE(PG8_SB(1, 0), b3, voffB);
            PG8_BAR; PG8_WAIT_L(0); PG8_MMA(0, 1, At, B1); PG8_BAR;
            PG8_LDA(At, 1, 1); PG8_STAGE(PG8_SA(1, 0), a3, voffA);
            PG8_BAR; PG8_WAIT_L(0); PG8_MMA(1, 0, At, B0); PG8_BAR; PG8_SCHED;
            PG8_STAGE(PG8_SB(1, 1), b3 + hstep, voffB);
            PG8_WAIT_V(6); PG8_BAR; PG8_MMA(1, 1, At, B1); PG8_BAR;
            }
        }
        if constexpr (ALIGN_EPI) { if (wr == 0) PG8_BAR; }
        if constexpr (!Epi::AFTER_DRAIN) { E(acc, cur, wr, wc, fr, fq); S.done(cur); }
        if (!has_next) break;
        if (!(Epi::SEGS && cur.ks < 2)) {
#pragma unroll
        for (int a = 0; a < 2; ++a)
#pragma unroll
            for (int b = 0; b < 2; ++b)
#pragma unroll
                for (int m = 0; m < 4; ++m)
#pragma unroll
                    for (int n = 0; n < 2; ++n) acc[a][b][m][n] = (f32x4){0.f, 0.f, 0.f, 0.f};
        }
        cur = nxt; cA = nA; cB = nB; ++ui;
        if constexpr (ALIGN_EPI) { if (wr == 1) PG8_BAR; }
    }
    PG8_WAIT_V(0);
    if constexpr (!ALIGN_EPI) { if (wr == 0) PG8_BAR; }
    PG8_BAR;
    if constexpr (Epi::AFTER_DRAIN) { E.fused(acc, cur, wr, wc, fr, fq, lds, wid, lane); S.done(cur); }
#undef PG8_SA
#undef PG8_SB
#undef PG8_STAGE
#undef PG8_LDA
#undef PG8_LDB
#undef PG8_MMA
#undef PG8_WAIT_V
#undef PG8_WAIT_L
#undef PG8_BAR
#undef PG8_SCHED
}
}

namespace attn_body {
using bf16=__hip_bfloat16;
using bf16x8=__attribute__((ext_vector_type(8)))short;
using s16x4=__attribute__((ext_vector_type(4)))short;
using f32x16=__attribute__((ext_vector_type(16)))float;
using u32x4=__attribute__((ext_vector_type(4)))unsigned;
constexpr int BATCH=8,NHEAD=8,SEQ=4096,D=64,QP=3584,OP=1536;
constexpr int NW=8,QBLK=32,QB=QBLK*NW,KVBLK=64,NQB=SEQ/QB;
constexpr int ATTN_UNIT_ROWS=QB;
__device__ __forceinline__ int crow(int r,int hi){return (r&3)+8*(r>>2)+4*hi;}
#define SBAR() __builtin_amdgcn_sched_barrier(0)
__device__ __forceinline__ void cmask(f32x16&p0,f32x16&p1,int jb,int qrel,int hi){
  const float NEG=-INFINITY; int kb=64*jb+4*hi;
  #pragma unroll
  for(int r=0;r<16;++r){int kv=kb+(r&3)+8*(r>>2); if(kv>qrel)p0[r]=NEG; if(kv+32>qrel)p1[r]=NEG;}
}

constexpr int NSLOT=3, SLOTB=8192;
constexpr int LDS_K=0, LDS_V=NSLOT*SLOTB, LDS_WS=2*NSLOT*SLOTB, LDS_OST=LDS_WS+NW*64*4, LDS_BYTES=LDS_OST+NW*4096;
constexpr float C2=0.125f*1.4426950408889634f;
__device__ __forceinline__ void glds16(const void*gsrc,unsigned lds_dst){unsigned keep;
  asm volatile("s_mov_b32 %0, m0\n\ts_mov_b32 m0, %2\n\ts_nop 0\n\tglobal_load_lds_dwordx4 %1, off\n\ts_mov_b32 m0, %0":"=&s"(keep):"v"(gsrc),"s"(lds_dst):"memory");}
__device__ __forceinline__ float max3f(float a,float b,float c){float r;asm("v_max3_f32 %0, %1, %2, %3":"=v"(r):"v"(a),"v"(b),"v"(c));return r;}
__device__ __forceinline__ float max2f(float a,float b){float r;asm("v_max_f32_e32 %0, %1, %2":"=v"(r):"v"(a),"v"(b));return r;}
__device__ __forceinline__ float fadd_s(float a,float b){float r;asm("v_add_f32_e32 %0, %1, %2":"=v"(r):"v"(a),"v"(b));return r;}
__device__ __forceinline__ float fsub_s(float a,float b){float r;asm("v_sub_f32_e32 %0, %1, %2":"=v"(r):"v"(a),"v"(b));return r;}
typedef float f32x2_t __attribute__((ext_vector_type(2))); typedef __bf16 bf16x2_t __attribute__((ext_vector_type(2)));
__device__ __forceinline__ unsigned cvtpk_s(float lo,float hi){f32x2_t v={lo,hi};bf16x2_t b=__builtin_convertvector(v,bf16x2_t);return __builtin_bit_cast(unsigned,b);}
#define WAIT_BAR(N) asm volatile("s_waitcnt vmcnt(" #N ") lgkmcnt(0)\n\ts_barrier":::"memory")

__device__ __forceinline__ void qkt(f32x16&p0,f32x16&p1,const char*Kslot,const bf16x8*qr,int r32,int hi){
  const char*kb=Kslot+hi*1024+r32*16;
  #pragma unroll
  for(int d0=0;d0<4;++d0){
    const bf16x8 b0=*reinterpret_cast<const bf16x8*>(kb+d0*2048);
    const bf16x8 b1=*reinterpret_cast<const bf16x8*>(kb+d0*2048+512);
    p0=__builtin_amdgcn_mfma_f32_32x32x16_bf16(b0,qr[d0],p0,0,0,0);p1=__builtin_amdgcn_mfma_f32_32x32x16_bf16(b1,qr[d0],p1,0,0,0);}
}
typedef __attribute__((address_space(3))) const char* lds_cptr;
typedef short v4i16_t __attribute__((ext_vector_type(4)));
__device__ __forceinline__ void kload8(bf16x8*kf,lds_cptr kp){
  kf[0]=*(const __attribute__((address_space(3))) bf16x8*)(kp);      kf[1]=*(const __attribute__((address_space(3))) bf16x8*)(kp+512);
  kf[2]=*(const __attribute__((address_space(3))) bf16x8*)(kp+2048); kf[3]=*(const __attribute__((address_space(3))) bf16x8*)(kp+2560);
  kf[4]=*(const __attribute__((address_space(3))) bf16x8*)(kp+4096); kf[5]=*(const __attribute__((address_space(3))) bf16x8*)(kp+4608);
  kf[6]=*(const __attribute__((address_space(3))) bf16x8*)(kp+6144); kf[7]=*(const __attribute__((address_space(3))) bf16x8*)(kp+6656);
}
__device__ __forceinline__ void kload2(bf16x8*kf,lds_cptr kp,int j){ kf[2*j]=*(const __attribute__((address_space(3))) bf16x8*)(kp+j*2048); kf[2*j+1]=*(const __attribute__((address_space(3))) bf16x8*)(kp+j*2048+512); }
__device__ __forceinline__ s16x4 vtr(lds_cptr p){ return __builtin_bit_cast(s16x4,__builtin_amdgcn_ds_read_tr16_b64_v4i16((__attribute__((address_space(3))) v4i16_t*)p)); }
__device__ __forceinline__ float rowmax(const f32x16&p0,const f32x16&p1){
  float a=max3f(p0[0],p0[1],p1[0]),b=max3f(p0[2],p0[3],p1[1]);a=max3f(a,p1[2],p1[3]);
  #pragma unroll
  for(int r=4;r<16;r+=4){a=max3f(a,p0[r],p0[r+1]);b=max3f(b,p0[r+2],p0[r+3]);a=max3f(a,p1[r],p1[r+1]);b=max3f(b,p1[r+2],p1[r+3]);}
  const float m=max2f(a,b);
  auto rr=__builtin_amdgcn_permlane32_swap(__float_as_uint(m),__float_as_uint(m),false,false);
  return max2f(__uint_as_float(rr[0]),__uint_as_float(rr[1]));
}
__device__ __forceinline__ void pv(f32x16*o,int vb,bf16x8 pa0,bf16x8 pa1,bf16x8 pa2,bf16x8 pa3){
  #pragma unroll
  for(int d0=0;d0<2;++d0){s16x4 lo[4],hi[4];
    #pragma unroll
    for(int ks=0;ks<4;++ks){
      asm volatile("ds_read_b64_tr_b16 %0,%1 offset:%c2":"=&v"(lo[ks]):"v"(vb),"i"(d0*4096+ks*1024):"memory");
      asm volatile("ds_read_b64_tr_b16 %0,%1 offset:%c2":"=&v"(hi[ks]):"v"(vb),"i"(d0*4096+ks*1024+512):"memory");}
    asm volatile("s_waitcnt lgkmcnt(0)":::"memory");SBAR();
    #define PK(k) (bf16x8){lo[k][0],lo[k][1],lo[k][2],lo[k][3],hi[k][0],hi[k][1],hi[k][2],hi[k][3]}
    o[d0]=__builtin_amdgcn_mfma_f32_32x32x16_bf16(pa0,PK(0),o[d0],0,0,0);
    o[d0]=__builtin_amdgcn_mfma_f32_32x32x16_bf16(pa1,PK(1),o[d0],0,0,0);
    o[d0]=__builtin_amdgcn_mfma_f32_32x32x16_bf16(pa2,PK(2),o[d0],0,0,0);
    o[d0]=__builtin_amdgcn_mfma_f32_32x32x16_bf16(pa3,PK(3),o[d0],0,0,0);
    #undef PK
  }
}

#ifndef ATTN_STORE16
#define ATTN_STORE16(p,v) (*(u32x4*)(p)=(v))
#endif
template<int THRL> __device__ __forceinline__ void attn_unit(int b,int h,int qb,const bf16*Q,const bf16*__restrict__ K,const bf16*__restrict__ V,bf16*O,const unsigned*__restrict__ SEL,char*shm){
  int tid_=threadIdx.x; asm volatile("":"+v"(tid_)); const int tid=tid_,lane=tid&63,r32=lane&31,hi=lane>>5; const int wid=__builtin_amdgcn_readfirstlane(tid>>6);
  const long rowbase=(long)b*SEQ; const int q0=qb*QB;
  const bf16*Qw=Q+(rowbase+q0+wid*QBLK)*QP+h*D;
  const bf16*Kh=K+rowbase*QP+h*D,*Vh=V+rowbase*QP+h*D;
  const unsigned lds0=(unsigned)(uintptr_t)shm;
  float*wsf=(float*)(shm+LDS_WS)+wid*64;
  const bf16*ksrc=Kh+(long)lane*QP+wid*8;
  const bf16*vsrc=Vh+(long)(16*(wid&3)+(lane>>2))*QP+(wid>>2)*32+(lane&3)*8;
  const unsigned kdst=lds0+LDS_K+wid*1024, vdst=lds0+LDS_V+wid*1024;
  #define KT(t) (((t)<4)?(NT-4+(t)):((t)-4))
  #define DMA_K(t,slot) glds16(ksrc+(long)KT(t)*KVBLK*QP,(unsigned)__builtin_amdgcn_readfirstlane(kdst+(slot)))
  #define DMA_V(t,slot) glds16(vsrc+(long)KT(t)*KVBLK*QP,(unsigned)__builtin_amdgcn_readfirstlane(vdst+(slot)))
  const int vb0=(int)(lds0+LDS_V)+((lane>>4)&1)*32+(lane&3)*8+(4*hi+((lane&15)>>2))*64;
  const char*Kbase=shm+LDS_K; bf16x8 kf[8];
  const lds_cptr shm3=(lds_cptr)shm; const lds_cptr kp0=shm3+LDS_K+hi*1024+r32*16; const lds_cptr vp0=shm3+LDS_V+((lane>>4)&1)*32+(lane&3)*8+(4*hi+((lane&15)>>2))*64;
  const int NT=(q0+QB)/KVBLK;
  DMA_K(0,0);DMA_V(0,0);DMA_K(1,SLOTB);
  const unsigned selm=SEL[((long)(b*NHEAD+h))*SEQ+q0+wid*QBLK+r32];
  const float sl2=__builtin_amdgcn_exp2f(-(float)(h+1))*1.4426950408889634f;
  bf16x8 qr[4];
  #pragma unroll
  for(int d0=0;d0<4;++d0)qr[d0]=*reinterpret_cast<const bf16x8*>(&Qw[(long)r32*QP+d0*16+hi*8]);
  float mhat=0.f,l_reg=0.f;f32x16 o[2];o[0]=f32x16{};o[1]=f32x16{};
  #define CINIT(C0,C1,t) do{ const int kt_=KT(t); const bool on_=((t)<4)||(((selm>>(kt_>>2))&1u)!=0u); \
    const float bs_=on_?(sl2*(float)(64*kt_-q0+4*hi)-mhat):-1e30f; const float s32_=32.f*sl2; \
    _Pragma("unroll") for(int r=0;r<16;++r)C0[r]=__builtin_fmaf(sl2,(float)((r&3)+8*(r>>2)),bs_); \
    _Pragma("unroll") for(int r=0;r<16;++r)C1[r]=C0[r]+s32_; }while(0)
  const int qrel=wid*QBLK+r32;
  #define CMASK(P0,P1,t) do{ if((t)<4)cmask(P0,P1,(t),qrel,hi); }while(0)
  bool resc=false;
  #define START(P0,P1) do{ const float rm=rowmax(P0,P1); resc=false; \
    { const float dl=rm; mhat=fadd_s(mhat,dl); \
      _Pragma("unroll") for(int r=0;r<16;++r){P0[r]=fsub_s(P0[r],dl);P1[r]=fsub_s(P1[r],dl);} } \
    _Pragma("unroll") for(int r=0;r<16;++r)P0[r]=__builtin_amdgcn_exp2f(P0[r]); }while(0)
  #define RESC() do{ if(resc){ asm volatile("s_waitcnt lgkmcnt(0)":::"memory"); \
      _Pragma("unroll") for(int d_=0;d_<2;++d_) _Pragma("unroll") for(int r=0;r<16;++r)o[d_][r]*=wsf[crow(r,hi)]; } }while(0)
  f32x16 pA0,pA1,pB0,pB1;
  int sl_prev=0,sl_cur=0,sl_next=SLOTB;
  #define ROT() do{sl_prev=sl_cur;sl_cur=sl_next;sl_next=(sl_next==(NSLOT-1)*SLOTB)?0:sl_next+SLOTB;}while(0)
  DMA_K(2,2*SLOTB);
  WAIT_BAR(3);
  CINIT(pA0,pA1,0); qkt(pA0,pA1,Kbase,qr,r32,hi);asm volatile("s_nop 15\n\ts_nop 7":"+v"(pA0),"+v"(pA1));CMASK(pA0,pA1,0);
  START(pA0,pA1);
  _Pragma("unroll") for(int r=0;r<16;++r)pA1[r]=__builtin_amdgcn_exp2f(pA1[r]);
  WAIT_BAR(0);
  DMA_K(3,0);DMA_V(1,SLOTB);
  ROT();
  kload8(kf,kp0+sl_cur);
  WAIT_BAR(2);
  s16x4 vlo[8],vhi[8]; u32x4 pw0,pw1,pw2,pw3;
  #define PKW(P,B) cvtpk_s(P[B],P[B+1])
  #define PAF(k) __builtin_bit_cast(bf16x8,pw##k)
  #define VFR(i) (bf16x8){vlo[i][0],vlo[i][1],vlo[i][2],vlo[i][3],vhi[i][0],vhi[i][1],vhi[i][2],vhi[i][3]}
  #define PIN(x) asm volatile("":"+v"(x))
  #define MX3(a,b,c) __builtin_fmaxf(__builtin_fmaxf((a),(b)),(c))
  #define GAPA(MF,A0,A1,A2,A3,W0,W1,PW) do{ MF; sacc+=A0; sacc+=A1; sacc+=A2; sacc+=A3; PIN(sacc); W0; W1; PIN(PW); SBAR(); }while(0)
  #define EX(v) __builtin_amdgcn_exp2f(v)
  #define GAPB(MF,X,B) do{ MF; X[B]=EX(X[B]); X[B+1]=EX(X[B+1]); X[B+2]=EX(X[B+2]); X[B+3]=EX(X[B+3]); PIN(X); SBAR(); }while(0)
  #define VRD(i) do{ vlo[i]=vtr(vp_+(((i)>>2)*4096+((i)&3)*1024)); vhi[i]=vtr(vp_+(((i)>>2)*4096+((i)&3)*1024+512)); }while(0)
  #define KRD(G,j) do{ if(G){ kload2(kf,kp0+sl_next,j); SBAR(); } }while(0)
  #define STEP(C0,C1,P0,P1,t,GK,GV,GL) do{ SBAR(); CINIT(C0,C1,t); SBAR(); \
    const lds_cptr vp_=vp0+sl_prev; \
    VRD(0); SBAR(); float sacc=(P0[0]+P0[1]); \
    GAPA(C0=__builtin_amdgcn_mfma_f32_32x32x16_bf16(kf[0],qr[0],C0,0,0,0), P0[2],P0[3],P0[4],P0[5],     pw0[0]=PKW(P0,0), pw0[1]=PKW(P0,2), pw0); \
    VRD(4); SBAR(); GAPA(C1=__builtin_amdgcn_mfma_f32_32x32x16_bf16(kf[1],qr[0],C1,0,0,0), P0[6],P0[7],P0[8],P0[9],     pw0[2]=PKW(P0,4), pw0[3]=PKW(P0,6), pw0); \
    VRD(1); SBAR(); GAPA(C0=__builtin_amdgcn_mfma_f32_32x32x16_bf16(kf[2],qr[1],C0,0,0,0),   P0[10],P0[11],P0[12],P0[13], pw1[0]=PKW(P0,8), pw1[1]=PKW(P0,10), pw1); \
    VRD(5); SBAR(); GAPA(C1=__builtin_amdgcn_mfma_f32_32x32x16_bf16(kf[3],qr[1],C1,0,0,0),   P0[14],P0[15],P1[0],P1[1],   pw1[2]=PKW(P0,12),pw1[3]=PKW(P0,14), pw1); \
    VRD(2); SBAR(); GAPA(C0=__builtin_amdgcn_mfma_f32_32x32x16_bf16(kf[4],qr[2],C0,0,0,0),   P1[2],P1[3],P1[4],P1[5],     pw2[0]=PKW(P1,0), pw2[1]=PKW(P1,2), pw2); \
    VRD(6); SBAR(); GAPA(C1=__builtin_amdgcn_mfma_f32_32x32x16_bf16(kf[5],qr[2],C1,0,0,0),   P1[6],P1[7],P1[8],P1[9],     pw2[2]=PKW(P1,4), pw2[3]=PKW(P1,6), pw2); \
    VRD(3); SBAR(); GAPA(C0=__builtin_amdgcn_mfma_f32_32x32x16_bf16(kf[6],qr[3],C0,0,0,0),   P1[10],P1[11],P1[12],P1[13], pw3[0]=PKW(P1,8), pw3[1]=PKW(P1,10), pw3); \
    VRD(7); SBAR(); GAPA(C1=__builtin_amdgcn_mfma_f32_32x32x16_bf16(kf[7],qr[3],C1,0,0,0),   P1[14],P1[15],0.f,0.f,       pw3[2]=PKW(P1,12),pw3[3]=PKW(P1,14), pw3); \
    l_reg+=sacc; \
    if(GK){DMA_K((t)+3,sl_cur);} if(GV){DMA_V((t)+1,sl_next);} \
    CMASK(C0,C1,t); \
    { float a=MX3(C0[0],C0[1],C1[0]),b=MX3(C0[2],C0[3],C1[1]); a=MX3(a,C1[2],C1[3]); \
      _Pragma("unroll") for(int r=4;r<16;r+=4){a=MX3(a,C0[r],C0[r+1]);b=MX3(b,C0[r+2],C0[r+3]);a=MX3(a,C1[r],C1[r+1]);b=MX3(b,C1[r+2],C1[r+3]);} \
      float rm=__builtin_fmaxf(a,b); { auto rr=__builtin_amdgcn_permlane32_swap(__float_as_uint(rm),__float_as_uint(rm),false,false); rm=__builtin_fmaxf(__uint_as_float(rr[0]),__uint_as_float(rr[1])); } \
      resc=false; \
      if(__builtin_expect(__any(rm>(float)THRL),0)){ const float dl=__builtin_fmaxf(rm,0.f); mhat+=dl; \
        _Pragma("unroll") for(int r=0;r<16;++r){C0[r]-=dl;C1[r]-=dl;} \
        const float f=__builtin_amdgcn_exp2f(-dl); l_reg*=f; if(hi==0)wsf[r32]=f; resc=true; } } \
    SBAR(); \
    GAPB(o[0]=__builtin_amdgcn_mfma_f32_32x32x16_bf16(PAF(0),VFR(0),o[0],0,0,0), C0,0); \
    GAPB(o[1]=__builtin_amdgcn_mfma_f32_32x32x16_bf16(PAF(0),VFR(4),o[1],0,0,0), C0,4); \
    KRD(GL,0); GAPB(o[0]=__builtin_amdgcn_mfma_f32_32x32x16_bf16(PAF(1),VFR(1),o[0],0,0,0), C0,8); \
    KRD(GL,1); GAPB(o[1]=__builtin_amdgcn_mfma_f32_32x32x16_bf16(PAF(1),VFR(5),o[1],0,0,0), C0,12); \
    KRD(GL,2); GAPB(o[0]=__builtin_amdgcn_mfma_f32_32x32x16_bf16(PAF(2),VFR(2),o[0],0,0,0), C1,0); \
    KRD(GL,3); GAPB(o[1]=__builtin_amdgcn_mfma_f32_32x32x16_bf16(PAF(2),VFR(6),o[1],0,0,0), C1,4); \
    GAPB(o[0]=__builtin_amdgcn_mfma_f32_32x32x16_bf16(PAF(3),VFR(3),o[0],0,0,0), C1,8); \
    GAPB(o[1]=__builtin_amdgcn_mfma_f32_32x32x16_bf16(PAF(3),VFR(7),o[1],0,0,0), C1,12); \
    }while(0)
  int t=1;
  for(;t+5<NT;t+=2){
    STEP(pB0,pB1,pA0,pA1,t,true,true,true);     WAIT_BAR(2); RESC(); ROT();
    STEP(pA0,pA1,pB0,pB1,t+1,true,true,true);   WAIT_BAR(2); RESC(); ROT();
  }
  #define ENDW(tt) do{ if((tt)+3<NT){WAIT_BAR(2);} else if((tt)+2<NT){WAIT_BAR(1);} else {WAIT_BAR(0);} }while(0)
  for(;t+1<NT;t+=2){
    STEP(pB0,pB1,pA0,pA1,t,(t+3<NT),(t+1<NT),(t+1<NT));       ENDW(t);   RESC(); ROT();
    STEP(pA0,pA1,pB0,pB1,t+1,(t+4<NT),(t+2<NT),(t+2<NT));     ENDW(t+1); RESC(); ROT();
  }
  STEP(pB0,pB1,pA0,pA1,NT-1,false,false,false); RESC();
  { float sacc=pB0[0]+pB0[1]; _Pragma("unroll") for(int r=2;r<16;++r)sacc+=pB0[r]; _Pragma("unroll") for(int r=0;r<16;++r)sacc+=pB1[r]; l_reg+=sacc;
    pw0=(u32x4){PKW(pB0,0),PKW(pB0,2),PKW(pB0,4),PKW(pB0,6)};pw1=(u32x4){PKW(pB0,8),PKW(pB0,10),PKW(pB0,12),PKW(pB0,14)};pw2=(u32x4){PKW(pB1,0),PKW(pB1,2),PKW(pB1,4),PKW(pB1,6)};pw3=(u32x4){PKW(pB1,8),PKW(pB1,10),PKW(pB1,12),PKW(pB1,14)};
    SBAR(); pv(o,vb0+sl_cur,PAF(0),PAF(1),PAF(2),PAF(3)); }
  #undef PKW
  #undef PAF
  #undef VFR
  #undef PIN
  #undef MX3
  #undef GAPA
  #undef GAPB
  #undef EX
  #undef VRD
  #undef KRD
  #undef STEP
  #undef ENDW
  {auto rr=__builtin_amdgcn_permlane32_swap(__float_as_uint(l_reg),__float_as_uint(l_reg),false,false);l_reg=__uint_as_float(rr[0])+__uint_as_float(rr[1]);}
  if(hi==0)wsf[32+r32]=l_reg;asm volatile("s_waitcnt lgkmcnt(0)":::"memory");
  float rli[16];
  #pragma unroll
  for(int r=0;r<16;++r)rli[r]=__builtin_amdgcn_rcpf(wsf[32+crow(r,hi)]);
  bf16*Ow=O+(rowbase+q0+wid*QBLK)*OP+h*D;
  { bf16*stg=(bf16*)(shm+LDS_OST)+wid*2048;
    #pragma unroll
    for(int r=0;r<16;++r){const int orow=crow(r,hi);
      #pragma unroll
      for(int d0=0;d0<2;++d0)stg[orow*64+d0*32+r32]=__float2bfloat16(o[d0][r]*rli[r]);}
    asm volatile("s_waitcnt lgkmcnt(0)":::"memory");
    #pragma unroll
    for(int i=0;i<4;++i){const int row=i*8+(lane>>3),ch=lane&7; const u32x4 v=*(const u32x4*)(stg+row*64+ch*8); ATTN_STORE16(Ow+(long)row*OP+ch*8,v);} }
  asm volatile("s_waitcnt lgkmcnt(0)\n\ts_barrier":::"memory");
  #undef DMA_K
  #undef DMA_V
  #undef KT
  #undef CINIT
  #undef CMASK
  #undef START
  #undef RESC
  #undef ROT
}
constexpr int ATTN_LDS_BYTES=LDS_BYTES;
struct AttnTensors { const bf16* Q; const bf16* K; const bf16* V; bf16* O; const unsigned* SEL; };
struct AttnUnit { int bh; int qb; };
struct StaticOrder {
  int vcu, G;
  __device__ __forceinline__ StaticOrder(int grid,int vcu_):vcu(vcu_),G(grid){}
  __device__ __forceinline__ bool next(int i,AttnUnit&u)const{
    if(G==256){ if(i>=4)return false; const int c=vcu&3; u.bh=vcu>>2; u.qb=(i==0)?15-c:(i==1)?11-c:(i==2)?4+c:c; return true; }
    const int L=i*G+vcu; if(L>=BATCH*NHEAD*NQB)return false; u.qb=NQB-1-L/(BATCH*NHEAD); u.bh=L%(BATCH*NHEAD); return true; }
  __device__ __forceinline__ void a_ready(const AttnUnit&)const{}
  __device__ __forceinline__ void done(const AttnUnit&)const{}
};
template<class Sched,int THRL=8> __device__ __forceinline__ void attn_phase(char*lds,const AttnTensors&T,const Sched&S){
  AttnUnit u;
  for(int i=0;S.next(i,u);++i){ S.a_ready(u); attn_unit<THRL>(u.bh/NHEAD,u.bh%NHEAD,u.qb,T.Q,T.K,T.V,T.O,T.SEL,lds); S.done(u); }
}
#undef SBAR
#undef WAIT_BAR
}

#define GAS __attribute__((address_space(1)))
#define LAS __attribute__((address_space(3)))
typedef unsigned short bf16;
typedef unsigned v4u __attribute__((ext_vector_type(4)));
typedef float f32x4 __attribute__((ext_vector_type(4)));
typedef short bf16x8 __attribute__((ext_vector_type(8)));
typedef GAS unsigned gu32;
typedef GAS unsigned long long gu64;
#define RLX_AGENT __ATOMIC_RELAXED, __HIP_MEMORY_SCOPE_AGENT
#define LDS_WAIT() asm volatile("s_waitcnt lgkmcnt(0)" ::: "memory")
#define VM_WAIT() asm volatile("s_waitcnt vmcnt(0)" ::: "memory")
__device__ __forceinline__ unsigned long long rt() { return __builtin_amdgcn_s_memrealtime(); }
__device__ __forceinline__ unsigned f2bf(float f) { unsigned u = __builtin_bit_cast(unsigned, f); return (u + 0x7fffu + ((u >> 16) & 1u)) >> 16; }
__device__ __forceinline__ unsigned pk2(float lo, float hi) { return f2bf(lo) | (f2bf(hi) << 16); }

#define XB_TMO      128
#define XB_XCNT(j)  (256  + 64 * (j))
#define XB_XSUB(j)  (1280 + 64 * (j))
#define XB_XGEN(j)  (2304 + 64 * (j))
#define XB_TOP      3328
#define XB_TOPGEN   3392
#define XCD_BAR_WORDS 3456
#define XB_SPIN_CAP (1u << 18)

__device__ __forceinline__ unsigned xb_ld(unsigned* p)              { return __hip_atomic_load(p, __ATOMIC_RELAXED, __HIP_MEMORY_SCOPE_AGENT); }
__device__ __forceinline__ unsigned xb_add(unsigned* p, unsigned v) { return __hip_atomic_fetch_add(p, v, __ATOMIC_RELAXED, __HIP_MEMORY_SCOPE_AGENT); }
__device__ __forceinline__ unsigned xb_xcc_id() { return (unsigned)__builtin_amdgcn_s_getreg((3 << 11) | 20) & 0xFu; }
#define XB_SPIN(cond, bar) do { unsigned _sp = 0; while (cond) { __builtin_amdgcn_s_sleep(1); \
    if ((++_sp & 255u) == 0u) { if (xb_ld(&(bar)[XB_TMO])) break; if (_sp > XB_SPIN_CAP) { atomicAdd(&(bar)[XB_TMO], 1u); break; } } } } while (0)

struct XcdBarrier {
    unsigned* bar; unsigned x;
    volatile LAS unsigned* st;
};

__device__ __forceinline__ XcdBarrier xcd_barrier_post(unsigned* bar, volatile LAS unsigned* st) {
    XcdBarrier b; b.bar = bar; b.x = xb_xcc_id(); b.st = st;
    if (threadIdx.x == 0) (void)xb_add(&bar[XB_XCNT(b.x)], 1u);
    return b;
}
__device__ __forceinline__ void xcd_barrier_complete(unsigned* bar, unsigned x, unsigned& nloc, unsigned& nx) {
    const unsigned G = gridDim.x * gridDim.y * gridDim.z;
    unsigned sum, cnt, mine, sp = 0u;
    for (;;) {
        sum = 0u; cnt = 0u; mine = 0u;
#pragma unroll
        for (unsigned j = 0; j < 16; ++j) { const unsigned c = xb_ld(&bar[XB_XCNT(j)]); sum += c; cnt += (c > 0u) ? 1u : 0u; mine = (j == x) ? c : mine; }
        if (sum == G) break;
        __builtin_amdgcn_s_sleep(1);
        if ((++sp & 255u) == 0u) { if (xb_ld(&bar[XB_TMO])) break; if (sp > XB_SPIN_CAP) { atomicAdd(&bar[XB_TMO], 1u); break; } }
    }
    nloc = mine > 0u ? mine : 1u; nx = cnt > 0u ? cnt : 1u;
}

__device__ __forceinline__ void xcd_barrier(const XcdBarrier& b) {
    asm volatile("s_waitcnt vmcnt(0)" ::: "memory");
    __syncthreads();
    if (threadIdx.x == 0) {
        unsigned* bar = b.bar;
        __builtin_amdgcn_s_waitcnt(0);
        unsigned nloc = b.st[0], nx = b.st[1];
        if (nloc == 0u) { xcd_barrier_complete(bar, b.x, nloc, nx); b.st[0] = nloc; b.st[1] = nx; }
        const unsigned old = xb_add(&bar[XB_XSUB(b.x)], 1u);
        const unsigned gen = old / nloc;
        if (old + 1u == (gen + 1u) * nloc) {
            __builtin_amdgcn_fence(__ATOMIC_RELEASE, "agent");
            asm volatile("s_waitcnt vmcnt(0)" ::: "memory");
            const unsigned og = xb_add(&bar[XB_TOP], 1u);
            const unsigned tg = og / nx;
            if (og + 1u == (tg + 1u) * nx) xb_add(&bar[XB_TOPGEN], 1u);
            else XB_SPIN(xb_ld(&bar[XB_TOPGEN]) == tg, bar);
            __builtin_amdgcn_fence(__ATOMIC_ACQUIRE, "agent");
            xb_add(&bar[XB_XGEN(b.x)], 1u);
            asm volatile("s_waitcnt vmcnt(0)" ::: "memory");
        } else {
            XB_SPIN(xb_ld(&bar[XB_XGEN(b.x)]) == gen, bar);
            __builtin_amdgcn_fence(__ATOMIC_ACQUIRE, "agent");
            asm volatile("s_waitcnt vmcnt(0)" ::: "memory");
        }
    }
    __syncthreads();
}


constexpr int NWAVES = 8;
constexpr int RING_OFF = 0, RING_BYTES = 131072;
constexpr int LDSCTL_OFF = RING_BYTES, MISC_OFF = LDSCTL_OFF + 320;
constexpr int LDS_BYTES = 147456;
constexpr int CW_TMO = 0, CW_CODE = 1, CW_BAR = 4096;
constexpr int N_PHASES = 19;

struct Frame {
    LAS unsigned char* lds;
    volatile LAS unsigned* MISC;
    gu32* ctl;
    int tid, lane, wave, vcu, G;
};
struct Args { const float* in[18]; float* out; unsigned char* ws; int ph_lo, ph_hi, li, pad; };

__device__ __forceinline__ float wave_sum(float v) {
#pragma unroll
    for (int o = 1; o < 64; o <<= 1) v += __shfl_xor(v, o);
    return v;
}

struct PrepSeg { const float* W; const float* gain; bf16* dst; int ldin, col0, N, K, ldout, seg, seg_stride; };
__device__ __forceinline__ void prep_item(const PrepSeg& s, LAS float* scr, int item, int lane) {
    const int nblk = s.N / 32, kb = item / nblk, nb = item % nblk, k0 = 64 * kb, n0 = 32 * nb;
#pragma unroll
    for (int i = 0; i < 32; ++i) { const int kk = 2 * i + (lane >> 5); const float g = s.gain ? s.gain[k0 + kk] : 1.f; scr[kk * 33 + (lane & 31)] = s.W[(size_t)(k0 + kk) * s.ldin + s.col0 + n0 + (lane & 31)] * g; }
    LDS_WAIT(); asm volatile("" ::: "memory");
    const int c = lane & 7;
#pragma unroll
    for (int j = 0; j < 4; ++j) { const int n = n0 + (lane >> 3) + 8 * j; const LAS float* p = scr + (8 * c) * 33 + (lane >> 3) + 8 * j;
        v4u o; o.x = pk2(p[0 * 33], p[1 * 33]); o.y = pk2(p[2 * 33], p[3 * 33]); o.z = pk2(p[4 * 33], p[5 * 33]); o.w = pk2(p[6 * 33], p[7 * 33]);
        const int drow = (n / s.seg) * s.seg_stride + (n % s.seg);
        *(GAS v4u*)(s.dst + (size_t)drow * s.ldout + k0 + 8 * c) = o; }
    LDS_WAIT(); asm volatile("" ::: "memory");
}
constexpr int NSEG = 14;
__device__ const int SEG_DSTC[9] = {C_MQ, C_MK, C_MV, C_GQ, C_GK, C_GV, C_GR, C_PU, 0};
__device__ const int SEG_SRCC[9] = {O_MQ, O_MK, O_MV, O_GQ, O_GK, O_GV, O_GR, O_PU, O_GATE};
__device__ const int SEG_NN[9] = {512, 512, 512, 256, 256, 512, 512, 512, NGATE};
__device__ __forceinline__ void get_seg(const Args& a, int l, int s, PrepSeg& d) {
    unsigned char* wl = a.ws + WS_W + (size_t)l * W_LAYER;
    const float* win = a.in[2] + (size_t)l * DM * DIN; const float* gpre = a.in[1] + l * DM; const float* gffn = a.in[13] + l * DM;
    d.seg = 1 << 30; d.seg_stride = 0; d.gain = nullptr; d.col0 = 0;
    if (s < 9) {
        d.W = win; d.gain = gpre; d.ldin = DIN; d.col0 = SEG_SRCC[s]; d.N = SEG_NN[s]; d.K = DM; d.ldout = DM;
        d.dst = (s < 8) ? (bf16*)(wl + W_IN) + (size_t)SEG_DSTC[s] * DM : (bf16*)(wl + W_GATE);
    } else if (s == 9)  { d.W = a.in[8] + (size_t)l * 512 * 1024; d.ldin = 1024; d.N = 1024; d.K = 512; d.ldout = KBR; d.dst = (bf16*)(wl + W_BR); }
    else if (s == 10) { d.W = a.in[10] + (size_t)l * 512 * 1024; d.ldin = 1024; d.N = 1024; d.K = 512; d.ldout = KBR; d.dst = (bf16*)(wl + W_BR) + 1024; }
    else if (s == 11) { d.W = a.in[11] + (size_t)l * 1024 * 1024; d.ldin = 1024; d.N = 1024; d.K = 1024; d.ldout = DM; d.dst = (bf16*)(wl + W_OUT); }
    else if (s == 12) { d.W = a.in[14] + (size_t)l * DM * DFF; d.gain = gffn; d.ldin = DFF; d.N = DFF; d.K = DM; d.ldout = DM; d.dst = (bf16*)(wl + W_GU); d.seg = 128; d.seg_stride = 256; }
    else              { d.W = a.in[15] + (size_t)l * DM * DFF; d.gain = gffn; d.ldin = DFF; d.N = DFF; d.K = DM; d.ldout = DM; d.dst = (bf16*)(wl + W_GU) + (size_t)128 * DM; d.seg = 128; d.seg_stride = 256; }
}
__device__ __forceinline__ void p0_prologue(Frame& F, const Args& a) {
    int tid_ = threadIdx.x; asm volatile("" : "+v"(tid_)); const int tid = tid_, lane = tid & 63;
    LAS float* scr = (LAS float*)(F.lds + RING_OFF + F.wave * 16384);
    const int gw = F.vcu * NWAVES + F.wave, NGW = F.G * NWAVES;
    int base = 0;
    for (int l = 0; l < DEPTH; ++l) {
        for (int s = 0; s < NSEG + 1; ++s) {
            PrepSeg d;
            if (s < NSEG) get_seg(a, l, s, d);
            else { d.W = a.in[16] + (size_t)l * DFF * DM; d.gain = nullptr; d.ldin = DM; d.col0 = 0; d.N = DM; d.K = DFF; d.ldout = DFF; d.dst = (bf16*)(a.ws + WS_W + (size_t)l * W_LAYER + W_DN); d.seg = 1 << 30; d.seg_stride = 0; }
            const int nitems = (d.K / 64) * (d.N / 32);
            int first = gw - (base % NGW); if (first < 0) first += NGW;
            for (int it = first; it < nitems; it += NGW) prep_item(d, scr, it, lane);
            base += nitems;
        }
        const float* wp = a.in[6] + (size_t)l * 4 * 128 * 128; const float* sc = a.in[7] + l * 512; const float* Wb = a.in[9] + (size_t)l * 512 * 1024;
        bf16* WBR_t = (bf16*)(a.ws + WS_W + (size_t)l * W_LAYER + W_BR);
        for (int idx = (F.vcu * NWAVES * 64) + tid; idx < 64 * 1024; idx += F.G * NWAVES * 64) {
            const int n = idx & 1023, c8 = idx >> 10, g = c8 >> 4, c0 = (c8 & 15) * 8;
            float s8[8];
#pragma unroll
            for (int i = 0; i < 8; ++i) s8[i] = 0.f;
            for (int d = 0; d < 128; ++d) { const float wb = sc[g * 128 + d] * Wb[(size_t)(g * 128 + d) * 1024 + n];
#pragma unroll
                for (int i = 0; i < 8; ++i) s8[i] += wp[((size_t)g * 128 + c0 + i) * 128 + d] * wb; }
            v4u o; o.x = pk2(s8[0], s8[1]); o.y = pk2(s8[2], s8[3]); o.z = pk2(s8[4], s8[5]); o.w = pk2(s8[6], s8[7]);
            *(GAS v4u*)(WBR_t + (size_t)n * KBR + 512 + g * 128 + c0) = o;
        }
    }
}
__device__ __forceinline__ void rows_phase(Frame& F, const float* xsrc, const bf16* Fin, const float* wpost, float* xdst, bf16* XB, float* R, float* G1, const float* g1_win, const float* g1_gain) {
    int tid_ = threadIdx.x; asm volatile("" : "+v"(tid_)); const int tid = tid_;
    LAS float* wt = (LAS float*)(F.lds + RING_OFF);
    if (g1_win) {
        for (int idx = tid; idx < 16 * 1024; idx += NWAVES * 64) { const int k = idx >> 4, j = idx & 15; wt[j * 1024 + k] = g1_gain[k] * g1_win[(size_t)k * DIN + O_G1 + j]; }
        __syncthreads();
    }
    const int gw = F.vcu * NWAVES + F.wave, NGW = F.G * NWAVES, lane = tid & 63;
    for (int m = gw; m < M; m += NGW) {
        const GAS f32x4* xr = (const GAS f32x4*)(xsrc + (size_t)m * DM) + lane;
        f32x4 v[4];
#pragma unroll
        for (int j = 0; j < 4; ++j) v[j] = xr[64 * j];
        if (Fin) {
            const GAS unsigned long long* fr8 = (const GAS unsigned long long*)(Fin + (size_t)m * DM) + lane;
            f32x4 f[4]; float s = 0.f;
#pragma unroll
            for (int j = 0; j < 4; ++j) { const unsigned long long w = fr8[64 * j]; const unsigned lo = (unsigned)w, hi = (unsigned)(w >> 32);
                f[j] = (f32x4){__uint_as_float(lo << 16), __uint_as_float(lo & 0xffff0000u), __uint_as_float(hi << 16), __uint_as_float(hi & 0xffff0000u)};
                s += (f[j].x * f[j].x + f[j].y * f[j].y) + (f[j].z * f[j].z + f[j].w * f[j].w); }
            const float rf = 1.f / sqrtf(wave_sum(s) * (1.f / DM) + EPS);
#pragma unroll
            for (int j = 0; j < 4; ++j) { const f32x4 w = ((const GAS f32x4*)wpost)[64 * j + lane]; v[j] = v[j] + f[j] * rf * w; }
        }
        if (xdst) { GAS f32x4* xo = (GAS f32x4*)(xdst + (size_t)m * DM) + lane;
#pragma unroll
            for (int j = 0; j < 4; ++j) xo[64 * j] = v[j]; }
        if (XB) {
            float s = 0.f;
#pragma unroll
            for (int j = 0; j < 4; ++j) s += (v[j].x * v[j].x + v[j].y * v[j].y) + (v[j].z * v[j].z + v[j].w * v[j].w);
            const float r = 1.f / sqrtf(wave_sum(s) * (1.f / DM) + EPS);
            GAS unsigned long long* o8 = (GAS unsigned long long*)(XB + (size_t)m * DM) + lane;
#pragma unroll
            for (int j = 0; j < 4; ++j) o8[64 * j] = (unsigned long long)pk2(v[j].x, v[j].y) | ((unsigned long long)pk2(v[j].z, v[j].w) << 32);
            if (lane == 0) R[m] = r;
            if (g1_win) {
                float mine = 0.f;
#pragma unroll
                for (int jj = 0; jj < 16; ++jj) { float d = 0.f;
#pragma unroll
                    for (int j = 0; j < 4; ++j) { const f32x4 w = *(const LAS f32x4*)(wt + jj * 1024 + 4 * (64 * j + lane)); d += (v[j].x * w.x + v[j].y * w.y) + (v[j].z * w.z + v[j].w * w.w); }
                    d = wave_sum(d); if (lane == jj) mine = d; }
                if (lane < 16) G1[(size_t)m * 16 + lane] = mine * r;
            }
        }
    }
    if (g1_win) __syncthreads();
}


constexpr size_t WS_SEL = 5 * MiB;
__device__ __forceinline__ void kmean_phase(Frame& F, const bf16* PM, float* KM) {
    int tid_ = threadIdx.x; asm volatile("" : "+v"(tid_)); const int lane = tid_ & 63;
    const int gw = F.vcu * NWAVES + F.wave, NGW = F.G * NWAVES;
    for (int u = gw; u < BATCH * 16 * 8; u += NGW) {
        const int h = u & 7, n = (u >> 3) & 15, b = u >> 7, dp = lane & 31, half = lane >> 5;
        const GAS unsigned* p = (const GAS unsigned*)(PM + ((size_t)b * SEQ + n * 256 + half * 128) * NMIX + C_MK + h * 64) + dp;
        float s0 = 0.f, s1 = 0.f;
        for (int i = 0; i < 128; i += 16) { unsigned x[16];
#pragma unroll
            for (int k = 0; k < 16; ++k) x[k] = p[(size_t)(i + k) * (NMIX / 2)];
#pragma unroll
            for (int k = 0; k < 16; ++k) { s0 += __uint_as_float(x[k] << 16); s1 += __uint_as_float(x[k] & 0xffff0000u); } }
        s0 += __shfl_xor(s0, 32); s1 += __shfl_xor(s1, 32);
        if (half == 0) { float* o = KM + (((size_t)b * 8 + h) * 16 + n) * 64 + 2 * dp; o[0] = s0 * (1.f / 256.f); o[1] = s1 * (1.f / 256.f); }
    }
}
__device__ __forceinline__ void topk_phase(Frame& F, const bf16* PM, const float* KM, unsigned* SEL) {
    int tid_ = threadIdx.x; asm volatile("" : "+v"(tid_)); const int lane = tid_ & 63;
    const int gw = F.vcu * NWAVES + F.wave, NGW = F.G * NWAVES;
    for (int u = gw; u < (M / 64) * 8; u += NGW) {
        const int h = u & 7, m0 = (u >> 3) * 64, m = m0 + lane, b = m0 >> 12, j = (m0 & (SEQ - 1)) >> 8;
        float q[64];
        const GAS v4u* qp = (const GAS v4u*)(PM + (size_t)m * NMIX + C_MQ + h * 64);
#pragma unroll
        for (int d = 0; d < 8; ++d) { const v4u w = qp[d];
            q[8 * d + 0] = __uint_as_float(w.x << 16); q[8 * d + 1] = __uint_as_float(w.x & 0xffff0000u); q[8 * d + 2] = __uint_as_float(w.y << 16); q[8 * d + 3] = __uint_as_float(w.y & 0xffff0000u);
            q[8 * d + 4] = __uint_as_float(w.z << 16); q[8 * d + 5] = __uint_as_float(w.z & 0xffff0000u); q[8 * d + 6] = __uint_as_float(w.w << 16); q[8 * d + 7] = __uint_as_float(w.w & 0xffff0000u); }
        float b0 = -3e38f, b1 = -3e38f, b2 = -3e38f; int i0 = -1, i1 = -1, i2 = -1;
        for (int n = 0; n < j; ++n) {
            const float* km = KM + (((size_t)b * 8 + h) * 16 + n) * 64;
            float g = 0.f;
#pragma unroll
            for (int d = 0; d < 64; ++d) g += q[d] * km[d];
            if (g > b0) { b2 = b1; i2 = i1; b1 = b0; i1 = i0; b0 = g; i0 = n; }
            else if (g > b1) { b2 = b1; i2 = i1; b1 = g; i1 = n; }
            else if (g > b2) { b2 = g; i2 = n; }
        }
        unsigned sel = 0u;
        if (i0 >= 0) sel |= 1u << i0;
        if (i1 >= 0) sel |= 1u << i1;
        if (i2 >= 0) sel |= 1u << i2;
        SEL[((size_t)b * 8 + h) * SEQ + (m & (SEQ - 1))] = sel;
    }
}

namespace gla {
typedef short bf16x8 __attribute__((ext_vector_type(8)));
typedef float f32x4 __attribute__((ext_vector_type(4)));
constexpr int LP = 72, LPB = LP * 2;
constexpr int L_QD = 0, L_KI = 9216, L_KIT = 18432, L_VT = 27648, L_AT = 46080, L_SEG = 55296, L_RED = 57344, L_RN = 59392, L_END = 59648;
constexpr int NUNITS = BATCH * 4 * 64;
__device__ __forceinline__ bf16x8 frag(const LAS unsigned char* base, int row0, int k0, int lane) {
    return *(const LAS bf16x8*)(base + (row0 + (lane & 15)) * LPB + (k0 + 8 * (lane >> 4)) * 2);
}
__device__ __forceinline__ void load_vt(LAS unsigned char* lds, const bf16* PM, size_t m0, int h, int w, int lane) {
#pragma unroll
    for (int tt = 0; tt < 8; ++tt) { const int t = 8 * w + tt;
        const unsigned vw = *(const GAS unsigned*)(PM + (m0 + t) * NMIX + C_GV + h * 128 + 2 * lane);
        *(LAS unsigned short*)(lds + L_VT + (2 * lane) * LPB + t * 2) = (unsigned short)(vw & 0xffffu);
        *(LAS unsigned short*)(lds + L_VT + (2 * lane + 1) * LPB + t * 2) = (unsigned short)(vw >> 16); }
}
__device__ __forceinline__ void prep_unit(int u, LAS unsigned char* lds, bf16* PM, const float* G1, const float* w2, const float* bg, bf16* UT, float* EF, int w, int lane) {
    const int bh = u >> 6, c = u & 63, b = bh >> 2, h = bh & 3; const size_t m0 = (size_t)b * SEQ + c * 64;
    float wj[16];
#pragma unroll
    for (int j = 0; j < 16; ++j) wj[j] = w2[j * 256 + h * 64 + lane];
    const float bias = bg[h * 64 + lane];
    float cs[8]; float run = 0.f;
#pragma unroll
    for (int tt = 0; tt < 8; ++tt) { const float* g = G1 + (m0 + 8 * w + tt) * 16; float x = bias;
#pragma unroll
        for (int j = 0; j < 16; ++j) x += g[j] * wj[j];
        const float ls = fminf(x, 0.f) - __logf(1.f + __expf(-fabsf(x)));
        run += ls * (1.f / 16.f); cs[tt] = run; }
    LAS float* seg = (LAS float*)(lds + L_SEG);
    seg[w * 64 + lane] = run;
    unsigned short qraw[8], kraw[8];
#pragma unroll
    for (int tt = 0; tt < 8; ++tt) { qraw[tt] = PM[(m0 + 8 * w + tt) * NMIX + C_GQ + h * 64 + lane]; kraw[tt] = PM[(m0 + 8 * w + tt) * NMIX + C_GK + h * 64 + lane]; }
    load_vt(lds, PM, m0, h, w, lane);
    __syncthreads();
    float prefix = 0.f, ref = 0.f, tot = 0.f;
#pragma unroll
    for (int ww = 0; ww < 8; ++ww) { const float s = seg[ww * 64 + lane]; if (ww < w) prefix += s; if (ww < 4) ref += s; tot += s; }
#pragma unroll
    for (int tt = 0; tt < 8; ++tt) { const int t = 8 * w + tt; const float bc = prefix + cs[tt];
        const float e1 = __expf(bc - ref), e2 = __builtin_amdgcn_rcpf(e1);
        bf16* qp = PM + (m0 + t) * NMIX + C_GQ + h * 64 + lane; bf16* kp = PM + (m0 + t) * NMIX + C_GK + h * 64 + lane;
        const float q = __uint_as_float((unsigned)qraw[tt] << 16), k = __uint_as_float((unsigned)kraw[tt] << 16);
        const unsigned qi = f2bf(q * e1), ki = f2bf(k * e2);
        *qp = (bf16)qi; *kp = (bf16)ki;
        *(LAS unsigned short*)(lds + L_KIT + lane * LPB + t * 2) = (unsigned short)ki; }
    if (w == 0) { float* ef = EF + (size_t)u * 192; ef[lane] = __expf(tot); ef[64 + lane] = __expf(tot - ref); ef[128 + lane] = __expf(ref); }
    __syncthreads();
    const bf16x8 bv0 = frag(lds + L_VT, 16 * w, 0, lane), bv1 = frag(lds + L_VT, 16 * w, 32, lane);
#pragma unroll
    for (int dt = 0; dt < 4; ++dt) {
        const bf16x8 a0 = frag(lds + L_KIT, 16 * dt, 0, lane), a1 = frag(lds + L_KIT, 16 * dt, 32, lane);
        f32x4 acc = {0.f, 0.f, 0.f, 0.f};
        acc = __builtin_amdgcn_mfma_f32_16x16x32_bf16(a0, bv0, acc, 0, 0, 0);
        acc = __builtin_amdgcn_mfma_f32_16x16x32_bf16(a1, bv1, acc, 0, 0, 0);
        const int v = 16 * w + (lane & 15), d0 = 16 * dt + 4 * (lane >> 4);
        const unsigned long long pk = (unsigned long long)pk2(acc[0], acc[1]) | ((unsigned long long)pk2(acc[2], acc[3]) << 32);
        *(GAS unsigned long long*)(UT + ((size_t)u * 128 + v) * 64 + d0) = pk; }
    __syncthreads();
}
__device__ __forceinline__ void scan_phase(Frame& F, bf16* UT, const float* EF, int tid) {
    for (int idx = F.vcu * (NWAVES * 64) + tid; idx < BATCH * 4 * 128 * 32; idx += F.G * NWAVES * 64) {
        const int dp = idx & 31, v = (idx >> 5) & 127, bh = idx >> 12;
        float s0 = 0.f, s1 = 0.f;
        for (int cb = 0; cb < 64; cb += 8) {
            unsigned uw[8]; float ea0[8], ea1[8], eb0[8], eb1[8], ec0[8], ec1[8];
#pragma unroll
            for (int i = 0; i < 8; ++i) { const size_t u = (size_t)bh * 64 + cb + i;
                uw[i] = *(const GAS unsigned*)(UT + (u * 128 + v) * 64 + 2 * dp); const float* ef = EF + u * 192 + 2 * dp;
                ea0[i] = ef[0]; ea1[i] = ef[1]; eb0[i] = ef[64]; eb1[i] = ef[65]; ec0[i] = ef[128]; ec1[i] = ef[129]; }
#pragma unroll
            for (int i = 0; i < 8; ++i) { const size_t u = (size_t)bh * 64 + cb + i;
                const float u0 = __uint_as_float(uw[i] << 16), u1 = __uint_as_float(uw[i] & 0xffff0000u);
                *(GAS unsigned*)(UT + (u * 128 + v) * 64 + 2 * dp) = pk2(ec0[i] * s0, ec1[i] * s1);
                s0 = ea0[i] * s0 + eb0[i] * u0; s1 = ea1[i] * s1 + eb1[i] * u1; }
        }
    }
}
__device__ __forceinline__ void out_unit(int u, LAS unsigned char* lds, const bf16* PM, const bf16* UT, const float* nw, bf16* MO, int tid, int w, int lane) {
    const int bh = u >> 6, c = u & 63, b = bh >> 2, h = bh & 3; const size_t m0 = (size_t)b * SEQ + c * 64;
    { const int row = tid >> 3, ch = tid & 7;
        const v4u qv = *(const GAS v4u*)(PM + (m0 + row) * NMIX + C_GQ + h * 64 + ch * 8), kv = *(const GAS v4u*)(PM + (m0 + row) * NMIX + C_GK + h * 64 + ch * 8);
        *(LAS v4u*)(lds + L_QD + row * LPB + ch * 16) = qv; *(LAS v4u*)(lds + L_KI + row * LPB + ch * 16) = kv; }
    const int v = 16 * w + (lane & 15);
    const bf16x8 bs0 = *(const GAS bf16x8*)(UT + ((size_t)u * 128 + v) * 64 + 8 * (lane >> 4)), bs1 = *(const GAS bf16x8*)(UT + ((size_t)u * 128 + v) * 64 + 32 + 8 * (lane >> 4));
    unsigned short srr[16];
#pragma unroll
    for (int i = 0; i < 16; ++i) srr[i] = PM[(m0 + 16 * (i >> 2) + 4 * (lane >> 4) + (i & 3)) * NMIX + C_GR + h * 128 + v];
    const float nwv = nw[v];
    load_vt(lds, PM, m0, h, w, lane);
    __syncthreads();
    { const int tt = w >> 1; const bf16x8 a0 = frag(lds + L_QD, 16 * tt, 0, lane), a1 = frag(lds + L_QD, 16 * tt, 32, lane);
#pragma unroll
        for (int i = 0; i < 2; ++i) { const int st = 2 * (w & 1) + i;
            const bf16x8 b0 = frag(lds + L_KI, 16 * st, 0, lane), b1 = frag(lds + L_KI, 16 * st, 32, lane);
            f32x4 acc = {0.f, 0.f, 0.f, 0.f};
            acc = __builtin_amdgcn_mfma_f32_16x16x32_bf16(a0, b0, acc, 0, 0, 0);
            acc = __builtin_amdgcn_mfma_f32_16x16x32_bf16(a1, b1, acc, 0, 0, 0);
            const int s = 16 * st + (lane & 15);
#pragma unroll
            for (int j = 0; j < 4; ++j) { const int t = 16 * tt + 4 * (lane >> 4) + j;
                *(LAS unsigned short*)(lds + L_AT + t * LPB + s * 2) = (unsigned short)f2bf(s <= t ? acc[j] : 0.f); } } }
    __syncthreads();
    const bf16x8 bv0 = frag(lds + L_VT, 16 * w, 0, lane), bv1 = frag(lds + L_VT, 16 * w, 32, lane);
    f32x4 o[4];
    LAS float* red = (LAS float*)(lds + L_RED);
#pragma unroll
    for (int tt = 0; tt < 4; ++tt) {
        const bf16x8 q0 = frag(lds + L_QD, 16 * tt, 0, lane), q1 = frag(lds + L_QD, 16 * tt, 32, lane), p0 = frag(lds + L_AT, 16 * tt, 0, lane), p1 = frag(lds + L_AT, 16 * tt, 32, lane);
        f32x4 acc = {0.f, 0.f, 0.f, 0.f};
        acc = __builtin_amdgcn_mfma_f32_16x16x32_bf16(q0, bs0, acc, 0, 0, 0);
        acc = __builtin_amdgcn_mfma_f32_16x16x32_bf16(q1, bs1, acc, 0, 0, 0);
        acc = __builtin_amdgcn_mfma_f32_16x16x32_bf16(p0, bv0, acc, 0, 0, 0);
        acc = __builtin_amdgcn_mfma_f32_16x16x32_bf16(p1, bv1, acc, 0, 0, 0);
        o[tt] = acc;
#pragma unroll
        for (int j = 0; j < 4; ++j) { float p = acc[j] * acc[j];
            p += __shfl_xor(p, 1); p += __shfl_xor(p, 2); p += __shfl_xor(p, 4); p += __shfl_xor(p, 8);
            if ((lane & 15) == 0) red[w * 64 + 16 * tt + 4 * (lane >> 4) + j] = p; } }
    __syncthreads();
    LAS float* rn = (LAS float*)(lds + L_RN);
    if (tid < 64) { float s = 0.f;
#pragma unroll
        for (int ww = 0; ww < 8; ++ww) s += red[ww * 64 + tid];
        rn[tid] = 1.f / sqrtf(s * (1.f / 128.f) + EPS); }
    __syncthreads();
#pragma unroll
    for (int tt = 0; tt < 4; ++tt)
#pragma unroll
        for (int j = 0; j < 4; ++j) { const int t = 16 * tt + 4 * (lane >> 4) + j;
            const float sr = __uint_as_float((unsigned)srr[4 * tt + j] << 16);
            MO[(m0 + t) * KBR + h * 128 + v] = (bf16)f2bf(o[tt][j] * rn[t] * nwv * sr); }
    __syncthreads();
}
template <int WIN> __device__ __forceinline__ void pool_item(const bf16* PM, bf16* MO, int m, int t, int chn) {
    const int cnt = (t + 1 < WIN) ? (t + 1) : WIN;
    v4u x[WIN];
#pragma unroll
    for (int i = 0; i < WIN; ++i) x[i] = *(const GAS v4u*)(PM + (size_t)(m - (i < cnt ? i : 0)) * NMIX + C_PU + chn);
    float s[8];
#pragma unroll
    for (int k = 0; k < 8; ++k) s[k] = 0.f;
#pragma unroll
    for (int i = 0; i < WIN; ++i) { const float wgt = (i < cnt) ? 1.f : 0.f;
        s[0] += wgt * __uint_as_float(x[i].x << 16); s[1] += wgt * __uint_as_float(x[i].x & 0xffff0000u); s[2] += wgt * __uint_as_float(x[i].y << 16); s[3] += wgt * __uint_as_float(x[i].y & 0xffff0000u);
        s[4] += wgt * __uint_as_float(x[i].z << 16); s[5] += wgt * __uint_as_float(x[i].z & 0xffff0000u); s[6] += wgt * __uint_as_float(x[i].w << 16); s[7] += wgt * __uint_as_float(x[i].w & 0xffff0000u); }
    const float ic = 1.f / (float)cnt; const v4u x0 = x[0];
    v4u o; o.x = pk2(s[0] * ic - __uint_as_float(x0.x << 16), s[1] * ic - __uint_as_float(x0.x & 0xffff0000u)); o.y = pk2(s[2] * ic - __uint_as_float(x0.y << 16), s[3] * ic - __uint_as_float(x0.y & 0xffff0000u));
    o.z = pk2(s[4] * ic - __uint_as_float(x0.z << 16), s[5] * ic - __uint_as_float(x0.z & 0xffff0000u)); o.w = pk2(s[6] * ic - __uint_as_float(x0.w << 16), s[7] * ic - __uint_as_float(x0.w & 0xffff0000u));
    *(GAS v4u*)(MO + (size_t)m * KBR + 512 + chn) = o;
}
__device__ __forceinline__ void pool_phase(Frame& F, const bf16* PM, bf16* MO, int tid) {
    const int gw = F.vcu * NWAVES + F.wave, NGW = F.G * NWAVES, lane = tid & 63;
    for (int wi = gw; wi < M; wi += NGW) {
        const int g = wi & 3, m = 4 * (wi >> 2) + (lane >> 4), t = m & (SEQ - 1), chn = 128 * g + 8 * (lane & 15);
        if (g == 0) pool_item<2>(PM, MO, m, t, chn); else if (g == 1) pool_item<4>(PM, MO, m, t, chn); else if (g == 2) pool_item<8>(PM, MO, m, t, chn); else pool_item<16>(PM, MO, m, t, chn);
    }
}
}

__global__ void __launch_bounds__(NWAVES * 64, 2) mega_fwd(Args args) {
    extern __shared__ __attribute__((aligned(16))) unsigned char lds[];
    Frame F;
    F.lds = (LAS unsigned char*)lds;
    F.MISC = (volatile LAS unsigned*)(F.lds + MISC_OFF);
    F.tid = threadIdx.x; F.lane = F.tid & 63; F.wave = __builtin_amdgcn_readfirstlane(F.tid >> 6);
    F.G = gridDim.x; { const int bx = blockIdx.x; F.vcu = (F.G % 8 == 0) ? (bx % 8) * (F.G / 8) + bx / 8 : bx; }
    unsigned char* ws = args.ws;
    F.ctl = (gu32*)(ws + WS_CTL);
    for (int u = F.tid; u < (LDS_BYTES - LDSCTL_OFF) / 4; u += NWAVES * 64) ((LAS unsigned*)(F.lds + LDSCTL_OFF))[u] = 0u;
    __syncthreads();
    XcdBarrier bar = xcd_barrier_post((unsigned*)(F.ctl + CW_BAR) + args.li * XCD_BAR_WORDS, F.MISC + 8);
    const int lo = args.ph_lo, hi = args.ph_hi;
    unsigned long long pt0 = 0ull, pacc = 0ull;
#define PT0() do { if (PROBE_MASK) pt0 = rt(); } while (0)
#define PT1(cat) do { if (PROBE_MASK & (1u << (cat))) pacc += rt() - pt0; } while (0)
#define IN(k) (lo <= (k) && (k) < hi)
#define SEAM(k) do { if (IN(k) && IN((k) + 1)) { PT0(); xcd_barrier(bar); PT1(15); } } while (0)
    const float* x = args.in[0]; float* out = args.out;
    float* R = (float*)(ws + WS_R); float* G1 = (float*)(ws + WS_G1);
    bf16* XB = (bf16*)(ws + WS_XB); bf16* PM = (bf16*)(ws + WS_PM); bf16* MO = (bf16*)(ws + WS_MO);
    bf16* GATES = (bf16*)(ws + WS_GATES); bf16* MIXED = (bf16*)(ws + WS_MIXED); bf16* F1 = (bf16*)(ws + WS_F1); bf16* HDN = (bf16*)(ws + WS_HDN); bf16* F2 = (bf16*)(ws + WS_F2);

    PT0(); if (IN(0)) { p0_prologue(F, args); __syncthreads();     rows_phase(F, x, nullptr, nullptr, nullptr, XB, R, G1, args.in[2], args.in[1]); }
    PT1(0);
    SEAM(0);
    for (int l = 0; l < DEPTH; ++l) {
        const int pb = 1 + 9 * l;
        unsigned char* wl = ws + WS_W + (size_t)l * W_LAYER;
        const bf16* WIN_t = (const bf16*)(wl + W_IN); const bf16* WGATE_t = (const bf16*)(wl + W_GATE); const bf16* WBR_t = (const bf16*)(wl + W_BR);
        const bf16* WOUT_t = (const bf16*)(wl + W_OUT); const bf16* WGU_t = (const bf16*)(wl + W_GU); const bf16* WDN_t = (const bf16*)(wl + W_DN);
        PT0(); if (IN(pb + 0)) {
            pg8::Gemm g{XB, WIN_t, M, NMIX, DM, DM, 0}; pg8::StaticOrder S; S.init(M, NMIX, F.G, (int)blockIdx.x);
            pg8::EpiProj E{PM, R};
            pg8::gemm_phase<pg8::EpiProj, pg8::StaticOrder, true, true>(F.lds + RING_OFF, g, S, E);
        }
        PT1(1);
        SEAM(pb + 0);
        if (IN(pb + 1)) {
            float* KM = (float*)(ws + WS_KM); unsigned* SEL = (unsigned*)(ws + WS_SEL); bf16* UT = (bf16*)(ws + WS_UT); float* EF = (float*)(ws + WS_EF);
            int tid_ = threadIdx.x; asm volatile("" : "+v"(tid_)); const int tid = tid_, lane = tid & 63;
            PT0(); kmean_phase(F, PM, KM); PT1(8); PT0();
            for (int u = F.vcu; u < gla::NUNITS; u += F.G) gla::prep_unit(u, F.lds + RING_OFF, PM, G1, args.in[3] + l * 16 * 256, args.in[4] + l * 256, UT, EF, F.wave, lane);
            PT1(9); PT0(); gla::pool_phase(F, PM, MO, tid); PT1(10);
            PT0(); xcd_barrier(bar); PT1(15);
            PT0(); topk_phase(F, PM, KM, SEL); PT1(11); PT0();
            gla::scan_phase(F, UT, EF, tid); PT1(12);
            PT0(); xcd_barrier(bar); PT1(15);
            const attn_body::AttnTensors AT{(const attn_body::bf16*)(PM + C_MQ), (const attn_body::bf16*)(PM + C_MK), (const attn_body::bf16*)(PM + C_MV), (attn_body::bf16*)(MO + 1024), SEL};
            const attn_body::StaticOrder S((int)F.G, F.vcu);
            PT0(); attn_body::attn_phase<attn_body::StaticOrder>((char*)lds + RING_OFF, AT, S); PT1(13); PT0();
            int tid2_ = threadIdx.x; asm volatile("" : "+v"(tid2_));
            for (int u = F.vcu; u < gla::NUNITS; u += F.G) gla::out_unit(u, F.lds + RING_OFF, PM, UT, args.in[5] + l * 128, MO, tid2_, F.wave, tid2_ & 63);
            PT1(14);
        }
        SEAM(pb + 1);
        PT0(); if (IN(pb + 2)) {
            pg8::Gemm g{XB, WGATE_t, M, NGATE, DM, DM, 0}; pg8::StaticOrder S; S.init(M, NGATE, F.G, (int)blockIdx.x);
            pg8::EpiSig E{GATES, R};
            pg8::gemm_phase<pg8::EpiSig, pg8::StaticOrder, true, true>(F.lds + RING_OFF, g, S, E);
        }
        PT1(2);
        SEAM(pb + 2);
        PT0(); if (IN(pb + 3)) {
            pg8::Gemm g{MO, WBR_t, M, DM, KBR, 512, 1024}; pg8::SegOrder3 S; S.S.init(M, DM, F.G, (int)blockIdx.x);
            pg8::EpiMixed E{MIXED, GATES};
            pg8::gemm_phase<pg8::EpiMixed, pg8::SegOrder3, true, true>(F.lds + RING_OFF, g, S, E);
        }
        PT1(3);
        SEAM(pb + 3);
        PT0(); if (IN(pb + 4)) {
            pg8::Gemm g{MIXED, WOUT_t, M, DM, DM, DM, 0}; pg8::StaticOrder S; S.init(M, DM, F.G, (int)blockIdx.x);
            pg8::EpiPlain E{F1};
            pg8::gemm_phase<pg8::EpiPlain, pg8::StaticOrder, true, true>(F.lds + RING_OFF, g, S, E);
        }
        PT1(4);
        SEAM(pb + 4);
        PT0(); if (IN(pb + 5)) rows_phase(F, l == 0 ? x : out, F1, args.in[12] + l * DM, out, XB, R, nullptr, nullptr, nullptr);
        PT1(7);
        SEAM(pb + 5);
        PT0(); if (IN(pb + 6)) {
            pg8::Gemm g{XB, WGU_t, M, 2 * DFF, DM, DM, 0}; pg8::StaticOrder S; S.init(M, 2 * DFF, F.G, (int)blockIdx.x);
            pg8::EpiSwiglu E{HDN, R};
            pg8::gemm_phase<pg8::EpiSwiglu, pg8::StaticOrder, true, true>(F.lds + RING_OFF, g, S, E);
        }
        PT1(5);
        SEAM(pb + 6);
        PT0(); if (IN(pb + 7)) {
            pg8::Gemm g{HDN, WDN_t, M, DM, DFF, DFF, 0}; pg8::StaticOrder S; S.init(M, DM, F.G, (int)blockIdx.x);
            pg8::EpiPlain E{F2};
            pg8::gemm_phase<pg8::EpiPlain, pg8::StaticOrder, true, true>(F.lds + RING_OFF, g, S, E);
        }
        PT1(6);
        SEAM(pb + 7);
        PT0(); if (IN(pb + 8)) {
            const bool last = (l == DEPTH - 1);
            rows_phase(F, out, F2, args.in[17] + l * DM, out, last ? nullptr : XB, last ? nullptr : R, last ? nullptr : G1,
                       last ? nullptr : args.in[2] + (size_t)(l + 1) * DM * DIN, last ? nullptr : args.in[1] + (l + 1) * DM);
        }
        PT1(7);
        SEAM(pb + 8);
    }
#undef IN
#undef SEAM
    if (PROBE_MASK) { if (blockIdx.x == 0) { const unsigned long long tend = rt() + pacc; while (rt() < tend) __builtin_amdgcn_s_sleep(8); } }
#undef PT0
#undef PT1
}

extern "C" void kernel_launch(void* const* d_in, const int* in_sizes, int n_in, void* d_out, int out_size, void* d_ws, size_t ws_size, hipStream_t stream) {
    static int grid = 0;
    if (grid == 0) {
        if (n_in != 18 || in_sizes[0] != M * DM || out_size != M * DM || ws_size < WS_END) { fprintf(stderr, "kernel_launch: unexpected shapes (n_in %d, out %d, ws %zu); nothing launched\n", n_in, out_size, ws_size); grid = -1; return; }
        int dev = 0, cus = 0, per_cu = 0;
        if (hipGetDevice(&dev) != hipSuccess || hipDeviceGetAttribute(&cus, hipDeviceAttributeMultiprocessorCount, dev) != hipSuccess) { grid = -1; return; }
        if (hipFuncSetAttribute((const void*)mega_fwd, hipFuncAttributeMaxDynamicSharedMemorySize, LDS_BYTES) != hipSuccess) { fprintf(stderr, "kernel_launch: hipFuncSetAttribute failed\n"); grid = -1; return; }
        if (hipOccupancyMaxActiveBlocksPerMultiprocessor(&per_cu, (const void*)mega_fwd, NWAVES * 64, LDS_BYTES) != hipSuccess || per_cu < 1) { fprintf(stderr, "kernel_launch: occupancy query reports %d blocks per CU; nothing launched\n", per_cu); (void)hipGetLastError(); grid = -1; return; }
        grid = cus;
    }
    if (grid < 0) return;
    if (hipMemsetAsync((char*)d_ws + WS_CTL, 0, CTL_ZERO_BYTES, stream) != hipSuccess) return;
    Args a{};
    for (int i = 0; i < 18; ++i) a.in[i] = (const float*)d_in[i];
    a.out = (float*)d_out; a.ws = (unsigned char*)d_ws;
    a.ph_lo = 0; a.ph_hi = N_PHASES; a.li = 0;
    hipLaunchKernelGGL(mega_fwd, dim3(grid), dim3(NWAVES * 64), LDS_BYTES, stream, a);
}
```

```cpp
#include <hip/hip_runtime.h>
#include <hip/hip_bf16.h>
#include <cmath>
#include <stdint.h>
#include <cstdio>
#ifndef PROBE_MASK
#define PROBE_MASK 0
#endif

constexpr int BATCH = 8, SEQ = 4096, DM = 1024, M = BATCH * SEQ, DEPTH = 2;
constexpr int DIN = 6672, NMIX = 3584, NGATE = 3072, DFF = 2816, KBR = 1536;
constexpr int C_MQ = 0, C_MK = 512, C_MV = 1024, C_GQ = 1536, C_GK = 1792, C_GV = 2048, C_GR = 2560, C_PU = 3072;
constexpr int O_GQ = 0, O_GK = 256, O_GV = 512, O_G1 = 1024, O_GR = 1040, O_PU = 1552, O_MQ = 2064, O_MK = 2576, O_MV = 3088, O_GATE = 3600;
constexpr float EPS = 1e-6f;

constexpr size_t MiB = 1u << 20;
constexpr size_t WS_CTL = 0, CTL_ZERO_BYTES = 1 * MiB;
constexpr size_t WS_R = 1 * MiB;
constexpr size_t WS_G1 = 2 * MiB;
constexpr size_t WS_KM = 4 * MiB;
constexpr size_t WS_W = 6 * MiB, W_LAYER = 35 * MiB;
constexpr size_t W_IN = 0, W_GATE = 7 * MiB, W_BR = 13 * MiB, W_OUT = 16 * MiB, W_GU = 18 * MiB, W_DN = 29 * MiB;
constexpr size_t WS_XB = 76 * MiB;
constexpr size_t WS_PM = 140 * MiB;
constexpr size_t WS_MO = 364 * MiB;
constexpr size_t WS_UT = 460 * MiB;
constexpr size_t WS_EF = 492 * MiB;
constexpr size_t WS_GATES = WS_PM;
constexpr size_t WS_MIXED = WS_XB;
constexpr size_t WS_F1 = WS_MO;
constexpr size_t WS_HDN = WS_PM;
constexpr size_t WS_F2 = WS_MO;
constexpr size_t WS_END = 512 * MiB;

typedef unsigned short bf16_t;
namespace pg8 {
#define PG8_LAS __attribute__((address_space(3)))
typedef unsigned short bf16_t;
typedef short bf16x8 __attribute__((ext_vector_type(8)));
typedef float f32x4 __attribute__((ext_vector_type(4)));
typedef unsigned u32x4 __attribute__((ext_vector_type(4)));
constexpr int BM = 256, BK = 64, HALF = 128, HTB = HALF * BK * 2  , STAGE_BYTES = 8 * HTB, NXCD = 8, WGM = 8;

__host__ __device__ __forceinline__ int lds_byte(int r, int c) { const int st = (r >> 4) * 2 + (c >> 5), rr = r & 15, cc = c & 31, ob = rr * 64 + cc * 2; return st * 1024 + (ob ^ (((ob >> 9) & 1) << 5)); }
__host__ __device__ __forceinline__ void stage_rc(int b, int& R, int& C) { const int st = b / 1024, sb = b % 1024, swz = sb ^ (((sb >> 9) & 1) << 5); R = (st >> 1) * 16 + swz / 64; C = (st & 1) * 32 + (swz % 64) / 2; }
__host__ __device__ __forceinline__ int perm32(int rho) { const int n = rho >> 4, i = rho & 15; return 8 * (i >> 2) + 4 * n + (i & 3); }

struct Unit { int pm, pn, ks; };
struct Gemm { const bf16_t* A; const bf16_t* Bt; int M, N, K, Kt, ksb; };

struct StaticOrder {
    int nM, nN, nwg, G, c;
    __host__ __device__ void init(int M, int N, int G_, int c_) { nM = M / BM; nN = N / BM; nwg = nM * nN; G = G_; c = c_; }
    __host__ __device__ bool next(int i, Unit& u) const {
        const long L = (long)i * G + c; if (L >= nwg) return false;
        int wgid = (int)L; { const int q = nwg / NXCD, r = nwg % NXCD, xcd = wgid % NXCD, off = wgid / NXCD; wgid = (xcd < r ? xcd * (q + 1) : r * (q + 1) + (xcd - r) * q) + off; }
        const int nig = WGM * nN, gid = wgid / nig, fm = gid * WGM, gsz = (nM - fm) < WGM ? (nM - fm) : WGM;
        u.pm = fm + ((wgid % nig) % gsz); u.pn = (wgid % nig) / gsz; u.ks = 0; return true;
    }
    __device__ __forceinline__ void a_ready(const Unit&) const {}
    __device__ __forceinline__ void done(const Unit&) const {}
};

__device__ __forceinline__ unsigned cvt_pk_bf16(float lo, float hi) { unsigned r; asm volatile("v_cvt_pk_bf16_f32 %0, %1, %2" : "=v"(r) : "v"(lo), "v"(hi)); return r; }
struct SegOrder3 {
    StaticOrder S;
    __device__ __forceinline__ bool next(int i, Unit& u) const { const int q = i / 3; if (!S.next(q, u)) return false; u.ks = i - 3 * q; return true; }
    __device__ __forceinline__ void a_ready(const Unit&) const {}
    __device__ __forceinline__ void done(const Unit&) const {}
};
__device__ __forceinline__ float fast_sigmoid(float x) { return __builtin_amdgcn_rcpf(1.f + __expf(-x)); }
__device__ __forceinline__ float bflo(unsigned w) { return __uint_as_float(w << 16); }
__device__ __forceinline__ float bfhi(unsigned w) { return __uint_as_float(w & 0xffff0000u); }
struct EpiProj {
    static constexpr bool PERM = true, AFTER_DRAIN = false, SEGS = false;
    bf16_t* O; const float* R;
    __device__ __forceinline__ void operator()(const f32x4 (&acc)[2][2][4][2], const Unit& u, int wr, int wc, int fr, int fq) const {
        const int pn = u.pn; const float cs = (pn < 2) ? 0.125f * 1.4426950408889634f : (pn == 6) ? 0.125f : 1.f; const bool silu = (pn == 10 || pn == 11);
        const int row0 = u.pm * BM + wr * 64 + fr, col0 = pn * BM + wc * 32 + 8 * fq;
#pragma unroll
        for (int ai = 0; ai < 2; ++ai)
#pragma unroll
            for (int m = 0; m < 4; ++m) { const int row = row0 + ai * HALF + m * 16; const float r = R[row] * cs; bf16_t* rowp = O + (size_t)row * 3584 + col0;
#pragma unroll
                for (int bj = 0; bj < 2; ++bj) { f32x4 v0 = acc[ai][bj][m][0] * r, v1 = acc[ai][bj][m][1] * r;
                    if (silu) {
#pragma unroll
                        for (int i = 0; i < 4; ++i) { v0[i] = v0[i] * fast_sigmoid(v0[i]); v1[i] = v1[i] * fast_sigmoid(v1[i]); } }
                    u32x4 w; w.x = cvt_pk_bf16(v0[0], v0[1]); w.y = cvt_pk_bf16(v0[2], v0[3]); w.z = cvt_pk_bf16(v1[0], v1[1]); w.w = cvt_pk_bf16(v1[2], v1[3]);
                    *(u32x4*)(rowp + bj * HALF) = w; } }
    }
};
struct EpiSig {
    static constexpr bool PERM = true, AFTER_DRAIN = false, SEGS = false;
    bf16_t* O; const float* R;
    __device__ __forceinline__ void operator()(const f32x4 (&acc)[2][2][4][2], const Unit& u, int wr, int wc, int fr, int fq) const {
        const int row0 = u.pm * BM + wr * 64 + fr, col0 = u.pn * BM + wc * 32 + 8 * fq;
#pragma unroll
        for (int ai = 0; ai < 2; ++ai)
#pragma unroll
            for (int m = 0; m < 4; ++m) { const int row = row0 + ai * HALF + m * 16; const float r = R[row]; bf16_t* rowp = O + (size_t)row * 3072 + col0;
#pragma unroll
                for (int bj = 0; bj < 2; ++bj) { f32x4 v0 = acc[ai][bj][m][0] * r, v1 = acc[ai][bj][m][1] * r;
#pragma unroll
                    for (int i = 0; i < 4; ++i) { v0[i] = fmaxf(fast_sigmoid(v0[i]), 1e-18f); v1[i] = fmaxf(fast_sigmoid(v1[i]), 1e-18f); }
                    u32x4 w; w.x = cvt_pk_bf16(v0[0], v0[1]); w.y = cvt_pk_bf16(v0[2], v0[3]); w.z = cvt_pk_bf16(v1[0], v1[1]); w.w = cvt_pk_bf16(v1[2], v1[3]);
                    *(u32x4*)(rowp + bj * HALF) = w; } }
    }
};
struct EpiPlain {
    static constexpr bool PERM = true, AFTER_DRAIN = false, SEGS = false;
    bf16_t* O;
    __device__ __forceinline__ void operator()(const f32x4 (&acc)[2][2][4][2], const Unit& u, int wr, int wc, int fr, int fq) const {
        const int row0 = u.pm * BM + wr * 64 + fr, col0 = u.pn * BM + wc * 32 + 8 * fq;
#pragma unroll
        for (int ai = 0; ai < 2; ++ai)
#pragma unroll
            for (int m = 0; m < 4; ++m) { bf16_t* rowp = O + (size_t)(row0 + ai * HALF + m * 16) * 1024 + col0;
#pragma unroll
                for (int bj = 0; bj < 2; ++bj) { const f32x4 v0 = acc[ai][bj][m][0], v1 = acc[ai][bj][m][1];
                    u32x4 w; w.x = cvt_pk_bf16(v0[0], v0[1]); w.y = cvt_pk_bf16(v0[2], v0[3]); w.z = cvt_pk_bf16(v1[0], v1[1]); w.w = cvt_pk_bf16(v1[2], v1[3]);
                    *(u32x4*)(rowp + bj * HALF) = w; } }
    }
};
struct EpiSwiglu {
    static constexpr bool PERM = true, AFTER_DRAIN = false, SEGS = false;
    bf16_t* O; const float* R;
    __device__ __forceinline__ void operator()(const f32x4 (&acc)[2][2][4][2], const Unit& u, int wr, int wc, int fr, int fq) const {
        const int row0 = u.pm * BM + wr * 64 + fr, col0 = u.pn * HALF + wc * 32 + 8 * fq;
#pragma unroll
        for (int ai = 0; ai < 2; ++ai)
#pragma unroll
            for (int m = 0; m < 4; ++m) { const int row = row0 + ai * HALF + m * 16; const float r = R[row];
                f32x4 h0, h1;
#pragma unroll
                for (int i = 0; i < 4; ++i) { const float g0 = acc[ai][0][m][0][i] * r, g1 = acc[ai][0][m][1][i] * r;
                    h0[i] = g0 * fast_sigmoid(g0) * (acc[ai][1][m][0][i] * r); h1[i] = g1 * fast_sigmoid(g1) * (acc[ai][1][m][1][i] * r); }
                u32x4 w; w.x = cvt_pk_bf16(h0[0], h0[1]); w.y = cvt_pk_bf16(h0[2], h0[3]); w.z = cvt_pk_bf16(h1[0], h1[1]); w.w = cvt_pk_bf16(h1[2], h1[3]);
                *(u32x4*)(O + (size_t)row * 2816 + col0) = w; }
    }
};
struct EpiMixed {
    static constexpr bool PERM = true, AFTER_DRAIN = false, SEGS = true;
    bf16_t* O; const bf16_t* G;
    __device__ __forceinline__ void operator()(f32x4 (&acc)[2][2][4][2], const Unit& u, int wr, int wc, int fr, int fq) const {
        const int row0 = u.pm * BM + wr * 64 + fr, col0 = u.pn * BM + wc * 32 + 8 * fq;
        if (u.ks < 2) {
            const char* gb = (const char*)G + (size_t)u.ks * 2048;
#pragma unroll
            for (int ai = 0; ai < 2; ++ai)
#pragma unroll
                for (int m = 0; m < 4; ++m) { const unsigned off = ((unsigned)(row0 + ai * HALF + m * 16) * 3072u + (unsigned)col0) * 2u;
#pragma unroll
                    for (int bj = 0; bj < 2; ++bj) { const u32x4 a = *(const u32x4*)(gb + off + bj * 256), b = *(const u32x4*)(gb + off + 2048 + bj * 256);
                        f32x4 r0, r1;
                        r0[0] = bflo(a.x) * __builtin_amdgcn_rcpf(bflo(b.x)); r0[1] = bfhi(a.x) * __builtin_amdgcn_rcpf(bfhi(b.x));
                        r0[2] = bflo(a.y) * __builtin_amdgcn_rcpf(bflo(b.y)); r0[3] = bfhi(a.y) * __builtin_amdgcn_rcpf(bfhi(b.y));
                        r1[0] = bflo(a.z) * __builtin_amdgcn_rcpf(bflo(b.z)); r1[1] = bfhi(a.z) * __builtin_amdgcn_rcpf(bfhi(b.z));
                        r1[2] = bflo(a.w) * __builtin_amdgcn_rcpf(bflo(b.w)); r1[3] = bfhi(a.w) * __builtin_amdgcn_rcpf(bfhi(b.w));
                        acc[ai][bj][m][0] *= r0; acc[ai][bj][m][1] *= r1; }
                    asm volatile("" ::: "memory"); }
        } else {
#pragma unroll
            for (int ai = 0; ai < 2; ++ai)
#pragma unroll
                for (int m = 0; m < 4; ++m) { const int row = row0 + ai * HALF + m * 16; const bf16_t* gp = G + (size_t)row * 3072 + 2048 + col0; bf16_t* rowp = O + (size_t)row * 1024 + col0;
#pragma unroll
                    for (int bj = 0; bj < 2; ++bj) { const u32x4 a = *(const u32x4*)(gp + bj * HALF); const f32x4 v0 = acc[ai][bj][m][0], v1 = acc[ai][bj][m][1];
                        u32x4 w; w.x = cvt_pk_bf16(v0[0] * bflo(a.x), v0[1] * bfhi(a.x)); w.y = cvt_pk_bf16(v0[2] * bflo(a.y), v0[3] * bfhi(a.y));
                        w.z = cvt_pk_bf16(v1[0] * bflo(a.z), v1[1] * bfhi(a.z)); w.w = cvt_pk_bf16(v1[2] * bflo(a.w), v1[3] * bfhi(a.w));
                        *(u32x4*)(rowp + bj * HALF) = w; }
                    asm volatile("" ::: "memory"); }
        }
    }
};

template <class Epi, class Sched, bool ALIGN_EPI = false, bool SP2 = false>
__device__ __forceinline__ void gemm_phase(PG8_LAS unsigned char* lds, const Gemm g, const Sched& S, const Epi& E) {
    int tid_ = threadIdx.x; asm volatile("" : "+v"(tid_));
    const int tid = tid_, wid = __builtin_amdgcn_readfirstlane(tid >> 6), lane = tid & 63, wr = wid >> 2, wc = wid & 3, fr = lane & 15, fq = lane >> 4;
    const int K = g.K, nt = g.Kt / BK;
    unsigned voffA[2], voffB[2];
#pragma unroll
    for (int i = 0; i < 2; ++i) { int R, C; stage_rc(tid * 16 + i * 8192, R, C); const int Rb = Epi::PERM ? ((R & ~31) + perm32(R & 31)) : R;
        voffA[i] = (unsigned)(R * K + C) * 2u; voffB[i] = (unsigned)(Rb * K + C) * 2u; }
    const size_t kstep = (size_t)(BK * 2);
    const size_t hstep = (size_t)HALF * K * 2;
    const size_t tstep = 2 * hstep;
    const unsigned ldsw = (unsigned)wid * 1024u;
    const int aoff = lds_byte(wr * 64 + fr, fq * 8), boff = lds_byte(wc * 32 + fr, fq * 8);
#define PG8_SA(b, h) (((b) * 2 + (h)) * HTB)
#define PG8_SB(b, h) ((4 + (b) * 2 + (h)) * HTB)
#define PG8_STAGE(bufoff, gbase, voff) do { _Pragma("unroll") for (int _i = 0; _i < 2; ++_i) \
        __builtin_amdgcn_global_load_lds((const unsigned*)((const char*)(gbase) + (voff)[_i]), (PG8_LAS unsigned*)(lds + (bufoff) + ldsw + _i * 8192), 16, 0, 0); } while (0)
#define PG8_LDA(dst, b, h) do { _Pragma("unroll") for (int m = 0; m < 4; ++m) _Pragma("unroll") for (int k = 0; k < 2; ++k) dst[m][k] = *(const PG8_LAS bf16x8*)(lds + PG8_SA(b, h) + aoff + m * 2048 + k * 1024); } while (0)
#define PG8_LDB(dst, b, h) do { _Pragma("unroll") for (int n = 0; n < 2; ++n) _Pragma("unroll") for (int k = 0; k < 2; ++k) dst[n][k] = *(const PG8_LAS bf16x8*)(lds + PG8_SB(b, h) + boff + n * 2048 + k * 1024); } while (0)
#define PG8_MMA(ai, bj, At, Bt) do { __builtin_amdgcn_s_setprio(1); _Pragma("unroll") for (int m = 0; m < 4; ++m) _Pragma("unroll") for (int n = 0; n < 2; ++n) _Pragma("unroll") for (int k = 0; k < 2; ++k) \
        acc[ai][bj][m][n] = __builtin_amdgcn_mfma_f32_16x16x32_bf16(Bt[n][k], At[m][k], acc[ai][bj][m][n], 0, 0, 0); __builtin_amdgcn_s_setprio(0); } while (0)
#define PG8_WAIT_V(n) asm volatile("s_waitcnt vmcnt(" #n ")" ::: "memory")
#define PG8_WAIT_L(n) asm volatile("s_waitcnt lgkmcnt(" #n ")" ::: "memory")
#define PG8_BAR __builtin_amdgcn_s_barrier()
#define PG8_SCHED __builtin_amdgcn_sched_barrier(0)
    Unit cur, nxt; int ui = 0;
    if (!S.next(0, cur)) return;
    f32x4 acc[2][2][4][2];
#pragma unroll
    for (int a = 0; a < 2; ++a)
#pragma unroll
        for (int b = 0; b < 2; ++b)
#pragma unroll
            for (int m = 0; m < 4; ++m)
#pragma unroll
                for (int n = 0; n < 2; ++n) acc[a][b][m][n] = (f32x4){0.f, 0.f, 0.f, 0.f};
    bf16x8 At[4][2], B0[2][2], B1[2][2];
    const char* cA = (const char*)g.A + (size_t)cur.pm * tstep + (size_t)cur.ks * g.ksb; const char* cB = (const char*)g.Bt + (size_t)cur.pn * tstep + (size_t)cur.ks * g.ksb;
    S.a_ready(cur);
    if constexpr (SP2) {
        PG8_STAGE(PG8_SB(0, 0), cB, voffB); PG8_STAGE(PG8_SB(0, 1), cB + hstep, voffB); PG8_STAGE(PG8_SA(0, 0), cA, voffA); PG8_STAGE(PG8_SA(0, 1), cA + hstep, voffA);
        if (wr == 1) PG8_BAR;
        PG8_WAIT_V(2); PG8_BAR;
        PG8_STAGE(PG8_SB(1, 0), cB + kstep, voffB); PG8_STAGE(PG8_SA(1, 0), cA + kstep, voffA); PG8_STAGE(PG8_SB(1, 1), cB + hstep + kstep, voffB);
        PG8_WAIT_V(6); PG8_BAR;
    } else {
        PG8_STAGE(PG8_SB(0, 0), cB, voffB); PG8_STAGE(PG8_SA(0, 0), cA, voffA); PG8_STAGE(PG8_SB(0, 1), cB + hstep, voffB); PG8_STAGE(PG8_SA(0, 1), cA + hstep, voffA);
        if (wr == 1) PG8_BAR;
        PG8_WAIT_V(4); PG8_BAR;
        PG8_STAGE(PG8_SB(1, 0), cB + kstep, voffB); PG8_STAGE(PG8_SA(1, 0), cA + kstep, voffA); PG8_STAGE(PG8_SB(1, 1), cB + hstep + kstep, voffB);
        PG8_WAIT_V(6); PG8_BAR;
    }
    for (;;) {
        const bool has_next = S.next(ui + 1, nxt);
        const char* nA = has_next ? (const char*)g.A + (size_t)nxt.pm * tstep + (size_t)nxt.ks * g.ksb : cA; const char* nB = has_next ? (const char*)g.Bt + (size_t)nxt.pn * tstep + (size_t)nxt.ks * g.ksb : cB;
        for (int t = 0; t < nt; t += 2) {
            const bool last = (t == nt - 2);
            const char* a1 = cA + (size_t)(t + 1) * kstep;
            const char* a2 = last ? nA : cA + (size_t)(t + 2) * kstep; const char* b2 = last ? nB : cB + (size_t)(t + 2) * kstep;
            const char* a3 = a2 + kstep; const char* b3 = b2 + kstep;
            if (last && has_next) S.a_ready(nxt);
            if constexpr (SP2) {
            PG8_LDB(B0, 0, 0); PG8_LDB(B1, 0, 1); PG8_SCHED; PG8_LDA(At, 0, 0); PG8_STAGE(PG8_SA(1, 1), a1 + hstep, voffA);
            PG8_WAIT_V(8); PG8_WAIT_L(0); PG8_BAR; PG8_MMA(0, 0, At, B0); PG8_MMA(0, 1, At, B1); PG8_BAR; PG8_SCHED;
            PG8_LDA(At, 0, 1); PG8_STAGE(PG8_SB(0, 0), b2, voffB); PG8_STAGE(PG8_SB(0, 1), b2 + hstep, voffB); PG8_STAGE(PG8_SA(0, 0), a2, voffA);
            PG8_WAIT_V(8); PG8_WAIT_L(0); PG8_BAR; PG8_MMA(1, 0, At, B0); PG8_MMA(1, 1, At, B1); PG8_BAR; PG8_SCHED;
            PG8_LDB(B0, 1, 0); PG8_LDB(B1, 1, 1); PG8_SCHED; PG8_LDA(At, 1, 0); PG8_STAGE(PG8_SA(0, 1), a2 + hstep, voffA);
            PG8_WAIT_V(8); PG8_WAIT_L(0); PG8_BAR; PG8_MMA(0, 0, At, B0); PG8_MMA(0, 1, At, B1); PG8_BAR; PG8_SCHED;
            PG8_LDA(At, 1, 1); PG8_STAGE(PG8_SB(1, 0), b3, voffB); PG8_STAGE(PG8_SB(1, 1), b3 + hstep, voffB); PG8_STAGE(PG8_SA(1, 0), a3, voffA);
            PG8_WAIT_V(8); PG8_WAIT_L(0); PG8_BAR; PG8_MMA(1, 0, At, B0); PG8_MMA(1, 1, At, B1); PG8_BAR; PG8_SCHED;
            } else {
            PG8_LDB(B0, 0, 0); PG8_SCHED; PG8_LDA(At, 0, 0); PG8_STAGE(PG8_SA(1, 1), a1 + hstep, voffA);
            PG8_WAIT_L(8); PG8_BAR; PG8_WAIT_L(0); PG8_MMA(0, 0, At, B0); PG8_BAR; PG8_SCHED;
            PG8_LDB(B1, 0, 1); PG8_STAGE(PG8_SB(0, 0), b2, voffB);
            PG8_BAR; PG8_WAIT_L(0); PG8_MMA(0, 1, At, B1); PG8_BAR;
            PG8_LDA(At, 0, 1); PG8_STAGE(PG8_SA(0, 0), a2, voffA);
            PG8_BAR; PG8_WAIT_L(0); PG8_MMA(1, 0, At, B0); PG8_BAR; PG8_SCHED;
            PG8_STAGE(PG8_SB(0, 1), b2 + hstep, voffB);
            PG8_WAIT_V(6); PG8_BAR; PG8_MMA(1, 1, At, B1); PG8_BAR;
            PG8_LDB(B0, 1, 0); PG8_SCHED; PG8_LDA(At, 1, 0); PG8_STAGE(PG8_SA(0, 1), a2 + hstep, voffA);
            PG8_WAIT_L(8); PG8_BAR; PG8_WAIT_L(0); PG8_MMA(0, 0, At, B0); PG8_BAR; PG8_SCHED;
            PG8_LDB(B1, 1, 1); PG8_STAGE(PG8_SB(1, 0), b3, voffB);
            PG8_BAR; PG8_WAIT_L(0); PG8_MMA(0, 1, At, B1); PG8_BAR;
            PG8_LDA(At, 1, 1); PG8_STAGE(PG8_SA(1, 0), a3, voffA);
            PG8_BAR; PG8_WAIT_L(0); PG8_MMA(1, 0, At, B0); PG8_BAR; PG8_SCHED;
            PG8_STAGE(PG8_SB(1, 1), b3 + hstep, voffB);
            PG8_WAIT_V(6); PG8_BAR; PG8_MMA(1, 1, At, B1); PG8_BAR;
            }
        }
        if constexpr (ALIGN_EPI) { if (wr == 0) PG8_BAR; }
        if constexpr (!Epi::AFTER_DRAIN) { E(acc, cur, wr, wc, fr, fq); S.done(cur); }
        if (!has_next) break;
        if (!(Epi::SEGS && cur.ks < 2)) {
#pragma unroll
        for (int a = 0; a < 2; ++a)
#pragma unroll
            for (int b = 0; b < 2; ++b)
#pragma unroll
                for (int m = 0; m < 4; ++m)
#pragma unroll
                    for (int n = 0; n < 2; ++n) acc[a][b][m][n] = (f32x4){0.f, 0.f, 0.f, 0.f};
        }
        cur = nxt; cA = nA; cB = nB; ++ui;
        if constexpr (ALIGN_EPI) { if (wr == 1) PG8_BAR; }
    }
    PG8_WAIT_V(0);
    if constexpr (!ALIGN_EPI) { if (wr == 0) PG8_BAR; }
    PG8_BAR;
    if constexpr (Epi::AFTER_DRAIN) { E.fused(acc, cur, wr, wc, fr, fq, lds, wid, lane); S.done(cur); }
#undef PG8_SA
#undef PG8_SB
#undef PG8_STAGE
#undef PG8_LDA
#undef PG8_LDB
#undef PG8_MMA
#undef PG8_WAIT_V
#undef PG8_WAIT_L
#undef PG8_BAR
#undef PG8_SCHED
}
}

namespace attn_body {
using bf16=__hip_bfloat16;
using bf16x8=__attribute__((ext_vector_type(8)))short;
using s16x4=__attribute__((ext_vector_type(4)))short;
using f32x16=__attribute__((ext_vector_type(16)))float;
using u32x4=__attribute__((ext_vector_type(4)))unsigned;
constexpr int BATCH=8,NHEAD=8,SEQ=4096,D=64,QP=3584,OP=1536;
constexpr int NW=8,QBLK=32,QB=QBLK*NW,KVBLK=64,NQB=SEQ/QB;
constexpr int ATTN_UNIT_ROWS=QB;
__device__ __forceinline__ int crow(int r,int hi){return (r&3)+8*(r>>2)+4*hi;}
#define SBAR() __builtin_amdgcn_sched_barrier(0)
__device__ __forceinline__ void cmask(f32x16&p0,f32x16&p1,int jb,int qrel,int hi){
  const float NEG=-INFINITY; int kb=64*jb+4*hi;
  #pragma unroll
  for(int r=0;r<16;++r){int kv=kb+(r&3)+8*(r>>2); if(kv>qrel)p0[r]=NEG; if(kv+32>qrel)p1[r]=NEG;}
}

constexpr int NSLOT=3, SLOTB=8192;
constexpr int LDS_K=0, LDS_V=NSLOT*SLOTB, LDS_WS=2*NSLOT*SLOTB, LDS_OST=LDS_WS+NW*64*4, LDS_BYTES=LDS_OST+NW*4096;
constexpr float C2=0.125f*1.4426950408889634f;
__device__ __forceinline__ void glds16(const void*gsrc,unsigned lds_dst){unsigned keep;
  asm volatile("s_mov_b32 %0, m0\n\ts_mov_b32 m0, %2\n\ts_nop 0\n\tglobal_load_lds_dwordx4 %1, off\n\ts_mov_b32 m0, %0":"=&s"(keep):"v"(gsrc),"s"(lds_dst):"memory");}
__device__ __forceinline__ float max3f(float a,float b,float c){float r;asm("v_max3_f32 %0, %1, %2, %3":"=v"(r):"v"(a),"v"(b),"v"(c));return r;}
__device__ __forceinline__ float max2f(float a,float b){float r;asm("v_max_f32_e32 %0, %1, %2":"=v"(r):"v"(a),"v"(b));return r;}
__device__ __forceinline__ float fadd_s(float a,float b){float r;asm("v_add_f32_e32 %0, %1, %2":"=v"(r):"v"(a),"v"(b));return r;}
__device__ __forceinline__ float fsub_s(float a,float b){float r;asm("v_sub_f32_e32 %0, %1, %2":"=v"(r):"v"(a),"v"(b));return r;}
typedef float f32x2_t __attribute__((ext_vector_type(2))); typedef __bf16 bf16x2_t __attribute__((ext_vector_type(2)));
__device__ __forceinline__ unsigned cvtpk_s(float lo,float hi){f32x2_t v={lo,hi};bf16x2_t b=__builtin_convertvector(v,bf16x2_t);return __builtin_bit_cast(unsigned,b);}
#define WAIT_BAR(N) asm volatile("s_waitcnt vmcnt(" #N ") lgkmcnt(0)\n\ts_barrier":::"memory")

__device__ __forceinline__ void qkt(f32x16&p0,f32x16&p1,const char*Kslot,const bf16x8*qr,int r32,int hi){
  const char*kb=Kslot+hi*1024+r32*16;
  #pragma unroll
  for(int d0=0;d0<4;++d0){
    const bf16x8 b0=*reinterpret_cast<const bf16x8*>(kb+d0*2048);
    const bf16x8 b1=*reinterpret_cast<const bf16x8*>(kb+d0*2048+512);
    p0=__builtin_amdgcn_mfma_f32_32x32x16_bf16(b0,qr[d0],p0,0,0,0);p1=__builtin_amdgcn_mfma_f32_32x32x16_bf16(b1,qr[d0],p1,0,0,0);}
}
typedef __attribute__((address_space(3))) const char* lds_cptr;
typedef short v4i16_t __attribute__((ext_vector_type(4)));
__device__ __forceinline__ void kload8(bf16x8*kf,lds_cptr kp){
  kf[0]=*(const __attribute__((address_space(3))) bf16x8*)(kp);      kf[1]=*(const __attribute__((address_space(3))) bf16x8*)(kp+512);
  kf[2]=*(const __attribute__((address_space(3))) bf16x8*)(kp+2048); kf[3]=*(const __attribute__((address_space(3))) bf16x8*)(kp+2560);
  kf[4]=*(const __attribute__((address_space(3))) bf16x8*)(kp+4096); kf[5]=*(const __attribute__((address_space(3))) bf16x8*)(kp+4608);
  kf[6]=*(const __attribute__((address_space(3))) bf16x8*)(kp+6144); kf[7]=*(const __attribute__((address_space(3))) bf16x8*)(kp+6656);
}
__device__ __forceinline__ void kload2(bf16x8*kf,lds_cptr kp,int j){ kf[2*j]=*(const __attribute__((address_space(3))) bf16x8*)(kp+j*2048); kf[2*j+1]=*(const __attribute__((address_space(3))) bf16x8*)(kp+j*2048+512); }
__device__ __forceinline__ s16x4 vtr(lds_cptr p){ return __builtin_bit_cast(s16x4,__builtin_amdgcn_ds_read_tr16_b64_v4i16((__attribute__((address_space(3))) v4i16_t*)p)); }
__device__ __forceinline__ float rowmax(const f32x16&p0,const f32x16&p1){
  float a=max3f(p0[0],p0[1],p1[0]),b=max3f(p0[2],p0[3],p1[1]);a=max3f(a,p1[2],p1[3]);
  #pragma unroll
  for(int r=4;r<16;r+=4){a=max3f(a,p0[r],p0[r+1]);b=max3f(b,p0[r+2],p0[r+3]);a=max3f(a,p1[r],p1[r+1]);b=max3f(b,p1[r+2],p1[r+3]);}
  const float m=max2f(a,b);
  auto rr=__builtin_amdgcn_permlane32_swap(__float_as_uint(m),__float_as_uint(m),false,false);
  return max2f(__uint_as_float(rr[0]),__uint_as_float(rr[1]));
}
__device__ __forceinline__ void pv(f32x16*o,int vb,bf16x8 pa0,bf16x8 pa1,bf16x8 pa2,bf16x8 pa3){
  #pragma unroll
  for(int d0=0;d0<2;++d0){s16x4 lo[4],hi[4];
    #pragma unroll
    for(int ks=0;ks<4;++ks){
      asm volatile("ds_read_b64_tr_b16 %0,%1 offset:%c2":"=&v"(lo[ks]):"v"(vb),"i"(d0*4096+ks*1024):"memory");
      asm volatile("ds_read_b64_tr_b16 %0,%1 offset:%c2":"=&v"(hi[ks]):"v"(vb),"i"(d0*4096+ks*1024+512):"memory");}
    asm volatile("s_waitcnt lgkmcnt(0)":::"memory");SBAR();
    #define PK(k) (bf16x8){lo[k][0],lo[k][1],lo[k][2],lo[k][3],hi[k][0],hi[k][1],hi[k][2],hi[k][3]}
    o[d0]=__builtin_amdgcn_mfma_f32_32x32x16_bf16(pa0,PK(0),o[d0],0,0,0);
    o[d0]=__builtin_amdgcn_mfma_f32_32x32x16_bf16(pa1,PK(1),o[d0],0,0,0);
    o[d0]=__builtin_amdgcn_mfma_f32_32x32x16_bf16(pa2,PK(2),o[d0],0,0,0);
    o[d0]=__builtin_amdgcn_mfma_f32_32x32x16_bf16(pa3,PK(3),o[d0],0,0,0);
    #undef PK
  }
}

#ifndef ATTN_STORE16
#define ATTN_STORE16(p,v) (*(u32x4*)(p)=(v))
#endif
template<int THRL> __device__ __forceinline__ void attn_unit(int b,int h,int qb,const bf16*Q,const bf16*__restrict__ K,const bf16*__restrict__ V,bf16*O,const unsigned*__restrict__ SEL,char*shm){
  int tid_=threadIdx.x; asm volatile("":"+v"(tid_)); const int tid=tid_,lane=tid&63,r32=lane&31,hi=lane>>5; const int wid=__builtin_amdgcn_readfirstlane(tid>>6);
  const long rowbase=(long)b*SEQ; const int q0=qb*QB;
  const bf16*Qw=Q+(rowbase+q0+wid*QBLK)*QP+h*D;
  const bf16*Kh=K+rowbase*QP+h*D,*Vh=V+rowbase*QP+h*D;
  const unsigned lds0=(unsigned)(uintptr_t)shm;
  float*wsf=(float*)(shm+LDS_WS)+wid*64;
  const bf16*ksrc=Kh+(long)lane*QP+wid*8;
  const bf16*vsrc=Vh+(long)(16*(wid&3)+(lane>>2))*QP+(wid>>2)*32+(lane&3)*8;
  const unsigned kdst=lds0+LDS_K+wid*1024, vdst=lds0+LDS_V+wid*1024;
  #define KT(t) (((t)<4)?(NT-4+(t)):((t)-4))
  #define DMA_K(t,slot) glds16(ksrc+(long)KT(t)*KVBLK*QP,(unsigned)__builtin_amdgcn_readfirstlane(kdst+(slot)))
  #define DMA_V(t,slot) glds16(vsrc+(long)KT(t)*KVBLK*QP,(unsigned)__builtin_amdgcn_readfirstlane(vdst+(slot)))
  const int vb0=(int)(lds0+LDS_V)+((lane>>4)&1)*32+(lane&3)*8+(4*hi+((lane&15)>>2))*64;
  const char*Kbase=shm+LDS_K; bf16x8 kf[8];
  const lds_cptr shm3=(lds_cptr)shm; const lds_cptr kp0=shm3+LDS_K+hi*1024+r32*16; const lds_cptr vp0=shm3+LDS_V+((lane>>4)&1)*32+(lane&3)*8+(4*hi+((lane&15)>>2))*64;
  const int NT=(q0+QB)/KVBLK;
  DMA_K(0,0);DMA_V(0,0);DMA_K(1,SLOTB);
  const unsigned selm=SEL[((long)(b*NHEAD+h))*SEQ+q0+wid*QBLK+r32];
  const float sl2=__builtin_amdgcn_exp2f(-(float)(h+1))*1.4426950408889634f;
  bf16x8 qr[4];
  #pragma unroll
  for(int d0=0;d0<4;++d0)qr[d0]=*reinterpret_cast<const bf16x8*>(&Qw[(long)r32*QP+d0*16+hi*8]);
  float mhat=0.f,l_reg=0.f;f32x16 o[2];o[0]=f32x16{};o[1]=f32x16{};
  #define CINIT(C0,C1,t) do{ const int kt_=KT(t); const bool on_=((t)<4)||(((selm>>(kt_>>2))&1u)!=0u); \
    const float bs_=on_?(sl2*(float)(64*kt_-q0+4*hi)-mhat):-1e30f; const float s32_=32.f*sl2; \
    _Pragma("unroll") for(int r=0;r<16;++r)C0[r]=__builtin_fmaf(sl2,(float)((r&3)+8*(r>>2)),bs_); \
    _Pragma("unroll") for(int r=0;r<16;++r)C1[r]=C0[r]+s32_; }while(0)
  const int qrel=wid*QBLK+r32;
  #define CMASK(P0,P1,t) do{ if((t)<4)cmask(P0,P1,(t),qrel,hi); }while(0)
  bool resc=false;
  #define START(P0,P1) do{ const float rm=rowmax(P0,P1); resc=false; \
    { const float dl=rm; mhat=fadd_s(mhat,dl); \
      _Pragma("unroll") for(int r=0;r<16;++r){P0[r]=fsub_s(P0[r],dl);P1[r]=fsub_s(P1[r],dl);} } \
    _Pragma("unroll") for(int r=0;r<16;++r)P0[r]=__builtin_amdgcn_exp2f(P0[r]); }while(0)
  #define RESC() do{ if(resc){ asm volatile("s_waitcnt lgkmcnt(0)":::"memory"); \
      _Pragma("unroll") for(int d_=0;d_<2;++d_) _Pragma("unroll") for(int r=0;r<16;++r)o[d_][r]*=wsf[crow(r,hi)]; } }while(0)
  f32x16 pA0,pA1,pB0,pB1;
  int sl_prev=0,sl_cur=0,sl_next=SLOTB;
  #define ROT() do{sl_prev=sl_cur;sl_cur=sl_next;sl_next=(sl_next==(NSLOT-1)*SLOTB)?0:sl_next+SLOTB;}while(0)
  DMA_K(2,2*SLOTB);
  WAIT_BAR(3);
  CINIT(pA0,pA1,0); qkt(pA0,pA1,Kbase,qr,r32,hi);asm volatile("s_nop 15\n\ts_nop 7":"+v"(pA0),"+v"(pA1));CMASK(pA0,pA1,0);
  START(pA0,pA1);
  _Pragma("unroll") for(int r=0;r<16;++r)pA1[r]=__builtin_amdgcn_exp2f(pA1[r]);
  WAIT_BAR(0);
  DMA_K(3,0);DMA_V(1,SLOTB);
  ROT();
  kload8(kf,kp0+sl_cur);
  WAIT_BAR(2);
  s16x4 vlo[8],vhi[8]; u32x4 pw0,pw1,pw2,pw3;
  #define PKW(P,B) cvtpk_s(P[B],P[B+1])
  #define PAF(k) __builtin_bit_cast(bf16x8,pw##k)
  #define VFR(i) (bf16x8){vlo[i][0],vlo[i][1],vlo[i][2],vlo[i][3],vhi[i][0],vhi[i][1],vhi[i][2],vhi[i][3]}
  #define PIN(x) asm volatile("":"+v"(x))
  #define MX3(a,b,c) __builtin_fmaxf(__builtin_fmaxf((a),(b)),(c))
  #define GAPA(MF,A0,A1,A2,A3,W0,W1,PW) do{ MF; sacc+=A0; sacc+=A1; sacc+=A2; sacc+=A3; PIN(sacc); W0; W1; PIN(PW); SBAR(); }while(0)
  #define EX(v) __builtin_amdgcn_exp2f(v)
  #define GAPB(MF,X,B) do{ MF; X[B]=EX(X[B]); X[B+1]=EX(X[B+1]); X[B+2]=EX(X[B+2]); X[B+3]=EX(X[B+3]); PIN(X); SBAR(); }while(0)
  #define VRD(i) do{ vlo[i]=vtr(vp_+(((i)>>2)*4096+((i)&3)*1024)); vhi[i]=vtr(vp_+(((i)>>2)*4096+((i)&3)*1024+512)); }while(0)
  #define KRD(G,j) do{ if(G){ kload2(kf,kp0+sl_next,j); SBAR(); } }while(0)
  #define STEP(C0,C1,P0,P1,t,GK,GV,GL) do{ SBAR(); CINIT(C0,C1,t); SBAR(); \
    const lds_cptr vp_=vp0+sl_prev; \
    VRD(0); SBAR(); float sacc=(P0[0]+P0[1]); \
    GAPA(C0=__builtin_amdgcn_mfma_f32_32x32x16_bf16(kf[0],qr[0],C0,0,0,0), P0[2],P0[3],P0[4],P0[5],     pw0[0]=PKW(P0,0), pw0[1]=PKW(P0,2), pw0); \
    VRD(4); SBAR(); GAPA(C1=__builtin_amdgcn_mfma_f32_32x32x16_bf16(kf[1],qr[0],C1,0,0,0), P0[6],P0[7],P0[8],P0[9],     pw0[2]=PKW(P0,4), pw0[3]=PKW(P0,6), pw0); \
    VRD(1); SBAR(); GAPA(C0=__builtin_amdgcn_mfma_f32_32x32x16_bf16(kf[2],qr[1],C0,0,0,0),   P0[10],P0[11],P0[12],P0[13], pw1[0]=PKW(P0,8), pw1[1]=PKW(P0,10), pw1); \
    VRD(5); SBAR(); GAPA(C1=__builtin_amdgcn_mfma_f32_32x32x16_bf16(kf[3],qr[1],C1,0,0,0),   P0[14],P0[15],P1[0],P1[1],   pw1[2]=PKW(P0,12),pw1[3]=PKW(P0,14), pw1); \
    VRD(2); SBAR(); GAPA(C0=__builtin_amdgcn_mfma_f32_32x32x16_bf16(kf[4],qr[2],C0,0,0,0),   P1[2],P1[3],P1[4],P1[5],     pw2[0]=PKW(P1,0), pw2[1]=PKW(P1,2), pw2); \
    VRD(6); SBAR(); GAPA(C1=__builtin_amdgcn_mfma_f32_32x32x16_bf16(kf[5],qr[2],C1,0,0,0),   P1[6],P1[7],P1[8],P1[9],     pw2[2]=PKW(P1,4), pw2[3]=PKW(P1,6), pw2); \
    VRD(3); SBAR(); GAPA(C0=__builtin_amdgcn_mfma_f32_32x32x16_bf16(kf[6],qr[3],C0,0,0,0),   P1[10],P1[11],P1[12],P1[13], pw3[0]=PKW(P1,8), pw3[1]=PKW(P1,10), pw3); \
    VRD(7); SBAR(); GAPA(C1=__builtin_amdgcn_mfma_f32_32x32x16_bf16(kf[7],qr[3],C1,0,0,0),   P1[14],P1[15],0.f,0.f,       pw3[2]=PKW(P1,12),pw3[3]=PKW(P1,14), pw3); \
    l_reg+=sacc; \
    if(GK){DMA_K((t)+3,sl_cur);} if(GV){DMA_V((t)+1,sl_next);} \
    CMASK(C0,C1,t); \
    { float a=MX3(C0[0],C0[1],C1[0]),b=MX3(C0[2],C0[3],C1[1]); a=MX3(a,C1[2],C1[3]); \
      _Pragma("unroll") for(int r=4;r<16;r+=4){a=MX3(a,C0[r],C0[r+1]);b=MX3(b,C0[r+2],C0[r+3]);a=MX3(a,C1[r],C1[r+1]);b=MX3(b,C1[r+2],C1[r+3]);} \
      float rm=__builtin_fmaxf(a,b); { auto rr=__builtin_amdgcn_permlane32_swap(__float_as_uint(rm),__float_as_uint(rm),false,false); rm=__builtin_fmaxf(__uint_as_float(rr[0]),__uint_as_float(rr[1])); } \
      resc=false; \
      if(__builtin_expect(__any(rm>(float)THRL),0)){ const float dl=__builtin_fmaxf(rm,0.f); mhat+=dl; \
        _Pragma("unroll") for(int r=0;r<16;++r){C0[r]-=dl;C1[r]-=dl;} \
        const float f=__builtin_amdgcn_exp2f(-dl); l_reg*=f; if(hi==0)wsf[r32]=f; resc=true; } } \
    SBAR(); \
    GAPB(o[0]=__builtin_amdgcn_mfma_f32_32x32x16_bf16(PAF(0),VFR(0),o[0],0,0,0), C0,0); \
    GAPB(o[1]=__builtin_amdgcn_mfma_f32_32x32x16_bf16(PAF(0),VFR(4),o[1],0,0,0), C0,4); \
    KRD(GL,0); GAPB(o[0]=__builtin_amdgcn_mfma_f32_32x32x16_bf16(PAF(1),VFR(1),o[0],0,0,0), C0,8); \
    KRD(GL,1); GAPB(o[1]=__builtin_amdgcn_mfma_f32_32x32x16_bf16(PAF(1),VFR(5),o[1],0,0,0), C0,12); \
    KRD(GL,2); GAPB(o[0]=__builtin_amdgcn_mfma_f32_32x32x16_bf16(PAF(2),VFR(2),o[0],0,0,0), C1,0); \
    KRD(GL,3); GAPB(o[1]=__builtin_amdgcn_mfma_f32_32x32x16_bf16(PAF(2),VFR(6),o[1],0,0,0), C1,4); \
    GAPB(o[0]=__builtin_amdgcn_mfma_f32_32x32x16_bf16(PAF(3),VFR(3),o[0],0,0,0), C1,8); \
    GAPB(o[1]=__builtin_amdgcn_mfma_f32_32x32x16_bf16(PAF(3),VFR(7),o[1],0,0,0), C1,12); \
    }while(0)
  int t=1;
  for(;t+5<NT;t+=2){
    STEP(pB0,pB1,pA0,pA1,t,true,true,true);     WAIT_BAR(2); RESC(); ROT();
    STEP(pA0,pA1,pB0,pB1,t+1,true,true,true);   WAIT_BAR(2); RESC(); ROT();
  }
  #define ENDW(tt) do{ if((tt)+3<NT){WAIT_BAR(2);} else if((tt)+2<NT){WAIT_BAR(1);} else {WAIT_BAR(0);} }while(0)
  for(;t+1<NT;t+=2){
    STEP(pB0,pB1,pA0,pA1,t,(t+3<NT),(t+1<NT),(t+1<NT));       ENDW(t);   RESC(); ROT();
    STEP(pA0,pA1,pB0,pB1,t+1,(t+4<NT),(t+2<NT),(t+2<NT));     ENDW(t+1); RESC(); ROT();
  }
  STEP(pB0,pB1,pA0,pA1,NT-1,false,false,false); RESC();
  { float sacc=pB0[0]+pB0[1]; _Pragma("unroll") for(int r=2;r<16;++r)sacc+=pB0[r]; _Pragma("unroll") for(int r=0;r<16;++r)sacc+=pB1[r]; l_reg+=sacc;
    pw0=(u32x4){PKW(pB0,0),PKW(pB0,2),PKW(pB0,4),PKW(pB0,6)};pw1=(u32x4){PKW(pB0,8),PKW(pB0,10),PKW(pB0,12),PKW(pB0,14)};pw2=(u32x4){PKW(pB1,0),PKW(pB1,2),PKW(pB1,4),PKW(pB1,6)};pw3=(u32x4){PKW(pB1,8),PKW(pB1,10),PKW(pB1,12),PKW(pB1,14)};
    SBAR(); pv(o,vb0+sl_cur,PAF(0),PAF(1),PAF(2),PAF(3)); }
  #undef PKW
  #undef PAF
  #undef VFR
  #undef PIN
  #undef MX3
  #undef GAPA
  #undef GAPB
  #undef EX
  #undef VRD
  #undef KRD
  #undef STEP
  #undef ENDW
  {auto rr=__builtin_amdgcn_permlane32_swap(__float_as_uint(l_reg),__float_as_uint(l_reg),false,false);l_reg=__uint_as_float(rr[0])+__uint_as_float(rr[1]);}
  if(hi==0)wsf[32+r32]=l_reg;asm volatile("s_waitcnt lgkmcnt(0)":::"memory");
  float rli[16];
  #pragma unroll
  for(int r=0;r<16;++r)rli[r]=__builtin_amdgcn_rcpf(wsf[32+crow(r,hi)]);
  bf16*Ow=O+(rowbase+q0+wid*QBLK)*OP+h*D;
  { bf16*stg=(bf16*)(shm+LDS_OST)+wid*2048;
    #pragma unroll
    for(int r=0;r<16;++r){const int orow=crow(r,hi);
      #pragma unroll
      for(int d0=0;d0<2;++d0)stg[orow*64+d0*32+r32]=__float2bfloat16(o[d0][r]*rli[r]);}
    asm volatile("s_waitcnt lgkmcnt(0)":::"memory");
    #pragma unroll
    for(int i=0;i<4;++i){const int row=i*8+(lane>>3),ch=lane&7; const u32x4 v=*(const u32x4*)(stg+row*64+ch*8); ATTN_STORE16(Ow+(long)row*OP+ch*8,v);} }
  asm volatile("s_waitcnt lgkmcnt(0)\n\ts_barrier":::"memory");
  #undef DMA_K
  #undef DMA_V
  #undef KT
  #undef CINIT
  #undef CMASK
  #undef START
  #undef RESC
  #undef ROT
}
constexpr int ATTN_LDS_BYTES=LDS_BYTES;
struct AttnTensors { const bf16* Q; const bf16* K; const bf16* V; bf16* O; const unsigned* SEL; };
struct AttnUnit { int bh; int qb; };
struct StaticOrder {
  int vcu, G;
  __device__ __forceinline__ StaticOrder(int grid,int vcu_):vcu(vcu_),G(grid){}
  __device__ __forceinline__ bool next(int i,AttnUnit&u)const{
    if(G==256){ if(i>=4)return false; const int c=vcu&3; u.bh=vcu>>2; u.qb=(i==0)?15-c:(i==1)?11-c:(i==2)?4+c:c; return true; }
    const int L=i*G+vcu; if(L>=BATCH*NHEAD*NQB)return false; u.qb=NQB-1-L/(BATCH*NHEAD); u.bh=L%(BATCH*NHEAD); return true; }
  __device__ __forceinline__ void a_ready(const AttnUnit&)const{}
  __device__ __forceinline__ void done(const AttnUnit&)const{}
};
template<class Sched,int THRL=8> __device__ __forceinline__ void attn_phase(char*lds,const AttnTensors&T,const Sched&S){
  AttnUnit u;
  for(int i=0;S.next(i,u);++i){ S.a_ready(u); attn_unit<THRL>(u.bh/NHEAD,u.bh%NHEAD,u.qb,T.Q,T.K,T.V,T.O,T.SEL,lds); S.done(u); }
}
#undef SBAR
#undef WAIT_BAR
}

#define GAS __attribute__((address_space(1)))
#define LAS __attribute__((address_space(3)))
typedef unsigned short bf16;
typedef unsigned v4u __attribute__((ext_vector_type(4)));
typedef float f32x4 __attribute__((ext_vector_type(4)));
typedef short bf16x8 __attribute__((ext_vector_type(8)));
typedef GAS unsigned gu32;
typedef GAS unsigned long long gu64;
#define RLX_AGENT __ATOMIC_RELAXED, __HIP_MEMORY_SCOPE_AGENT
#define LDS_WAIT() asm volatile("s_waitcnt lgkmcnt(0)" ::: "memory")
#define VM_WAIT() asm volatile("s_waitcnt vmcnt(0)" ::: "memory")
__device__ __forceinline__ unsigned long long rt() { return __builtin_amdgcn_s_memrealtime(); }
__device__ __forceinline__ unsigned f2bf(float f) { unsigned u = __builtin_bit_cast(unsigned, f); return (u + 0x7fffu + ((u >> 16) & 1u)) >> 16; }
__device__ __forceinline__ unsigned pk2(float lo, float hi) { return f2bf(lo) | (f2bf(hi) << 16); }

#define XB_TMO      128
#define XB_XCNT(j)  (256  + 64 * (j))
#define XB_XSUB(j)  (1280 + 64 * (j))
#define XB_XGEN(j)  (2304 + 64 * (j))
#define XB_TOP      3328
#define XB_TOPGEN   3392
#define XCD_BAR_WORDS 3456
#define XB_SPIN_CAP (1u << 18)

__device__ __forceinline__ unsigned xb_ld(unsigned* p)              { return __hip_atomic_load(p, __ATOMIC_RELAXED, __HIP_MEMORY_SCOPE_AGENT); }
__device__ __forceinline__ unsigned xb_add(unsigned* p, unsigned v) { return __hip_atomic_fetch_add(p, v, __ATOMIC_RELAXED, __HIP_MEMORY_SCOPE_AGENT); }
__device__ __forceinline__ unsigned xb_xcc_id() { return (unsigned)__builtin_amdgcn_s_getreg((3 << 11) | 20) & 0xFu; }
#define XB_SPIN(cond, bar) do { unsigned _sp = 0; while (cond) { __builtin_amdgcn_s_sleep(1); \
    if ((++_sp & 255u) == 0u) { if (xb_ld(&(bar)[XB_TMO])) break; if (_sp > XB_SPIN_CAP) { atomicAdd(&(bar)[XB_TMO], 1u); break; } } } } while (0)

struct XcdBarrier {
    unsigned* bar; unsigned x;
    volatile LAS unsigned* st;
};

__device__ __forceinline__ XcdBarrier xcd_barrier_post(unsigned* bar, volatile LAS unsigned* st) {
    XcdBarrier b; b.bar = bar; b.x = xb_xcc_id(); b.st = st;
    if (threadIdx.x == 0) (void)xb_add(&bar[XB_XCNT(b.x)], 1u);
    return b;
}
__device__ __forceinline__ void xcd_barrier_complete(unsigned* bar, unsigned x, unsigned& nloc, unsigned& nx) {
    const unsigned G = gridDim.x * gridDim.y * gridDim.z;
    unsigned sum, cnt, mine, sp = 0u;
    for (;;) {
        sum = 0u; cnt = 0u; mine = 0u;
#pragma unroll
        for (unsigned j = 0; j < 16; ++j) { const unsigned c = xb_ld(&bar[XB_XCNT(j)]); sum += c; cnt += (c > 0u) ? 1u : 0u; mine = (j == x) ? c : mine; }
        if (sum == G) break;
        __builtin_amdgcn_s_sleep(1);
        if ((++sp & 255u) == 0u) { if (xb_ld(&bar[XB_TMO])) break; if (sp > XB_SPIN_CAP) { atomicAdd(&bar[XB_TMO], 1u); break; } }
    }
    nloc = mine > 0u ? mine : 1u; nx = cnt > 0u ? cnt : 1u;
}

__device__ __forceinline__ void xcd_barrier(const XcdBarrier& b) {
    asm volatile("s_waitcnt vmcnt(0)" ::: "memory");
    __syncthreads();
    if (threadIdx.x == 0) {
        unsigned* bar = b.bar;
        __builtin_amdgcn_s_waitcnt(0);
        unsigned nloc = b.st[0], nx = b.st[1];
        if (nloc == 0u) { xcd_barrier_complete(bar, b.x, nloc, nx); b.st[0] = nloc; b.st[1] = nx; }
        const unsigned old = xb_add(&bar[XB_XSUB(b.x)], 1u);
        const unsigned gen = old / nloc;
        if (old + 1u == (gen + 1u) * nloc) {
            __builtin_amdgcn_fence(__ATOMIC_RELEASE, "agent");
            asm volatile("s_waitcnt vmcnt(0)" ::: "memory");
            const unsigned og = xb_add(&bar[XB_TOP], 1u);
            const unsigned tg = og / nx;
            if (og + 1u == (tg + 1u) * nx) xb_add(&bar[XB_TOPGEN], 1u);
            else XB_SPIN(xb_ld(&bar[XB_TOPGEN]) == tg, bar);
            __builtin_amdgcn_fence(__ATOMIC_ACQUIRE, "agent");
            xb_add(&bar[XB_XGEN(b.x)], 1u);
            asm volatile("s_waitcnt vmcnt(0)" ::: "memory");
        } else {
            XB_SPIN(xb_ld(&bar[XB_XGEN(b.x)]) == gen, bar);
            __builtin_amdgcn_fence(__ATOMIC_ACQUIRE, "agent");
            asm volatile("s_waitcnt vmcnt(0)" ::: "memory");
        }
    }
    __syncthreads();
}


constexpr int NWAVES = 8;
constexpr int RING_OFF = 0, RING_BYTES = 131072;
constexpr int LDSCTL_OFF = RING_BYTES, MISC_OFF = LDSCTL_OFF + 320;
constexpr int LDS_BYTES = 147456;
constexpr int CW_TMO = 0, CW_CODE = 1, CW_BAR = 4096;
constexpr int N_PHASES = 19;

struct Frame {
    LAS unsigned char* lds;
    volatile LAS unsigned* MISC;
    gu32* ctl;
    int tid, lane, wave, vcu, G;
};
struct Args { const float* in[18]; float* out; unsigned char* ws; int ph_lo, ph_hi, li, pad; };

__device__ __forceinline__ float wave_sum(float v) {
#pragma unroll
    for (int o = 1; o < 64; o <<= 1) v += __shfl_xor(v, o);
    return v;
}

struct PrepSeg { const float* W; const float* gain; bf16* dst; int ldin, col0, N, K, ldout, seg, seg_stride; };
__device__ __forceinline__ void prep_item(const PrepSeg& s, LAS float* scr, int item, int lane) {
    const int nblk = s.N / 32, kb = item / nblk, nb = item % nblk, k0 = 64 * kb, n0 = 32 * nb;
    const GAS float* Wg = (const GAS float*)s.W; const GAS float* gg = (const GAS float*)s.gain;
    const GAS float* wsrc = Wg + (size_t)(k0 + (lane >> 5)) * s.ldin + s.col0 + n0 + (lane & 31);
    float wv[32];
#pragma unroll
    for (int i = 0; i < 32; ++i) wv[i] = wsrc[(size_t)(2 * i) * s.ldin];
    if (gg) {
        float gv[32];
#pragma unroll
        for (int i = 0; i < 32; ++i) gv[i] = gg[k0 + 2 * i + (lane >> 5)];
#pragma unroll
        for (int i = 0; i < 32; ++i) wv[i] *= gv[i];
    }
#pragma unroll
    for (int i = 0; i < 32; ++i) scr[(2 * i + (lane >> 5)) * 33 + (lane & 31)] = wv[i];
    LDS_WAIT(); asm volatile("" ::: "memory");
    const int c = lane & 7;
#pragma unroll
    for (int j = 0; j < 4; ++j) { const int n = n0 + (lane >> 3) + 8 * j; const LAS float* p = scr + (8 * c) * 33 + (lane >> 3) + 8 * j;
        v4u o; o.x = pk2(p[0 * 33], p[1 * 33]); o.y = pk2(p[2 * 33], p[3 * 33]); o.z = pk2(p[4 * 33], p[5 * 33]); o.w = pk2(p[6 * 33], p[7 * 33]);
        const int drow = (n / s.seg) * s.seg_stride + (n % s.seg);
        *(GAS v4u*)(s.dst + (size_t)drow * s.ldout + k0 + 8 * c) = o; }
    LDS_WAIT(); asm volatile("" ::: "memory");
}
constexpr int NSEG = 14;
__device__ const int SEG_DSTC[9] = {C_MQ, C_MK, C_MV, C_GQ, C_GK, C_GV, C_GR, C_PU, 0};
__device__ const int SEG_SRCC[9] = {O_MQ, O_MK, O_MV, O_GQ, O_GK, O_GV, O_GR, O_PU, O_GATE};
__device__ const int SEG_NN[9] = {512, 512, 512, 256, 256, 512, 512, 512, NGATE};
__device__ __forceinline__ void get_seg(const Args& a, int l, int s, PrepSeg& d) {
    unsigned char* wl = a.ws + WS_W + (size_t)l * W_LAYER;
    const float* win = a.in[2] + (size_t)l * DM * DIN; const float* gpre = a.in[1] + l * DM; const float* gffn = a.in[13] + l * DM;
    d.seg = 1 << 30; d.seg_stride = 0; d.gain = nullptr; d.col0 = 0;
    if (s < 9) {
        d.W = win; d.gain = gpre; d.ldin = DIN; d.col0 = SEG_SRCC[s]; d.N = SEG_NN[s]; d.K = DM; d.ldout = DM;
        d.dst = (s < 8) ? (bf16*)(wl + W_IN) + (size_t)SEG_DSTC[s] * DM : (bf16*)(wl + W_GATE);
    } else if (s == 9)  { d.W = a.in[8] + (size_t)l * 512 * 1024; d.ldin = 1024; d.N = 1024; d.K = 512; d.ldout = KBR; d.dst = (bf16*)(wl + W_BR); }
    else if (s == 10) { d.W = a.in[10] + (size_t)l * 512 * 1024; d.ldin = 1024; d.N = 1024; d.K = 512; d.ldout = KBR; d.dst = (bf16*)(wl + W_BR) + 1024; }
    else if (s == 11) { d.W = a.in[11] + (size_t)l * 1024 * 1024; d.ldin = 1024; d.N = 1024; d.K = 1024; d.ldout = DM; d.dst = (bf16*)(wl + W_OUT); }
    else if (s == 12) { d.W = a.in[14] + (size_t)l * DM * DFF; d.gain = gffn; d.ldin = DFF; d.N = DFF; d.K = DM; d.ldout = DM; d.dst = (bf16*)(wl + W_GU); d.seg = 128; d.seg_stride = 256; }
    else              { d.W = a.in[15] + (size_t)l * DM * DFF; d.gain = gffn; d.ldin = DFF; d.N = DFF; d.K = DM; d.ldout = DM; d.dst = (bf16*)(wl + W_GU) + (size_t)128 * DM; d.seg = 128; d.seg_stride = 256; }
}
__device__ __forceinline__ void p0_prologue(Frame& F, const Args& a) {
    int tid_ = threadIdx.x; asm volatile("" : "+v"(tid_)); const int tid = tid_, lane = tid & 63;
    LAS float* scr = (LAS float*)(F.lds + RING_OFF + F.wave * 16384);
    const int gw = F.vcu * NWAVES + F.wave, NGW = F.G * NWAVES;
    int base = 0;
    for (int l = 0; l < DEPTH; ++l) {
        for (int s = 0; s < NSEG + 1; ++s) {
            PrepSeg d;
            if (s < NSEG) get_seg(a, l, s, d);
            else { d.W = a.in[16] + (size_t)l * DFF * DM; d.gain = nullptr; d.ldin = DM; d.col0 = 0; d.N = DM; d.K = DFF; d.ldout = DFF; d.dst = (bf16*)(a.ws + WS_W + (size_t)l * W_LAYER + W_DN); d.seg = 1 << 30; d.seg_stride = 0; }
            const int nitems = (d.K / 64) * (d.N / 32);
            int first = gw - (base % NGW); if (first < 0) first += NGW;
            for (int it = first; it < nitems; it += NGW) prep_item(d, scr, it, lane);
            base += nitems;
        }
        const float* wp = a.in[6] + (size_t)l * 4 * 128 * 128; const float* sc = a.in[7] + l * 512; const float* Wb = a.in[9] + (size_t)l * 512 * 1024;
        bf16* WBR_t = (bf16*)(a.ws + WS_W + (size_t)l * W_LAYER + W_BR);
        for (int idx = (F.vcu * NWAVES * 64) + tid; idx < 64 * 1024; idx += F.G * NWAVES * 64) {
            const int n = idx & 1023, c8 = __builtin_amdgcn_readfirstlane(idx >> 10), g = c8 >> 4, c0 = (c8 & 15) * 8;
            float s8[8];
#pragma unroll
            for (int i = 0; i < 8; ++i) s8[i] = 0.f;
            for (int dc = 0; dc < 128; dc += 32) {
                float wb[32];
#pragma unroll
                for (int d = 0; d < 32; ++d) wb[d] = sc[g * 128 + dc + d] * Wb[(size_t)(g * 128 + dc + d) * 1024 + n];
#pragma unroll
                for (int i = 0; i < 8; ++i) { const float* wr_ = wp + ((size_t)g * 128 + c0 + i) * 128 + dc;
#pragma unroll
                    for (int d = 0; d < 32; ++d) s8[i] += wr_[d] * wb[d]; }
            }
            v4u o; o.x = pk2(s8[0], s8[1]); o.y = pk2(s8[2], s8[3]); o.z = pk2(s8[4], s8[5]); o.w = pk2(s8[6], s8[7]);
            *(GAS v4u*)(WBR_t + (size_t)n * KBR + 512 + g * 128 + c0) = o;
        }
    }
}
__device__ __forceinline__ void rows_phase(Frame& F, const float* xsrc, const bf16* Fin, const float* wpost, float* xdst, bf16* XB, float* R, float* G1, const float* g1_win, const float* g1_gain) {
    int tid_ = threadIdx.x; asm volatile("" : "+v"(tid_)); const int tid = tid_;
    LAS float* wt = (LAS float*)(F.lds + RING_OFF);
    if (g1_win) {
        const GAS float* gw_ = (const GAS float*)g1_win; const GAS float* gg_ = (const GAS float*)g1_gain;
#pragma unroll 8
        for (int idx = tid; idx < 16 * 1024; idx += NWAVES * 64) { const int k = idx >> 4, j = idx & 15; wt[j * 1024 + k] = gg_[k] * gw_[(size_t)k * DIN + O_G1 + j]; }
        __syncthreads();
    }
    const int gw = F.vcu * NWAVES + F.wave, NGW = F.G * NWAVES, lane = tid & 63;
    for (int m = gw; m < M; m += NGW) {
        const GAS f32x4* xr = (const GAS f32x4*)(xsrc + (size_t)m * DM) + lane;
        f32x4 v[4];
#pragma unroll
        for (int j = 0; j < 4; ++j) v[j] = xr[64 * j];
        if (Fin) {
            const GAS unsigned long long* fr8 = (const GAS unsigned long long*)(Fin + (size_t)m * DM) + lane;
            f32x4 f[4]; float s = 0.f;
#pragma unroll
            for (int j = 0; j < 4; ++j) { const unsigned long long w = fr8[64 * j]; const unsigned lo = (unsigned)w, hi = (unsigned)(w >> 32);
                f[j] = (f32x4){__uint_as_float(lo << 16), __uint_as_float(lo & 0xffff0000u), __uint_as_float(hi << 16), __uint_as_float(hi & 0xffff0000u)};
                s += (f[j].x * f[j].x + f[j].y * f[j].y) + (f[j].z * f[j].z + f[j].w * f[j].w); }
            const float rf = 1.f / sqrtf(wave_sum(s) * (1.f / DM) + EPS);
#pragma unroll
            for (int j = 0; j < 4; ++j) { const f32x4 w = ((const GAS f32x4*)wpost)[64 * j + lane]; v[j] = v[j] + f[j] * rf * w; }
        }
        if (xdst) { GAS f32x4* xo = (GAS f32x4*)(xdst + (size_t)m * DM) + lane;
#pragma unroll
            for (int j = 0; j < 4; ++j) xo[64 * j] = v[j]; }
        if (XB) {
            float s = 0.f;
#pragma unroll
            for (int j = 0; j < 4; ++j) s += (v[j].x * v[j].x + v[j].y * v[j].y) + (v[j].z * v[j].z + v[j].w * v[j].w);
            const float r = 1.f / sqrtf(wave_sum(s) * (1.f / DM) + EPS);
            GAS unsigned long long* o8 = (GAS unsigned long long*)(XB + (size_t)m * DM) + lane;
#pragma unroll
            for (int j = 0; j < 4; ++j) o8[64 * j] = (unsigned long long)pk2(v[j].x, v[j].y) | ((unsigned long long)pk2(v[j].z, v[j].w) << 32);
            if (lane == 0) R[m] = r;
            if (g1_win) {
                float mine = 0.f;
#pragma unroll
                for (int jj = 0; jj < 16; ++jj) { float d = 0.f;
#pragma unroll
                    for (int j = 0; j < 4; ++j) { const f32x4 w = *(const LAS f32x4*)(wt + jj * 1024 + 4 * (64 * j + lane)); d += (v[j].x * w.x + v[j].y * w.y) + (v[j].z * w.z + v[j].w * w.w); }
                    d = wave_sum(d); if (lane == jj) mine = d; }
                if (lane < 16) G1[(size_t)m * 16 + lane] = mine * r;
            }
        }
    }
    if (g1_win) __syncthreads();
}


constexpr size_t WS_SEL = 5 * MiB;
__device__ __forceinline__ void kmean_phase(Frame& F, const bf16* PM, float* KM) {
    int tid_ = threadIdx.x; asm volatile("" : "+v"(tid_)); const int lane = tid_ & 63;
    const int gw = F.vcu * NWAVES + F.wave, NGW = F.G * NWAVES;
    for (int u = gw; u < BATCH * 16 * 8; u += NGW) {
        const int h = u & 7, n = (u >> 3) & 15, b = u >> 7, dp = lane & 31, half = lane >> 5;
        const GAS unsigned* p = (const GAS unsigned*)(PM + ((size_t)b * SEQ + n * 256 + half * 128) * NMIX + C_MK + h * 64) + dp;
        float s0 = 0.f, s1 = 0.f;
        for (int i = 0; i < 128; i += 16) { unsigned x[16];
#pragma unroll
            for (int k = 0; k < 16; ++k) x[k] = p[(size_t)(i + k) * (NMIX / 2)];
#pragma unroll
            for (int k = 0; k < 16; ++k) { s0 += __uint_as_float(x[k] << 16); s1 += __uint_as_float(x[k] & 0xffff0000u); } }
        s0 += __shfl_xor(s0, 32); s1 += __shfl_xor(s1, 32);
        if (half == 0) { float* o = KM + (((size_t)b * 8 + h) * 16 + n) * 64 + 2 * dp; o[0] = s0 * (1.f / 256.f); o[1] = s1 * (1.f / 256.f); }
    }
}
__device__ __forceinline__ void topk_phase(Frame& F, const bf16* PM, const float* KM, unsigned* SEL) {
    int tid_ = threadIdx.x; asm volatile("" : "+v"(tid_)); const int lane = tid_ & 63;
    const int gw = F.vcu * NWAVES + F.wave, NGW = F.G * NWAVES;
    for (int u = gw; u < (M / 64) * 8; u += NGW) {
        const int h = u & 7, m0 = (u >> 3) * 64, m = m0 + lane, b = m0 >> 12, j = (m0 & (SEQ - 1)) >> 8;
        float q[64];
        const GAS v4u* qp = (const GAS v4u*)(PM + (size_t)m * NMIX + C_MQ + h * 64);
#pragma unroll
        for (int d = 0; d < 8; ++d) { const v4u w = qp[d];
            q[8 * d + 0] = __uint_as_float(w.x << 16); q[8 * d + 1] = __uint_as_float(w.x & 0xffff0000u); q[8 * d + 2] = __uint_as_float(w.y << 16); q[8 * d + 3] = __uint_as_float(w.y & 0xffff0000u);
            q[8 * d + 4] = __uint_as_float(w.z << 16); q[8 * d + 5] = __uint_as_float(w.z & 0xffff0000u); q[8 * d + 6] = __uint_as_float(w.w << 16); q[8 * d + 7] = __uint_as_float(w.w & 0xffff0000u); }
        float b0 = -3e38f, b1 = -3e38f, b2 = -3e38f; int i0 = -1, i1 = -1, i2 = -1;
        for (int n = 0; n < j; ++n) {
            const float* km = KM + (((size_t)b * 8 + h) * 16 + n) * 64;
            float g = 0.f;
#pragma unroll
            for (int d = 0; d < 64; ++d) g += q[d] * km[d];
            if (g > b0) { b2 = b1; i2 = i1; b1 = b0; i1 = i0; b0 = g; i0 = n; }
            else if (g > b1) { b2 = b1; i2 = i1; b1 = g; i1 = n; }
            else if (g > b2) { b2 = g; i2 = n; }
        }
        unsigned sel = 0u;
        if (i0 >= 0) sel |= 1u << i0;
        if (i1 >= 0) sel |= 1u << i1;
        if (i2 >= 0) sel |= 1u << i2;
        SEL[((size_t)b * 8 + h) * SEQ + (m & (SEQ - 1))] = sel;
    }
}

namespace gla {
typedef short bf16x8 __attribute__((ext_vector_type(8)));
typedef float f32x4 __attribute__((ext_vector_type(4)));
constexpr int LP = 72, LPB = LP * 2;
constexpr int L_QD = 0, L_KI = 9216, L_KIT = 18432, L_VT = 27648, L_AT = 46080, L_SEG = 55296, L_RED = 57344, L_RN = 59392, L_END = 59648;
constexpr int NUNITS = BATCH * 4 * 64;
__device__ __forceinline__ bf16x8 frag(const LAS unsigned char* base, int row0, int k0, int lane) {
    return *(const LAS bf16x8*)(base + (row0 + (lane & 15)) * LPB + (k0 + 8 * (lane >> 4)) * 2);
}
__device__ __forceinline__ void load_vt(LAS unsigned char* lds, const bf16* PM, size_t m0, int h, int w, int lane) {
#pragma unroll
    for (int tt = 0; tt < 8; ++tt) { const int t = 8 * w + tt;
        const unsigned vw = *(const GAS unsigned*)(PM + (m0 + t) * NMIX + C_GV + h * 128 + 2 * lane);
        *(LAS unsigned short*)(lds + L_VT + (2 * lane) * LPB + t * 2) = (unsigned short)(vw & 0xffffu);
        *(LAS unsigned short*)(lds + L_VT + (2 * lane + 1) * LPB + t * 2) = (unsigned short)(vw >> 16); }
}
__device__ __forceinline__ void prep_unit(int u, LAS unsigned char* lds, bf16* PM, const float* G1, const float* w2, const float* bg, bf16* UT, float* EF, int w, int lane) {
    const int bh = u >> 6, c = u & 63, b = bh >> 2, h = bh & 3; const size_t m0 = (size_t)b * SEQ + c * 64;
    float wj[16];
#pragma unroll
    for (int j = 0; j < 16; ++j) wj[j] = w2[j * 256 + h * 64 + lane];
    const float bias = bg[h * 64 + lane];
    float cs[8]; float run = 0.f;
#pragma unroll
    for (int tt = 0; tt < 8; ++tt) { const float* g = G1 + (m0 + 8 * w + tt) * 16; float x = bias;
#pragma unroll
        for (int j = 0; j < 16; ++j) x += g[j] * wj[j];
        const float ls = fminf(x, 0.f) - __logf(1.f + __expf(-fabsf(x)));
        run += ls * (1.f / 16.f); cs[tt] = run; }
    LAS float* seg = (LAS float*)(lds + L_SEG);
    seg[w * 64 + lane] = run;
    unsigned short qraw[8], kraw[8];
#pragma unroll
    for (int tt = 0; tt < 8; ++tt) { qraw[tt] = PM[(m0 + 8 * w + tt) * NMIX + C_GQ + h * 64 + lane]; kraw[tt] = PM[(m0 + 8 * w + tt) * NMIX + C_GK + h * 64 + lane]; }
    load_vt(lds, PM, m0, h, w, lane);
    __syncthreads();
    float prefix = 0.f, ref = 0.f, tot = 0.f;
#pragma unroll
    for (int ww = 0; ww < 8; ++ww) { const float s = seg[ww * 64 + lane]; if (ww < w) prefix += s; if (ww < 4) ref += s; tot += s; }
#pragma unroll
    for (int tt = 0; tt < 8; ++tt) { const int t = 8 * w + tt; const float bc = prefix + cs[tt];
        const float e1 = __expf(bc - ref), e2 = __builtin_amdgcn_rcpf(e1);
        bf16* qp = PM + (m0 + t) * NMIX + C_GQ + h * 64 + lane; bf16* kp = PM + (m0 + t) * NMIX + C_GK + h * 64 + lane;
        const float q = __uint_as_float((unsigned)qraw[tt] << 16), k = __uint_as_float((unsigned)kraw[tt] << 16);
        const unsigned qi = f2bf(q * e1), ki = f2bf(k * e2);
        *qp = (bf16)qi; *kp = (bf16)ki;
        *(LAS unsigned short*)(lds + L_KIT + lane * LPB + t * 2) = (unsigned short)ki; }
    if (w == 0) { float* ef = EF + (size_t)u * 192; ef[lane] = __expf(tot); ef[64 + lane] = __expf(tot - ref); ef[128 + lane] = __expf(ref); }
    __syncthreads();
    const bf16x8 bv0 = frag(lds + L_VT, 16 * w, 0, lane), bv1 = frag(lds + L_VT, 16 * w, 32, lane);
#pragma unroll
    for (int dt = 0; dt < 4; ++dt) {
        const bf16x8 a0 = frag(lds + L_KIT, 16 * dt, 0, lane), a1 = frag(lds + L_KIT, 16 * dt, 32, lane);
        f32x4 acc = {0.f, 0.f, 0.f, 0.f};
        acc = __builtin_amdgcn_mfma_f32_16x16x32_bf16(a0, bv0, acc, 0, 0, 0);
        acc = __builtin_amdgcn_mfma_f32_16x16x32_bf16(a1, bv1, acc, 0, 0, 0);
        const int v = 16 * w + (lane & 15), d0 = 16 * dt + 4 * (lane >> 4);
        const unsigned long long pk = (unsigned long long)pk2(acc[0], acc[1]) | ((unsigned long long)pk2(acc[2], acc[3]) << 32);
        *(GAS unsigned long long*)(UT + ((size_t)u * 128 + v) * 64 + d0) = pk; }
    __syncthreads();
}
__device__ __forceinline__ void scan_phase(Frame& F, bf16* UT, const float* EF, int tid) {
    for (int idx = F.vcu * (NWAVES * 64) + tid; idx < BATCH * 4 * 128 * 32; idx += F.G * NWAVES * 64) {
        const int dp = idx & 31, v = (idx >> 5) & 127, bh = idx >> 12;
        float s0 = 0.f, s1 = 0.f;
        for (int cb = 0; cb < 64; cb += 8) {
            unsigned uw[8]; float ea0[8], ea1[8], eb0[8], eb1[8], ec0[8], ec1[8];
#pragma unroll
            for (int i = 0; i < 8; ++i) { const size_t u = (size_t)bh * 64 + cb + i;
                uw[i] = *(const GAS unsigned*)(UT + (u * 128 + v) * 64 + 2 * dp); const float* ef = EF + u * 192 + 2 * dp;
                ea0[i] = ef[0]; ea1[i] = ef[1]; eb0[i] = ef[64]; eb1[i] = ef[65]; ec0[i] = ef[128]; ec1[i] = ef[129]; }
#pragma unroll
            for (int i = 0; i < 8; ++i) { const size_t u = (size_t)bh * 64 + cb + i;
                const float u0 = __uint_as_float(uw[i] << 16), u1 = __uint_as_float(uw[i] & 0xffff0000u);
                *(GAS unsigned*)(UT + (u * 128 + v) * 64 + 2 * dp) = pk2(ec0[i] * s0, ec1[i] * s1);
                s0 = ea0[i] * s0 + eb0[i] * u0; s1 = ea1[i] * s1 + eb1[i] * u1; }
        }
    }
}
__device__ __forceinline__ void out_unit(int u, LAS unsigned char* lds, const bf16* PM, const bf16* UT, const float* nw, bf16* MO, int tid, int w, int lane) {
    const int bh = u >> 6, c = u & 63, b = bh >> 2, h = bh & 3; const size_t m0 = (size_t)b * SEQ + c * 64;
    { const int row = tid >> 3, ch = tid & 7;
        const v4u qv = *(const GAS v4u*)(PM + (m0 + row) * NMIX + C_GQ + h * 64 + ch * 8), kv = *(const GAS v4u*)(PM + (m0 + row) * NMIX + C_GK + h * 64 + ch * 8);
        *(LAS v4u*)(lds + L_QD + row * LPB + ch * 16) = qv; *(LAS v4u*)(lds + L_KI + row * LPB + ch * 16) = kv; }
    const int v = 16 * w + (lane & 15);
    const bf16x8 bs0 = *(const GAS bf16x8*)(UT + ((size_t)u * 128 + v) * 64 + 8 * (lane >> 4)), bs1 = *(const GAS bf16x8*)(UT + ((size_t)u * 128 + v) * 64 + 32 + 8 * (lane >> 4));
    unsigned short srr[16];
#pragma unroll
    for (int i = 0; i < 16; ++i) srr[i] = PM[(m0 + 16 * (i >> 2) + 4 * (lane >> 4) + (i & 3)) * NMIX + C_GR + h * 128 + v];
    const float nwv = nw[v];
    load_vt(lds, PM, m0, h, w, lane);
    __syncthreads();
    { const int tt = w >> 1; const bf16x8 a0 = frag(lds + L_QD, 16 * tt, 0, lane), a1 = frag(lds + L_QD, 16 * tt, 32, lane);
#pragma unroll
        for (int i = 0; i < 2; ++i) { const int st = 2 * (w & 1) + i;
            const bf16x8 b0 = frag(lds + L_KI, 16 * st, 0, lane), b1 = frag(lds + L_KI, 16 * st, 32, lane);
            f32x4 acc = {0.f, 0.f, 0.f, 0.f};
            acc = __builtin_amdgcn_mfma_f32_16x16x32_bf16(a0, b0, acc, 0, 0, 0);
            acc = __builtin_amdgcn_mfma_f32_16x16x32_bf16(a1, b1, acc, 0, 0, 0);
            const int s = 16 * st + (lane & 15);
#pragma unroll
            for (int j = 0; j < 4; ++j) { const int t = 16 * tt + 4 * (lane >> 4) + j;
                *(LAS unsigned short*)(lds + L_AT + t * LPB + s * 2) = (unsigned short)f2bf(s <= t ? acc[j] : 0.f); } } }
    __syncthreads();
    const bf16x8 bv0 = frag(lds + L_VT, 16 * w, 0, lane), bv1 = frag(lds + L_VT, 16 * w, 32, lane);
    f32x4 o[4];
    LAS float* red = (LAS float*)(lds + L_RED);
#pragma unroll
    for (int tt = 0; tt < 4; ++tt) {
        const bf16x8 q0 = frag(lds + L_QD, 16 * tt, 0, lane), q1 = frag(lds + L_QD, 16 * tt, 32, lane), p0 = frag(lds + L_AT, 16 * tt, 0, lane), p1 = frag(lds + L_AT, 16 * tt, 32, lane);
        f32x4 acc = {0.f, 0.f, 0.f, 0.f};
        acc = __builtin_amdgcn_mfma_f32_16x16x32_bf16(q0, bs0, acc, 0, 0, 0);
        acc = __builtin_amdgcn_mfma_f32_16x16x32_bf16(q1, bs1, acc, 0, 0, 0);
        acc = __builtin_amdgcn_mfma_f32_16x16x32_bf16(p0, bv0, acc, 0, 0, 0);
        acc = __builtin_amdgcn_mfma_f32_16x16x32_bf16(p1, bv1, acc, 0, 0, 0);
        o[tt] = acc;
#pragma unroll
        for (int j = 0; j < 4; ++j) { float p = acc[j] * acc[j];
            p += __shfl_xor(p, 1); p += __shfl_xor(p, 2); p += __shfl_xor(p, 4); p += __shfl_xor(p, 8);
            if ((lane & 15) == 0) red[w * 64 + 16 * tt + 4 * (lane >> 4) + j] = p; } }
    __syncthreads();
    LAS float* rn = (LAS float*)(lds + L_RN);
    if (tid < 64) { float s = 0.f;
#pragma unroll
        for (int ww = 0; ww < 8; ++ww) s += red[ww * 64 + tid];
        rn[tid] = 1.f / sqrtf(s * (1.f / 128.f) + EPS); }
    __syncthreads();
#pragma unroll
    for (int tt = 0; tt < 4; ++tt)
#pragma unroll
        for (int j = 0; j < 4; ++j) { const int t = 16 * tt + 4 * (lane >> 4) + j;
            const float sr = __uint_as_float((unsigned)srr[4 * tt + j] << 16);
            MO[(m0 + t) * KBR + h * 128 + v] = (bf16)f2bf(o[tt][j] * rn[t] * nwv * sr); }
    __syncthreads();
}
template <int WIN> __device__ __forceinline__ void pool_item(const bf16* PM, bf16* MO, int m, int t, int chn) {
    const int cnt = (t + 1 < WIN) ? (t + 1) : WIN;
    v4u x[WIN];
#pragma unroll
    for (int i = 0; i < WIN; ++i) x[i] = *(const GAS v4u*)(PM + (size_t)(m - (i < cnt ? i : 0)) * NMIX + C_PU + chn);
    float s[8];
#pragma unroll
    for (int k = 0; k < 8; ++k) s[k] = 0.f;
#pragma unroll
    for (int i = 0; i < WIN; ++i) { const float wgt = (i < cnt) ? 1.f : 0.f;
        s[0] += wgt * __uint_as_float(x[i].x << 16); s[1] += wgt * __uint_as_float(x[i].x & 0xffff0000u); s[2] += wgt * __uint_as_float(x[i].y << 16); s[3] += wgt * __uint_as_float(x[i].y & 0xffff0000u);
        s[4] += wgt * __uint_as_float(x[i].z << 16); s[5] += wgt * __uint_as_float(x[i].z & 0xffff0000u); s[6] += wgt * __uint_as_float(x[i].w << 16); s[7] += wgt * __uint_as_float(x[i].w & 0xffff0000u); }
    const float ic = 1.f / (float)cnt; const v4u x0 = x[0];
    v4u o; o.x = pk2(s[0] * ic - __uint_as_float(x0.x << 16), s[1] * ic - __uint_as_float(x0.x & 0xffff0000u)); o.y = pk2(s[2] * ic - __uint_as_float(x0.y << 16), s[3] * ic - __uint_as_float(x0.y & 0xffff0000u));
    o.z = pk2(s[4] * ic - __uint_as_float(x0.z << 16), s[5] * ic - __uint_as_float(x0.z & 0xffff0000u)); o.w = pk2(s[6] * ic - __uint_as_float(x0.w << 16), s[7] * ic - __uint_as_float(x0.w & 0xffff0000u));
    *(GAS v4u*)(MO + (size_t)m * KBR + 512 + chn) = o;
}
__device__ __forceinline__ void pool_phase(Frame& F, const bf16* PM, bf16* MO, int tid) {
    const int gw = F.vcu * NWAVES + F.wave, NGW = F.G * NWAVES, lane = tid & 63;
    for (int wi = gw; wi < M; wi += NGW) {
        const int g = wi & 3, m = 4 * (wi >> 2) + (lane >> 4), t = m & (SEQ - 1), chn = 128 * g + 8 * (lane & 15);
        if (g == 0) pool_item<2>(PM, MO, m, t, chn); else if (g == 1) pool_item<4>(PM, MO, m, t, chn); else if (g == 2) pool_item<8>(PM, MO, m, t, chn); else pool_item<16>(PM, MO, m, t, chn);
    }
}
}

__global__ void __launch_bounds__(NWAVES * 64, 2) mega_fwd(Args args) {
    extern __shared__ __attribute__((aligned(16))) unsigned char lds[];
    Frame F;
    F.lds = (LAS unsigned char*)lds;
    F.MISC = (volatile LAS unsigned*)(F.lds + MISC_OFF);
    F.tid = threadIdx.x; F.lane = F.tid & 63; F.wave = __builtin_amdgcn_readfirstlane(F.tid >> 6);
    F.G = gridDim.x; { const int bx = blockIdx.x; F.vcu = (F.G % 8 == 0) ? (bx % 8) * (F.G / 8) + bx / 8 : bx; }
    unsigned char* ws = args.ws;
    F.ctl = (gu32*)(ws + WS_CTL);
    for (int u = F.tid; u < (LDS_BYTES - LDSCTL_OFF) / 4; u += NWAVES * 64) ((LAS unsigned*)(F.lds + LDSCTL_OFF))[u] = 0u;
    __syncthreads();
    XcdBarrier bar = xcd_barrier_post((unsigned*)(F.ctl + CW_BAR) + args.li * XCD_BAR_WORDS, F.MISC + 8);
    const int lo = args.ph_lo, hi = args.ph_hi;
    unsigned long long pt0 = 0ull, pacc = 0ull;
#define PT0() do { if (PROBE_MASK) pt0 = rt(); } while (0)
#define PT1(cat) do { if (PROBE_MASK & (1u << (cat))) pacc += rt() - pt0; } while (0)
#define IN(k) (lo <= (k) && (k) < hi)
#define SEAM(k) do { if (IN(k) && IN((k) + 1)) { PT0(); xcd_barrier(bar); PT1(15); } } while (0)
    const float* x = args.in[0]; float* out = args.out;
    float* R = (float*)(ws + WS_R); float* G1 = (float*)(ws + WS_G1);
    bf16* XB = (bf16*)(ws + WS_XB); bf16* PM = (bf16*)(ws + WS_PM); bf16* MO = (bf16*)(ws + WS_MO);
    bf16* GATES = (bf16*)(ws + WS_GATES); bf16* MIXED = (bf16*)(ws + WS_MIXED); bf16* F1 = (bf16*)(ws + WS_F1); bf16* HDN = (bf16*)(ws + WS_HDN); bf16* F2 = (bf16*)(ws + WS_F2);

    PT0(); if (IN(0)) { p0_prologue(F, args); PT1(0); PT0(); __syncthreads();     rows_phase(F, x, nullptr, nullptr, nullptr, XB, R, G1, args.in[2], args.in[1]); }
    PT1(7);
    SEAM(0);
    for (int l = 0; l < DEPTH; ++l) {
        const int pb = 1 + 9 * l;
        unsigned char* wl = ws + WS_W + (size_t)l * W_LAYER;
        const bf16* WIN_t = (const bf16*)(wl + W_IN); const bf16* WGATE_t = (const bf16*)(wl + W_GATE); const bf16* WBR_t = (const bf16*)(wl + W_BR);
        const bf16* WOUT_t = (const bf16*)(wl + W_OUT); const bf16* WGU_t = (const bf16*)(wl + W_GU); const bf16* WDN_t = (const bf16*)(wl + W_DN);
        PT0(); if (IN(pb + 0)) {
            pg8::Gemm g{XB, WIN_t, M, NMIX, DM, DM, 0}; pg8::StaticOrder S; S.init(M, NMIX, F.G, (int)blockIdx.x);
            pg8::EpiProj E{PM, R};
            pg8::gemm_phase<pg8::EpiProj, pg8::StaticOrder, true, true>(F.lds + RING_OFF, g, S, E);
        }
        PT1(1);
        SEAM(pb + 0);
        if (IN(pb + 1)) {
            float* KM = (float*)(ws + WS_KM); unsigned* SEL = (unsigned*)(ws + WS_SEL); bf16* UT = (bf16*)(ws + WS_UT); float* EF = (float*)(ws + WS_EF);
            int tid_ = threadIdx.x; asm volatile("" : "+v"(tid_)); const int tid = tid_, lane = tid & 63;
            PT0(); kmean_phase(F, PM, KM); PT1(8); PT0();
            for (int u = F.vcu; u < gla::NUNITS; u += F.G) gla::prep_unit(u, F.lds + RING_OFF, PM, G1, args.in[3] + l * 16 * 256, args.in[4] + l * 256, UT, EF, F.wave, lane);
            PT1(9); PT0(); gla::pool_phase(F, PM, MO, tid); PT1(10);
            PT0(); xcd_barrier(bar); PT1(15);
            PT0(); topk_phase(F, PM, KM, SEL); PT1(11); PT0();
            gla::scan_phase(F, UT, EF, tid); PT1(12);
            PT0(); xcd_barrier(bar); PT1(15);
            const attn_body::AttnTensors AT{(const attn_body::bf16*)(PM + C_MQ), (const attn_body::bf16*)(PM + C_MK), (const attn_body::bf16*)(PM + C_MV), (attn_body::bf16*)(MO + 1024), SEL};
            const attn_body::StaticOrder S((int)F.G, F.vcu);
            PT0(); attn_body::attn_phase<attn_body::StaticOrder>((char*)lds + RING_OFF, AT, S); PT1(13); PT0();
            int tid2_ = threadIdx.x; asm volatile("" : "+v"(tid2_));
            for (int u = F.vcu; u < gla::NUNITS; u += F.G) gla::out_unit(u, F.lds + RING_OFF, PM, UT, args.in[5] + l * 128, MO, tid2_, F.wave, tid2_ & 63);
            PT1(14);
        }
        SEAM(pb + 1);
        PT0(); if (IN(pb + 2)) {
            pg8::Gemm g{XB, WGATE_t, M, NGATE, DM, DM, 0}; pg8::StaticOrder S; S.init(M, NGATE, F.G, (int)blockIdx.x);
            pg8::EpiSig E{GATES, R};
            pg8::gemm_phase<pg8::EpiSig, pg8::StaticOrder, true, true>(F.lds + RING_OFF, g, S, E);
        }
        PT1(2);
        SEAM(pb + 2);
        PT0(); if (IN(pb + 3)) {
            pg8::Gemm g{MO, WBR_t, M, DM, KBR, 512, 1024}; pg8::SegOrder3 S; S.S.init(M, DM, F.G, (int)blockIdx.x);
            pg8::EpiMixed E{MIXED, GATES};
            pg8::gemm_phase<pg8::EpiMixed, pg8::SegOrder3, true, true>(F.lds + RING_OFF, g, S, E);
        }
        PT1(3);
        SEAM(pb + 3);
        PT0(); if (IN(pb + 4)) {
            pg8::Gemm g{MIXED, WOUT_t, M, DM, DM, DM, 0}; pg8::StaticOrder S; S.init(M, DM, F.G, (int)blockIdx.x);
            pg8::EpiPlain E{F1};
            pg8::gemm_phase<pg8::EpiPlain, pg8::StaticOrder, true, true>(F.lds + RING_OFF, g, S, E);
        }
        PT1(4);
        SEAM(pb + 4);
        PT0(); if (IN(pb + 5)) rows_phase(F, l == 0 ? x : out, F1, args.in[12] + l * DM, out, XB, R, nullptr, nullptr, nullptr);
        PT1(7);
        SEAM(pb + 5);
        PT0(); if (IN(pb + 6)) {
            pg8::Gemm g{XB, WGU_t, M, 2 * DFF, DM, DM, 0}; pg8::StaticOrder S; S.init(M, 2 * DFF, F.G, (int)blockIdx.x);
            pg8::EpiSwiglu E{HDN, R};
            pg8::gemm_phase<pg8::EpiSwiglu, pg8::StaticOrder, true, true>(F.lds + RING_OFF, g, S, E);
        }
        PT1(5);
        SEAM(pb + 6);
        PT0(); if (IN(pb + 7)) {
            pg8::Gemm g{HDN, WDN_t, M, DM, DFF, DFF, 0}; pg8::StaticOrder S; S.init(M, DM, F.G, (int)blockIdx.x);
            pg8::EpiPlain E{F2};
            pg8::gemm_phase<pg8::EpiPlain, pg8::StaticOrder, true, true>(F.lds + RING_OFF, g, S, E);
        }
        PT1(6);
        SEAM(pb + 7);
        PT0(); if (IN(pb + 8)) {
            const bool last = (l == DEPTH - 1);
            rows_phase(F, out, F2, args.in[17] + l * DM, out, last ? nullptr : XB, last ? nullptr : R, last ? nullptr : G1,
                       last ? nullptr : args.in[2] + (size_t)(l + 1) * DM * DIN, last ? nullptr : args.in[1] + (l + 1) * DM);
        }
        PT1(7);
        SEAM(pb + 8);
    }
#undef IN
#undef SEAM
    if (PROBE_MASK) { if (blockIdx.x == 0) { const unsigned long long tend = rt() + pacc; while (rt() < tend) __builtin_amdgcn_s_sleep(8); } }
#undef PT0
#undef PT1
}

extern "C" void kernel_launch(void* const* d_in, const int* in_sizes, int n_in, void* d_out, int out_size, void* d_ws, size_t ws_size, hipStream_t stream) {
    static int grid = 0;
    if (grid == 0) {
        if (n_in != 18 || in_sizes[0] != M * DM || out_size != M * DM || ws_size < WS_END) { fprintf(stderr, "kernel_launch: unexpected shapes (n_in %d, out %d, ws %zu); nothing launched\n", n_in, out_size, ws_size); grid = -1; return; }
        int dev = 0, cus = 0, per_cu = 0;
        if (hipGetDevice(&dev) != hipSuccess || hipDeviceGetAttribute(&cus, hipDeviceAttributeMultiprocessorCount, dev) != hipSuccess) { grid = -1; return; }
        if (hipFuncSetAttribute((const void*)mega_fwd, hipFuncAttributeMaxDynamicSharedMemorySize, LDS_BYTES) != hipSuccess) { fprintf(stderr, "kernel_launch: hipFuncSetAttribute failed\n"); grid = -1; return; }
        if (hipOccupancyMaxActiveBlocksPerMultiprocessor(&per_cu, (const void*)mega_fwd, NWAVES * 64, LDS_BYTES) != hipSuccess || per_cu < 1) { fprintf(stderr, "kernel_launch: occupancy query reports %d blocks per CU; nothing launched\n", per_cu); (void)hipGetLastError(); grid = -1; return; }
        grid = cus;
    }
    if (grid < 0) return;
    if (hipMemsetAsync((char*)d_ws + WS_CTL, 0, CTL_ZERO_BYTES, stream) != hipSuccess) return;
    Args a{};
    for (int i = 0; i < 18; ++i) a.in[i] = (const float*)d_in[i];
    a.out = (float*)d_out; a.ws = (unsigned char*)d_ws;
    a.ph_lo = 0; a.ph_hi = N_PHASES; a.li = 0;
    hipLaunchKernelGGL(mega_fwd, dim3(grid), dim3(NWAVES * 64), LDS_BYTES, stream, a);
}
```
